# Optimizing an MI355X kernel written in HIP

```python
import functools
import jax
import jax.numpy as jnp
from jax import lax
import numpy as np


D_MODEL = 2048
BATCH = 4
SEQ = 4096
DEPTH = 2

N_MEM = 256
NORM_EPS = 1e-6

DN_HEADS = 8
DN_DK = 128
DN_DV = 128
DN_CONV = 4
DN_CHUNK = 64
GLA_HEADS = 4
GLA_DK = 128
GLA_DV = 256
GLA_RANK = 16
GLA_TAU = 16.0
GLA_CHUNK = 64
S5_GROUP = 16
S5_GROUPS = 64
S5_WIDTH = S5_GROUP * S5_GROUPS
S5_STATE = 64
XA_HEADS = 4
XA_DH = 128
FFN_HIDDEN = 5632
FFN_CONV = 3

IN_SIZES = (
    DN_HEADS * DN_DK,
    DN_HEADS * DN_DK,
    DN_HEADS * DN_DV,
    DN_HEADS * DN_DV,
    DN_HEADS,
    DN_HEADS,
    GLA_HEADS * GLA_DK,
    GLA_HEADS * GLA_DK,
    GLA_HEADS * GLA_DV,
    GLA_RANK,
    GLA_HEADS * GLA_DV,
    S5_WIDTH,
    3 * D_MODEL,
)
IN_WIDTH = sum(IN_SIZES)

kernel_name = 'hybrid_deltanet_gla_s5_xattn_convffn'


def rms_norm(x, g):
    xf = x.astype(jnp.float32)
    y = xf * lax.rsqrt(jnp.mean(xf * xf, axis=-1, keepdims=True) + NORM_EPS)
    return (y * g.astype(jnp.float32)).astype(x.dtype)


def l2_normalize(x):
    xf = x.astype(jnp.float32)
    return xf * lax.rsqrt(jnp.sum(xf * xf, axis=-1, keepdims=True) + NORM_EPS)


def causal_depthwise_conv(x, w):
    k_w = w.shape[-1]
    s = x.shape[1]
    xp = jnp.pad(x, ((0, 0), (k_w - 1, 0), (0, 0)))
    y = xp[:, 0:s] * w[:, 0]
    for j in range(1, k_w):
        y = y + xp[:, j:j + s] * w[:, j]
    return y


def split_columns(z, sizes):
    idx = []
    acc = 0
    for n in sizes[:-1]:
        acc += n
        idx.append(acc)
    return jnp.split(z, idx, axis=-1)


def to_chunks(t, c):
    b, s, h = t.shape[:3]
    t = t.reshape((b, s // c, c, h) + t.shape[3:])
    t = jnp.moveaxis(t, 3, 2)
    return jnp.moveaxis(t, 1, 0)


def from_chunks(o):
    n, b, h, c, d = o.shape
    return o.transpose(1, 0, 3, 2, 4).reshape(b, n * c, h, d)


def gated_delta_rule(q, k, v, g, beta):
    f32 = jnp.float32
    c = DN_CHUNK
    dk = q.shape[-1]
    q = to_chunks(l2_normalize(q) * (dk ** -0.5), c)
    k = to_chunks(l2_normalize(k), c)
    v = to_chunks(v.astype(f32), c)
    beta = to_chunks(beta.astype(f32), c)
    gc = jnp.cumsum(to_chunks(g.astype(f32), c), axis=-1)
    causal = jnp.tril(jnp.ones((c, c), dtype=bool))
    strict = jnp.tril(jnp.ones((c, c), dtype=bool), k=-1)
    decay = jnp.exp(jnp.where(causal, gc[..., :, None] - gc[..., None, :], -jnp.inf))
    kb = k * beta[..., None]
    lower = jnp.where(strict, jnp.einsum('nbhid,nbhjd->nbhij', kb, k) * decay, 0.0)
    t_mat = lower + jnp.eye(c, dtype=f32)
    solve = functools.partial(lax.linalg.triangular_solve, left_side=True, lower=True, unit_diagonal=True)
    u = solve(t_mat, v * beta[..., None])
    w = solve(t_mat, kb * jnp.exp(gc)[..., None])
    a_qk = jnp.where(causal, jnp.einsum('nbhid,nbhjd->nbhij', q, k) * decay, 0.0)
    q_dec = q * jnp.exp(gc)[..., None]
    k_dec = k * jnp.exp(gc[..., -1:] - gc)[..., None]
    g_last = jnp.exp(gc[..., -1])

    def step(state, inp):
        a_c, qd, kd, wc, uc, gl = inp
        v_new = uc - jnp.einsum('bhcd,bhde->bhce', wc, state)
        o = jnp.einsum('bhcd,bhde->bhce', qd, state) + jnp.einsum('bhij,bhje->bhie', a_c, v_new)
        state = state * gl[..., None, None] + jnp.einsum('bhcd,bhce->bhde', kd, v_new)
        return state, o

    s0 = jnp.zeros(q.shape[1:3] + (dk, v.shape[-1]), f32)
    _, o = lax.scan(step, s0, (a_qk, q_dec, k_dec, w, u, g_last))
    return from_chunks(o)


def gla_chunked(q, k, v, log_a):
    f32 = jnp.float32
    c = GLA_CHUNK
    dk = q.shape[-1]
    q = to_chunks(q.astype(f32) * (dk ** -0.5), c)
    k = to_chunks(k.astype(f32), c)
    v = to_chunks(v.astype(f32), c)
    b = jnp.cumsum(to_chunks(log_a.astype(f32), c), axis=-2)
    q_dec = q * jnp.exp(b)
    k_dec = k * jnp.exp(b[..., -1:, :] - b)
    a_last = jnp.exp(b[..., -1, :])
    causal = jnp.tril(jnp.ones((c, c), dtype=bool))[:, :, None]

    def step(state, inp):
        qc, kc, vc, bc, qd, kd, al = inp
        dec = jnp.exp(jnp.where(causal, bc[:, :, :, None, :] - bc[:, :, None, :, :], -jnp.inf))
        a_qk = jnp.einsum('bhijd,bhjd->bhij', qc[:, :, :, None, :] * dec, kc)
        o = jnp.einsum('bhid,bhde->bhie', qd, state) + jnp.einsum('bhij,bhje->bhie', a_qk, vc)
        state = state * al[..., :, None] + jnp.einsum('bhcd,bhce->bhde', kd, vc)
        return state, o

    s0 = jnp.zeros(q.shape[1:3] + (dk, v.shape[-1]), f32)
    _, o = lax.scan(step, s0, (q, k, v, b, q_dec, k_dec, a_last))
    return from_chunks(o)


def s5_ssm(u, lam_re, lam_im, log_step, b_re, b_im, c_re, c_im, d_skip):
    f32 = jnp.float32
    bsz, s, _ = u.shape
    uf = u.astype(f32).reshape(bsz, s, S5_GROUPS, S5_GROUP)
    lr = jnp.minimum(lam_re.astype(f32), -1e-4)
    li = lam_im.astype(f32)
    dt = jnp.exp(log_step.astype(f32))[:, None]
    mag = jnp.exp(lr * dt)
    ar = mag * jnp.cos(li * dt)
    ai = mag * jnp.sin(li * dt)
    nr = ar - 1.0
    den = lr * lr + li * li
    zr = (nr * lr + ai * li) / den
    zi = (ai * lr - nr * li) / den
    br = b_re.astype(f32)
    bi = b_im.astype(f32)
    bbr = zr[..., None] * br - zi[..., None] * bi
    bbi = zr[..., None] * bi + zi[..., None] * br
    bu_r = jnp.einsum('bsgh,gph->sbgp', uf, bbr)
    bu_i = jnp.einsum('bsgh,gph->sbgp', uf, bbi)
    a_r = jnp.broadcast_to(ar, (s, 1) + ar.shape)
    a_i = jnp.broadcast_to(ai, (s, 1) + ai.shape)

    def combine(e1, e2):
        a1r, a1i, b1r, b1i = e1
        a2r, a2i, b2r, b2i = e2
        return (a2r * a1r - a2i * a1i,
                a2r * a1i + a2i * a1r,
                a2r * b1r - a2i * b1i + b2r,
                a2r * b1i + a2i * b1r + b2i)

    _, _, xr, xi = lax.associative_scan(combine, (a_r, a_i, bu_r, bu_i), axis=0)
    y = (jnp.einsum('sbgp,ghp->bsgh', xr, c_re.astype(f32))
         - jnp.einsum('sbgp,ghp->bsgh', xi, c_im.astype(f32)))
    y = y + d_skip.astype(f32).reshape(S5_GROUPS, S5_GROUP) * uf
    return y.reshape(bsz, s, S5_WIDTH).astype(u.dtype)


def hybrid_mixer(h, w_in, dn_conv_w, dn_a_log, dn_dt_bias, dn_norm_w, w_dn_out,
                 gla_w_up, gla_b_up, gla_norm_w, w_gla_out,
                 s5_lam_re, s5_lam_im, s5_log_step, s5_b_re, s5_b_im, s5_c_re, s5_c_im, s5_d,
                 w_s5_glu, w_mix_out):
    bsz, s, _ = h.shape
    z = h @ w_in
    (dq, dkk, dv, dz, db, da, gq, gk, gv, glow, gr, su, gates) = split_columns(z, IN_SIZES)

    qkv = jax.nn.silu(causal_depthwise_conv(jnp.concatenate([dq, dkk, dv], axis=-1), dn_conv_w))
    dq, dkk, dv = jnp.split(qkv, [DN_HEADS * DN_DK, 2 * DN_HEADS * DN_DK], axis=-1)
    beta = jax.nn.sigmoid(db.astype(jnp.float32))
    g = -jnp.exp(dn_a_log.astype(jnp.float32)) * jax.nn.softplus(da.astype(jnp.float32) + dn_dt_bias.astype(jnp.float32))
    o_a = gated_delta_rule(dq.reshape(bsz, s, DN_HEADS, DN_DK), dkk.reshape(bsz, s, DN_HEADS, DN_DK),
                           dv.reshape(bsz, s, DN_HEADS, DN_DV), g, beta)
    o_a = rms_norm(o_a, dn_norm_w) * jax.nn.silu(dz.reshape(bsz, s, DN_HEADS, DN_DV).astype(jnp.float32))
    y_a = o_a.reshape(bsz, s, DN_HEADS * DN_DV).astype(h.dtype) @ w_dn_out

    gate_logit = (glow @ gla_w_up + gla_b_up).astype(jnp.float32)
    log_a = jax.nn.log_sigmoid(gate_logit) / GLA_TAU
    o_b = gla_chunked(gq.reshape(bsz, s, GLA_HEADS, GLA_DK), gk.reshape(bsz, s, GLA_HEADS, GLA_DK),
                      gv.reshape(bsz, s, GLA_HEADS, GLA_DV), log_a.reshape(bsz, s, GLA_HEADS, GLA_DK))
    o_b = rms_norm(o_b, gla_norm_w) * jax.nn.silu(gr.reshape(bsz, s, GLA_HEADS, GLA_DV).astype(jnp.float32))
    y_b = o_b.reshape(bsz, s, GLA_HEADS * GLA_DV).astype(h.dtype) @ w_gla_out

    y_s = jax.nn.gelu(s5_ssm(su, s5_lam_re, s5_lam_im, s5_log_step, s5_b_re, s5_b_im, s5_c_re, s5_c_im, s5_d))
    glu_a, glu_b = jnp.split(y_s @ w_s5_glu, 2, axis=-1)
    y_c = glu_a * jax.nn.sigmoid(glu_b)

    g_a, g_b, g_c = jnp.split(jax.nn.sigmoid(gates), 3, axis=-1)
    merged = g_a * y_a + g_b * y_b + g_c * y_c
    return merged @ w_mix_out


def cross_attention(h, mem_n, w_xa_q, w_xa_kv, w_xa_out):
    bsz, s, _ = h.shape
    m = mem_n.shape[1]
    q = (h @ w_xa_q).reshape(bsz, s, XA_HEADS, XA_DH)
    kv = (mem_n @ w_xa_kv).reshape(bsz, m, 2, XA_HEADS, XA_DH)
    k = kv[:, :, 0]
    v = kv[:, :, 1]
    scores = jnp.einsum('bshd,bmhd->bhsm', q, k).astype(jnp.float32) * (XA_DH ** -0.5)
    p = jax.nn.softmax(scores, axis=-1).astype(v.dtype)
    o = jnp.einsum('bhsm,bmhd->bshd', p, v).reshape(bsz, s, XA_HEADS * XA_DH)
    return o @ w_xa_out


def conv_ffn(h, w_ffn_up, ffn_conv_w, w_ffn_down):
    gate, up = jnp.split(h @ w_ffn_up, 2, axis=-1)
    gate = causal_depthwise_conv(gate, ffn_conv_w)
    return (jax.nn.gelu(gate) * up) @ w_ffn_down


def setup_inputs(seed: int = 0) -> dict:
    key = jax.random.key(seed)
    ks = iter(jax.random.split(key, 48))
    f32 = jnp.float32
    L = DEPTH

    def dense(shape, fan_in):
        return jax.random.normal(next(ks), shape, f32) * (fan_in ** -0.5)

    def gain(shape):
        return 1.0 + 0.02 * jax.random.normal(next(ks), shape, f32)

    def log_uniform(shape, lo, hi):
        return jax.random.uniform(next(ks), shape, f32, minval=float(np.log(lo)), maxval=float(np.log(hi)))

    x = jax.random.normal(next(ks), (BATCH, SEQ, D_MODEL), f32)
    mem = jax.random.normal(next(ks), (BATCH, N_MEM, D_MODEL), f32)
    dt_init = jnp.exp(log_uniform((L, DN_HEADS), 1e-3, 1e-1))
    lam_im = jnp.broadcast_to(jnp.pi * jnp.arange(S5_STATE, dtype=f32), (L, S5_GROUPS, S5_STATE))
    return {
        'x': x,
        'mem': mem,
        'norm_mix_pre': gain((L, D_MODEL)),
        'norm_mix_post': gain((L, D_MODEL)),
        'w_in': dense((L, D_MODEL, IN_WIDTH), D_MODEL),
        'dn_conv_w': dense((L, 3 * DN_HEADS * DN_DK, DN_CONV), DN_CONV),
        'dn_a_log': jnp.log(jax.random.uniform(next(ks), (L, DN_HEADS), f32, minval=1.0, maxval=16.0)),
        'dn_dt_bias': dt_init + jnp.log(-jnp.expm1(-dt_init)),
        'dn_norm_w': gain((L, DN_DV)),
        'w_dn_out': dense((L, DN_HEADS * DN_DV, D_MODEL), DN_HEADS * DN_DV),
        'gla_w_up': dense((L, GLA_RANK, GLA_HEADS * GLA_DK), GLA_RANK),
        'gla_b_up': 0.1 * jax.random.normal(next(ks), (L, GLA_HEADS * GLA_DK), f32),
        'gla_norm_w': gain((L, GLA_DV)),
        'w_gla_out': dense((L, GLA_HEADS * GLA_DV, D_MODEL), GLA_HEADS * GLA_DV),
        's5_lam_re': -0.5 + 0.01 * jax.random.normal(next(ks), (L, S5_GROUPS, S5_STATE), f32),
        's5_lam_im': lam_im,
        's5_log_step': log_uniform((L, S5_GROUPS), 1e-3, 1e-1),
        's5_b_re': dense((L, S5_GROUPS, S5_STATE, S5_GROUP), 2 * S5_GROUP),
        's5_b_im': dense((L, S5_GROUPS, S5_STATE, S5_GROUP), 2 * S5_GROUP),
        's5_c_re': dense((L, S5_GROUPS, S5_GROUP, S5_STATE), S5_STATE),
        's5_c_im': dense((L, S5_GROUPS, S5_GROUP, S5_STATE), S5_STATE),
        's5_d': jax.random.normal(next(ks), (L, S5_WIDTH), f32),
        'w_s5_glu': dense((L, S5_WIDTH, 2 * D_MODEL), S5_WIDTH),
        'w_mix_out': dense((L, D_MODEL, D_MODEL), D_MODEL),
        'norm_xa_pre': gain((L, D_MODEL)),
        'norm_xa_post': gain((L, D_MODEL)),
        'norm_mem': gain((L, D_MODEL)),
        'w_xa_q': dense((L, D_MODEL, XA_HEADS * XA_DH), D_MODEL),
        'w_xa_kv': dense((L, D_MODEL, 2 * XA_HEADS * XA_DH), D_MODEL),
        'w_xa_out': dense((L, XA_HEADS * XA_DH, D_MODEL), XA_HEADS * XA_DH),
        'norm_ffn_pre': gain((L, D_MODEL)),
        'norm_ffn_post': gain((L, D_MODEL)),
        'w_ffn_up': dense((L, D_MODEL, 2 * FFN_HIDDEN), D_MODEL),
        'ffn_conv_w': dense((L, FFN_HIDDEN, FFN_CONV), FFN_CONV),
        'w_ffn_down': dense((L, FFN_HIDDEN, D_MODEL), FFN_HIDDEN),
    }


def reference(x, mem, norm_mix_pre, norm_mix_post, w_in, dn_conv_w, dn_a_log, dn_dt_bias, dn_norm_w,
              w_dn_out, gla_w_up, gla_b_up, gla_norm_w, w_gla_out, s5_lam_re, s5_lam_im, s5_log_step,
              s5_b_re, s5_b_im, s5_c_re, s5_c_im, s5_d, w_s5_glu, w_mix_out, norm_xa_pre, norm_xa_post,
              norm_mem, w_xa_q, w_xa_kv, w_xa_out, norm_ffn_pre, norm_ffn_post, w_ffn_up, ffn_conv_w,
              w_ffn_down):
    for l in range(DEPTH):
        h = rms_norm(x, norm_mix_pre[l])
        y = hybrid_mixer(h, w_in[l], dn_conv_w[l], dn_a_log[l], dn_dt_bias[l], dn_norm_w[l], w_dn_out[l],
                         gla_w_up[l], gla_b_up[l], gla_norm_w[l], w_gla_out[l],
                         s5_lam_re[l], s5_lam_im[l], s5_log_step[l], s5_b_re[l], s5_b_im[l],
                         s5_c_re[l], s5_c_im[l], s5_d[l], w_s5_glu[l], w_mix_out[l])
        x = x + rms_norm(y, norm_mix_post[l])
        h = rms_norm(x, norm_xa_pre[l])
        y = cross_attention(h, rms_norm(mem, norm_mem[l]), w_xa_q[l], w_xa_kv[l], w_xa_out[l])
        x = x + rms_norm(y, norm_xa_post[l])
        h = rms_norm(x, norm_ffn_pre[l])
        y = conv_ffn(h, w_ffn_up[l], ffn_conv_w[l], w_ffn_down[l])
        x = x + rms_norm(y, norm_ffn_post[l])
    return x
```

```cpp
#include <hip/hip_runtime.h>
#include <hip/hip_cooperative_groups.h>
#include <cstdio>
#include <type_traits>
namespace cg = cooperative_groups;

#define LAS __attribute__((address_space(3)))
typedef unsigned short bf16_t;
typedef short bf16x8 __attribute__((ext_vector_type(8)));
typedef float f32x4 __attribute__((ext_vector_type(4)));
typedef unsigned u32x2 __attribute__((ext_vector_type(2)));
typedef unsigned u32x4 __attribute__((ext_vector_type(4)));

constexpr int MTOK = 16384, DM = 2048, SEQ = 4096, NB = 4;
constexpr int ZW = 14336;
constexpr int ZN = 14592;
constexpr int ZQ = 0, ZK = 1024, ZV = 2048, ZZ = 3072, GQ = 4096, GK = 4608, GV = 5120, GR = 6144, SU = 7168, GT = 8192;
constexpr int FF = 5632;
constexpr float EPS = 1e-6f;

constexpr size_t WS_WA   = 0;
constexpr size_t SZ_WA   = 69206016;
constexpr size_t WS_WDN  = WS_WA + SZ_WA;
constexpr size_t WS_WGLA = WS_WDN + 4194304;
constexpr size_t WS_WGLU = WS_WGLA + 4194304;
constexpr size_t WS_WMIX = WS_WGLU + 8388608;
constexpr size_t WS_WXQ  = WS_WMIX + 8388608;
constexpr size_t WS_WXKV = WS_WXQ + 2097152;
constexpr size_t WS_WXO  = WS_WXKV + 4194304;
constexpr size_t WS_Z    = WS_WXO + 2097152;
constexpr size_t SZ_Z    = (size_t)MTOK * ZW * 2;
constexpr size_t WS_SM   = WS_Z + SZ_Z;
constexpr size_t WS_H    = WS_SM + (size_t)MTOK * 32 * 4;
constexpr size_t WS_DNP  = WS_H + (size_t)MTOK * DM * 2;
constexpr size_t DN_ITEM = 73728;
constexpr size_t WS_GLP  = WS_DNP + DN_ITEM * 2048;
constexpr size_t GL_ITEM = 74240;
constexpr size_t WS_MISC = WS_GLP + GL_ITEM * 1024;
constexpr size_t WS_END  = WS_MISC + 65536;

struct Params { const float* in[35]; float* out; unsigned char* ws; };
typedef const __attribute__((address_space(4))) Params* PPtr;
__device__ __forceinline__ int fresh_tid(int) {
    int hw = __builtin_amdgcn_s_getreg(10244) & 63; asm volatile("" : "+s"(hw));
    const int w = __builtin_amdgcn_readfirstlane(*(const volatile LAS int*)((LAS unsigned char*)nullptr + 131072 + hw * 4));
    const int ln = __builtin_amdgcn_mbcnt_hi(~0u, __builtin_amdgcn_mbcnt_lo(~0u, 0u)); int t = w * 64 + ln; asm volatile("" : "+v"(t)); return t; }
__device__ __forceinline__ int fresh_bid() { int b = blockIdx.x; asm volatile("" : "+s"(b)); return b; }
__device__ __forceinline__ int fresh_gdim() { int b = gridDim.x; asm volatile("" : "+s"(b)); return b; }
__device__ __forceinline__ PPtr PP() { auto kp = __builtin_amdgcn_kernarg_segment_ptr(); asm volatile("" : "+s"(kp)); return (PPtr)kp; }

__device__ __forceinline__ float bf2f(bf16_t v) { return __uint_as_float(((unsigned)v) << 16); }
typedef float f32x2_t __attribute__((ext_vector_type(2)));
typedef __bf16 bf16x2_t __attribute__((ext_vector_type(2)));
__device__ __forceinline__ unsigned pk_bf16(float lo, float hi) { const f32x2_t v = {lo, hi}; const bf16x2_t b = __builtin_convertvector(v, bf16x2_t); return __builtin_bit_cast(unsigned, b); }
__device__ __forceinline__ bf16_t f2bf(float f) { return (bf16_t)(pk_bf16(f, 0.f) & 0xffffu); }
__device__ __forceinline__ float sigmoidf_(float x) { return 1.f / (1.f + __expf(-x)); }
__device__ __forceinline__ float siluf_(float x) { return x * sigmoidf_(x); }
__device__ __forceinline__ float geluf_(float x) { const float u = 1.5957691216057308f * (x + 0.044715f * x * x * x); return x * sigmoidf_(u); }
__device__ __forceinline__ float softplusf_(float x) { return x > 20.f ? x : log1pf(__expf(x)); }
__device__ __forceinline__ float shx(float v, int mask, int lane) { return __int_as_float(__builtin_amdgcn_ds_bpermute((lane ^ mask) << 2, __float_as_int(v))); }
__device__ __forceinline__ float shup(float v, int delta, int lane) { return __int_as_float(__builtin_amdgcn_ds_bpermute((lane - delta) << 2, __float_as_int(v))); }
__device__ __forceinline__ float lo_bf(unsigned w) { return __uint_as_float(w << 16); }
__device__ __forceinline__ float hi_bf(unsigned w) { return __uint_as_float(w & 0xffff0000u); }
__device__ __forceinline__ f32x4 mfma16(bf16x8 a, bf16x8 b, f32x4 c) { return __builtin_amdgcn_mfma_f32_16x16x32_bf16(a, b, c, 0, 0, 0); }

__device__ __forceinline__ void gsync(cg::grid_group& grid) {
    __builtin_amdgcn_fence(__ATOMIC_RELEASE, "agent");
    asm volatile("s_waitcnt vmcnt(0) lgkmcnt(0)" ::: "memory");
    grid.sync();
    __builtin_amdgcn_fence(__ATOMIC_ACQUIRE, "agent");
    asm volatile("s_waitcnt vmcnt(0)" ::: "memory");
}

constexpr int BM = 256, BK = 64, HALF = 128, HTB = HALF * BK * 2, STAGE_BYTES = 8 * HTB, NXCD = 8, WGM = 8;
__device__ __forceinline__ int lds_byte(int r, int c) { const int st = (r >> 4) * 2 + (c >> 5), rr = r & 15, cc = c & 31, ob = rr * 64 + cc * 2; return st * 1024 + (ob ^ (((ob >> 9) & 1) << 5)); }
__device__ __forceinline__ void stage_rc(int b, int& R, int& C) { const int st = b / 1024, sb = b % 1024, swz = sb ^ (((sb >> 9) & 1) << 5); R = (st >> 1) * 16 + swz / 64; C = (st & 1) * 32 + (swz % 64) / 2; }
struct Unit { int pm, pn; };
struct Gemm { const bf16_t* A; const bf16_t* Bt; int M, N, K, lda; };
struct StaticOrder {
    int nM, nN, nwg, G, c;
    __device__ void init(int M, int N, int G_, int c_) { nM = M / BM; nN = N / BM; nwg = nM * nN; G = G_; c = c_; }
    __device__ bool next(int i, Unit& u) const {
        const long L = (long)i * G + c; if (L >= nwg) return false;
        int wgid = (int)L; { const int q = nwg / NXCD, r = nwg % NXCD, xcd = wgid % NXCD, off = wgid / NXCD; wgid = (xcd < r ? xcd * (q + 1) : r * (q + 1) + (xcd - r) * q) + off; }
        const int nig = WGM * nN, gid = wgid / nig, fm = gid * WGM, gsz = (nM - fm) < WGM ? (nM - fm) : WGM;
        u.pm = fm + ((wgid % nig) % gsz); u.pn = (wgid % nig) / gsz; return true;
    }
};

template <class Epi>
__device__ __forceinline__ void gemm_phase(LAS unsigned char* lds, const Gemm g, const StaticOrder& S, const Epi& E, const int wid_s) {
    const int tid = fresh_tid(wid_s), wid = __builtin_amdgcn_readfirstlane(tid >> 6), lane = tid & 63, wr = wid >> 2, wc = wid & 3, fr = lane & 15, fq = lane >> 4;
    const int K = g.K, nt = K / BK, lda = g.lda;
    unsigned voffA[2], voffB[2];
#pragma unroll
    for (int i = 0; i < 2; ++i) { int R, C; stage_rc(tid * 16 + i * 8192, R, C); voffA[i] = (unsigned)(R * lda + C) * 2u; voffB[i] = (unsigned)(R * K + C) * 2u; }
    const size_t kstep = (size_t)(BK * 2);
    const size_t hstepA = (size_t)HALF * lda * 2, hstepB = (size_t)HALF * K * 2;
    const size_t tstepA = 2 * hstepA, tstepB = 2 * hstepB;
    const unsigned ldsw = (unsigned)wid * 1024u;
    const int aoff = lds_byte(wr * 64 + fr, fq * 8), boff = lds_byte(wc * 32 + fr, fq * 8);
#define PG8_SA(b, h) (((b) * 2 + (h)) * HTB)
#define PG8_SB(b, h) ((4 + (b) * 2 + (h)) * HTB)
#define PG8_STAGE(bufoff, gbase, voff) do { _Pragma("unroll") for (int _i = 0; _i < 2; ++_i) \
        __builtin_amdgcn_global_load_lds((const unsigned*)((const char*)(gbase) + (voff)[_i]), (LAS unsigned*)(lds + (bufoff) + ldsw + _i * 8192), 16, 0, 0); } while (0)
#define PG8_LDA(dst, b, h) do { _Pragma("unroll") for (int m = 0; m < 4; ++m) _Pragma("unroll") for (int k = 0; k < 2; ++k) dst[m][k] = *(const LAS bf16x8*)(lds + PG8_SA(b, h) + aoff + m * 2048 + k * 1024); } while (0)
#define PG8_LDB(dst, b, h) do { _Pragma("unroll") for (int n = 0; n < 2; ++n) _Pragma("unroll") for (int k = 0; k < 2; ++k) dst[n][k] = *(const LAS bf16x8*)(lds + PG8_SB(b, h) + boff + n * 2048 + k * 1024); } while (0)
#define PG8_MMA(ai, bj, At, Bt) do { __builtin_amdgcn_s_setprio(1); _Pragma("unroll") for (int m = 0; m < 4; ++m) _Pragma("unroll") for (int n = 0; n < 2; ++n) _Pragma("unroll") for (int k = 0; k < 2; ++k) \
        acc[ai][bj][m][n] = __builtin_amdgcn_mfma_f32_16x16x32_bf16(Bt[n][k], At[m][k], acc[ai][bj][m][n], 0, 0, 0); __builtin_amdgcn_s_setprio(0); } while (0)
#define PG8_WAIT_V(n) asm volatile("s_waitcnt vmcnt(" #n ")" ::: "memory")
#define PG8_WAIT_L(n) asm volatile("s_waitcnt lgkmcnt(" #n ")" ::: "memory")
#define PG8_BAR __builtin_amdgcn_s_barrier()
#define PG8_SCHED __builtin_amdgcn_sched_barrier(0)
    Unit cur, nxt; int ui = 0;
    if (!S.next(0, cur)) return;
    f32x4 acc[2][2][4][2];
#pragma unroll
    for (int a = 0; a < 2; ++a)
#pragma unroll
        for (int b = 0; b < 2; ++b)
#pragma unroll
            for (int m = 0; m < 4; ++m)
#pragma unroll
                for (int n = 0; n < 2; ++n) acc[a][b][m][n] = (f32x4){0.f, 0.f, 0.f, 0.f};
    bf16x8 At[4][2], B0[2][2], B1[2][2];
    const char* cA = (const char*)g.A + (size_t)cur.pm * tstepA; const char* cB = (const char*)g.Bt + (size_t)cur.pn * tstepB;
    PG8_STAGE(PG8_SB(0, 0), cB, voffB); PG8_STAGE(PG8_SA(0, 0), cA, voffA); PG8_STAGE(PG8_SB(0, 1), cB + hstepB, voffB); PG8_STAGE(PG8_SA(0, 1), cA + hstepA, voffA);
    if (wr == 1) PG8_BAR;
    PG8_WAIT_V(4); PG8_BAR;
    PG8_STAGE(PG8_SB(1, 0), cB + kstep, voffB); PG8_STAGE(PG8_SA(1, 0), cA + kstep, voffA); PG8_STAGE(PG8_SB(1, 1), cB + hstepB + kstep, voffB);
    PG8_WAIT_V(6); PG8_BAR;
    for (;;) {
        const bool has_next = S.next(ui + 1, nxt);
        const char* nA = has_next ? (const char*)g.A + (size_t)nxt.pm * tstepA : cA; const char* nB = has_next ? (const char*)g.Bt + (size_t)nxt.pn * tstepB : cB;
        for (int t = 0; t < nt; t += 2) {
            const bool last = (t == nt - 2);
            const char* a1 = cA + (size_t)(t + 1) * kstep;
            const char* a2 = last ? nA : cA + (size_t)(t + 2) * kstep; const char* b2 = last ? nB : cB + (size_t)(t + 2) * kstep;
            const char* a3 = a2 + kstep; const char* b3 = b2 + kstep;
            PG8_LDB(B0, 0, 0); PG8_SCHED; PG8_LDA(At, 0, 0); PG8_STAGE(PG8_SA(1, 1), a1 + hstepA, voffA);
            PG8_WAIT_L(8); PG8_BAR; PG8_WAIT_L(0); PG8_MMA(0, 0, At, B0); PG8_BAR; PG8_SCHED;
            PG8_LDB(B1, 0, 1); PG8_STAGE(PG8_SB(0, 0), b2, voffB);
            PG8_BAR; PG8_WAIT_L(0); PG8_MMA(0, 1, At, B1); PG8_BAR;
            PG8_LDA(At, 0, 1); PG8_STAGE(PG8_SA(0, 0), a2, voffA);
            PG8_BAR; PG8_WAIT_L(0); PG8_MMA(1, 0, At, B0); PG8_BAR; PG8_SCHED;
            PG8_STAGE(PG8_SB(0, 1), b2 + hstepB, voffB);
            PG8_WAIT_V(6); PG8_BAR; PG8_MMA(1, 1, At, B1); PG8_BAR;
            PG8_LDB(B0, 1, 0); PG8_SCHED; PG8_LDA(At, 1, 0); PG8_STAGE(PG8_SA(0, 1), a2 + hstepA, voffA);
            PG8_WAIT_L(8); PG8_BAR; PG8_WAIT_L(0); PG8_MMA(0, 0, At, B0); PG8_BAR; PG8_SCHED;
            PG8_LDB(B1, 1, 1); PG8_STAGE(PG8_SB(1, 0), b3, voffB);
            PG8_BAR; PG8_WAIT_L(0); PG8_MMA(0, 1, At, B1); PG8_BAR;
            PG8_LDA(At, 1, 1); PG8_STAGE(PG8_SA(1, 0), a3, voffA);
            PG8_BAR; PG8_WAIT_L(0); PG8_MMA(1, 0, At, B0); PG8_BAR; PG8_SCHED;
            PG8_STAGE(PG8_SB(1, 1), b3 + hstepB, voffB);
            PG8_WAIT_V(6); PG8_BAR; PG8_MMA(1, 1, At, B1); PG8_BAR;
        }
        E(acc, cur, wr, wc, fr, fq);
        if (!has_next) break;
#pragma unroll
        for (int a = 0; a < 2; ++a)
#pragma unroll
            for (int b = 0; b < 2; ++b)
#pragma unroll
                for (int m = 0; m < 4; ++m)
#pragma unroll
                    for (int n = 0; n < 2; ++n) acc[a][b][m][n] = (f32x4){0.f, 0.f, 0.f, 0.f};
        cur = nxt; cA = nA; cB = nB; ++ui;
    }
    PG8_WAIT_V(0);
    if (wr == 0) PG8_BAR;
    PG8_BAR;
#undef PG8_SA
#undef PG8_SB
#undef PG8_STAGE
#undef PG8_LDA
#undef PG8_LDB
#undef PG8_MMA
#undef PG8_WAIT_V
#undef PG8_WAIT_L
#undef PG8_BAR
#undef PG8_SCHED
}

typedef const f32x4 (&AccRef)[2][2][4][2];
__device__ __forceinline__ u32x2 pk4(f32x4 v) { u32x2 r; r.x = pk_bf16(v[0], v[1]); r.y = pk_bf16(v[2], v[3]); return r; }
__device__ __forceinline__ f32x4 ld_bf4(const bf16_t* p) { const u32x2 w = *(const u32x2*)p; return (f32x4){lo_bf(w.x), hi_bf(w.x), lo_bf(w.y), hi_bf(w.y)}; }
__device__ __forceinline__ f32x4 sig4(f32x4 v) { return (f32x4){sigmoidf_(v[0]), sigmoidf_(v[1]), sigmoidf_(v[2]), sigmoidf_(v[3])}; }

struct EpiZ { bf16_t* Z; float* SMp;
    __device__ __forceinline__ void operator()(AccRef acc, const Unit& u, int wr, int wc, int fr, int fq) const {
        const int row0 = u.pm * BM + wr * 64 + fr;
        if (u.pn < 56) {
#pragma unroll
            for (int ai = 0; ai < 2; ++ai)
#pragma unroll
                for (int m = 0; m < 4; ++m) { bf16_t* rp = Z + (size_t)(row0 + ai * HALF + m * 16) * ZW + u.pn * BM + wc * 32 + 4 * fq;
#pragma unroll
                    for (int bj = 0; bj < 2; ++bj)
#pragma unroll
                        for (int n = 0; n < 2; ++n) *(u32x2*)(rp + bj * HALF + n * 16) = pk4(acc[ai][bj][m][n]); }
        } else if (wc == 0) {
#pragma unroll
            for (int ai = 0; ai < 2; ++ai)
#pragma unroll
                for (int m = 0; m < 4; ++m) { float* rp = SMp + (size_t)(row0 + ai * HALF + m * 16) * 32 + 4 * fq;
#pragma unroll
                    for (int n = 0; n < 2; ++n) *(f32x4*)(rp + n * 16) = acc[ai][0][m][n]; }
        }
    }
};
struct EpiF32 { float* C; int ldc;
    __device__ __forceinline__ void operator()(AccRef acc, const Unit& u, int wr, int wc, int fr, int fq) const {
        const int row0 = u.pm * BM + wr * 64 + fr, col0 = u.pn * BM + wc * 32 + 4 * fq;
#pragma unroll
        for (int ai = 0; ai < 2; ++ai)
#pragma unroll
            for (int m = 0; m < 4; ++m) { float* rp = C + (size_t)(row0 + ai * HALF + m * 16) * ldc + col0;
#pragma unroll
                for (int bj = 0; bj < 2; ++bj)
#pragma unroll
                    for (int n = 0; n < 2; ++n) *(f32x4*)(rp + bj * HALF + n * 16) = acc[ai][bj][m][n]; }
    }
};
struct EpiBf16 { bf16_t* C; int ldc;
    __device__ __forceinline__ void operator()(AccRef acc, const Unit& u, int wr, int wc, int fr, int fq) const {
        const int row0 = u.pm * BM + wr * 64 + fr, col0 = u.pn * BM + wc * 32 + 4 * fq;
#pragma unroll
        for (int ai = 0; ai < 2; ++ai)
#pragma unroll
            for (int m = 0; m < 4; ++m) { bf16_t* rp = C + (size_t)(row0 + ai * HALF + m * 16) * ldc + col0;
#pragma unroll
                for (int bj = 0; bj < 2; ++bj)
#pragma unroll
                    for (int n = 0; n < 2; ++n) *(u32x2*)(rp + bj * HALF + n * 16) = pk4(acc[ai][bj][m][n]); }
    }
};
struct EpiGLU { const bf16_t* Z; float* MRG;
    __device__ __forceinline__ void operator()(AccRef acc, const Unit& u, int wr, int wc, int fr, int fq) const {
        const int row0 = u.pm * BM + wr * 64 + fr;
#pragma unroll
        for (int ai = 0; ai < 2; ++ai)
#pragma unroll
            for (int m = 0; m < 4; ++m) { const int row = row0 + ai * HALF + m * 16;
#pragma unroll
                for (int bj = 0; bj < 2; ++bj) { const int oc = (u.pn * BM + bj * HALF + wc * 32) / 2 + 4 * fq;
                    const f32x4 gt = sig4(ld_bf4(Z + (size_t)row * ZW + GT + 4096 + oc));
                    const f32x4 a = acc[ai][bj][m][0], b = sig4(acc[ai][bj][m][1]);
                    *(f32x4*)(MRG + (size_t)row * DM + oc) = gt * a * b; } }
    }
};
template <bool FINAL> struct EpiAcc { const bf16_t* Z; float* MRG; bf16_t* MB; int goff;
    __device__ __forceinline__ void operator()(AccRef acc, const Unit& u, int wr, int wc, int fr, int fq) const {
        const int row0 = u.pm * BM + wr * 64 + fr, col0 = u.pn * BM + wc * 32 + 4 * fq;
#pragma unroll
        for (int ai = 0; ai < 2; ++ai)
#pragma unroll
            for (int m = 0; m < 4; ++m) { const int row = row0 + ai * HALF + m * 16;
#pragma unroll
                for (int bj = 0; bj < 2; ++bj)
#pragma unroll
                    for (int n = 0; n < 2; ++n) { const int c = col0 + bj * HALF + n * 16;
                        const f32x4 gt = sig4(ld_bf4(Z + (size_t)row * ZW + GT + goff + c));
                        const f32x4 v = *(const f32x4*)(MRG + (size_t)row * DM + c) + gt * acc[ai][bj][m][n];
                        if (FINAL) *(u32x2*)(MB + (size_t)row * DM + c) = pk4(v); else *(f32x4*)(MRG + (size_t)row * DM + c) = v; } }
    }
};
struct EpiKV { bf16_t* Kb; bf16_t* VT;
    __device__ __forceinline__ void operator()(AccRef acc, const Unit& u, int wr, int wc, int fr, int fq) const {
        const int row0 = u.pm * BM + wr * 64 + fr, col0 = u.pn * BM + wc * 32 + 4 * fq;
#pragma unroll
        for (int ai = 0; ai < 2; ++ai)
#pragma unroll
            for (int m = 0; m < 4; ++m) { const int row = row0 + ai * HALF + m * 16;
#pragma unroll
                for (int bj = 0; bj < 2; ++bj)
#pragma unroll
                    for (int n = 0; n < 2; ++n) { const int c = col0 + bj * HALF + n * 16; const f32x4 v = acc[ai][bj][m][n];
                        if (c < 512) *(u32x2*)(Kb + (size_t)row * 512 + c) = pk4(v);
                        else { const int cc = c - 512, b = row >> 8, key = row & 255;
#pragma unroll
                            for (int i = 0; i < 4; ++i) VT[((size_t)(b * 4 + ((cc + i) >> 7)) * 128 + ((cc + i) & 127)) * 256 + key] = f2bf(v[i]); } } }
    }
};
struct EpiFFN { bf16_t* G; bf16_t* U;
    __device__ __forceinline__ void operator()(AccRef acc, const Unit& u, int wr, int wc, int fr, int fq) const {
        const int row0 = u.pm * BM + wr * 64 + fr;
#pragma unroll
        for (int ai = 0; ai < 2; ++ai)
#pragma unroll
            for (int m = 0; m < 4; ++m) { const int row = row0 + ai * HALF + m * 16;
#pragma unroll
                for (int bj = 0; bj < 2; ++bj) { const int oc = (u.pn * BM + bj * HALF + wc * 32) / 2 + 4 * fq;
                    *(u32x2*)(G + (size_t)row * FF + oc) = pk4(acc[ai][bj][m][0]);
                    *(u32x2*)(U + (size_t)row * FF + oc) = pk4(acc[ai][bj][m][1]); } }
    }
};

template <class Epi> __device__ __forceinline__ void run_gemm(LAS unsigned char* lds, const bf16_t* A, int lda, const bf16_t* Bt, int M, int N, int K, const Epi& E, const int wid_s, int shift = 0) {
    Gemm g; g.A = A; g.Bt = Bt; g.M = M; g.N = N; g.K = K; g.lda = lda;
    StaticOrder S; S.init(M, N, (int)fresh_gdim(), (int)((fresh_bid() + fresh_gdim() - shift) % fresh_gdim()));
    gemm_phase<Epi>(lds, g, S, E, wid_s);
}

__device__ __forceinline__ int src_col(int kind, int n) {
    if (kind == 0) return n;
    if (kind == 1) {
        if (n < 4096) return n;
        if (n < 6144) return n + 16;
        if (n < 14336) return n + 32;
        if (n < 14352) return n - 14336 + 4096;
        if (n < 14368) return n - 14352 + 6160;
        return -1;
    }
    const int g = n >> 5, r = n & 31, half = (kind == 2) ? 2048 : FF;
    return r < 16 ? g * 16 + r : half + g * 16 + (r - 16);
}
__device__ void convert_w(LAS float* ldsf, const float* __restrict__ W, bf16_t* __restrict__ Wt, int K, int Nsrc, int Ndst, int kind, const int wid_s) {
    const int t = fresh_tid(wid_s), ntn = Ndst >> 6, ntiles = ntn * (K >> 6);
    for (int tile = fresh_bid(); tile < ntiles; tile += fresh_gdim()) {
        const int n0 = (tile % ntn) << 6, k0 = (tile / ntn) << 6;
        const int nn = t & 63, kq = t >> 6;
        const int sc = src_col(kind, n0 + nn);
#pragma unroll
        for (int i = 0; i < 8; ++i) { const int k = kq + 8 * i; const float v = sc >= 0 ? W[(size_t)(k0 + k) * Nsrc + sc] : 0.f; ldsf[nn * 65 + k] = v; }
        __syncthreads();
        const int row = t >> 3, seg = (t & 7) * 8;
        float v[8];
#pragma unroll
        for (int j = 0; j < 8; ++j) v[j] = ldsf[row * 65 + seg + j];
        u32x4 o; o.x = pk_bf16(v[0], v[1]); o.y = pk_bf16(v[2], v[3]); o.z = pk_bf16(v[4], v[5]); o.w = pk_bf16(v[6], v[7]);
        *(u32x4*)(Wt + (size_t)(n0 + row) * K + k0 + seg) = o;
        __syncthreads();
    }
}

__device__ __forceinline__ float wave_sum(float v, int lane) {
#pragma unroll
    for (int o = 32; o >= 1; o >>= 1) v += shx(v, o, lane);
    return v;
}
__device__ void norm_rows(const float* xin, const float* y, const float* gpost, float* xout, const float* gpre, bf16_t* hout, int nrows, const int wid_s) {
    const int t_ = fresh_tid(wid_s); const int lane = t_ & 63, gw = fresh_bid() * 8 + (t_ >> 6), nw = fresh_gdim() * 8;
    for (int row = gw; row < nrows; row += nw) {
        f32x4 v[8];
        const float* xr = xin + (size_t)row * DM;
#pragma unroll
        for (int i = 0; i < 8; ++i) v[i] = *(const f32x4*)(xr + (i * 64 + lane) * 4);
        if (y) {
            f32x4 yv[8]; float ss = 0.f;
            const float* yr = y + (size_t)row * DM;
#pragma unroll
            for (int i = 0; i < 8; ++i) { yv[i] = *(const f32x4*)(yr + (i * 64 + lane) * 4); ss += yv[i][0] * yv[i][0] + yv[i][1] * yv[i][1] + yv[i][2] * yv[i][2] + yv[i][3] * yv[i][3]; }
            ss = wave_sum(ss, lane);
            const float inv = rsqrtf(ss * (1.f / DM) + EPS);
#pragma unroll
            for (int i = 0; i < 8; ++i) { const f32x4 gp = *(const f32x4*)(gpost + (i * 64 + lane) * 4); v[i] += yv[i] * inv * gp; }
        }
        if (xout) {
            float* xo = xout + (size_t)row * DM;
#pragma unroll
            for (int i = 0; i < 8; ++i) *(f32x4*)(xo + (i * 64 + lane) * 4) = v[i];
        }
        if (hout) {
            float ss = 0.f;
#pragma unroll
            for (int i = 0; i < 8; ++i) ss += v[i][0] * v[i][0] + v[i][1] * v[i][1] + v[i][2] * v[i][2] + v[i][3] * v[i][3];
            ss = wave_sum(ss, lane);
            const float inv = rsqrtf(ss * (1.f / DM) + EPS);
            bf16_t* ho = hout + (size_t)row * DM;
#pragma unroll
            for (int i = 0; i < 8; ++i) { const f32x4 gp = *(const f32x4*)(gpre + (i * 64 + lane) * 4); *(u32x2*)(ho + (i * 64 + lane) * 4) = pk4(v[i] * inv * gp); }
        }
    }
}

__device__ void dn_prep(LAS unsigned char* lds, PPtr p, int layer, const int wid_s) {
    const int t = fresh_tid(wid_s), wv = t >> 6, lane = t & 63, fr = lane & 15, fq = lane >> 4;
    LAS bf16_t* QS = (LAS bf16_t*)lds;
    LAS bf16_t* KS = (LAS bf16_t*)(lds + 17408);
    LAS float* KF = (LAS float*)(lds + 34816);
    LAS float* VF = (LAS float*)(lds + 67584);
    LAS float* LS = (LAS float*)(lds + 100352);
    LAS float* GC = (LAS float*)(lds + 117760);
    LAS float* BE = GC + 64;
    LAS float* EG = GC + 128;
    const bf16_t* Z = (const bf16_t*)(p->ws + WS_Z);
    const float* SMp = (const float*)(p->ws + WS_SM);
    bf16_t* DNP = (bf16_t*)(p->ws + WS_DNP);
    float* GLAST = (float*)(p->ws + WS_MISC);
    const float* convw = p->in[5] + (size_t)layer * 3072 * 4;
    for (int item = fresh_bid(); item < 2048; item += fresh_gdim()) {
        const int n = item & 63, h = (item >> 6) & 7, b = item >> 9;
        const size_t row0 = (size_t)b * SEQ + n * 64;
        bf16_t* it = DNP + (size_t)item * 36864;
#pragma unroll 1
        for (int pass = 0; pass < 2; ++pass) {
            const int tok = pass * 32 + (t >> 4), c8 = (t & 15) * 8;
#pragma unroll
            for (int mat = 0; mat < 3; ++mat) {
                const int ch = mat * 1024 + h * 128 + c8;
                float y[8];
#pragma unroll
                for (int c = 0; c < 8; ++c) y[c] = 0.f;
                f32x4 wc[8];
#pragma unroll
                for (int c = 0; c < 8; ++c) wc[c] = *(const f32x4*)(convw + (size_t)(ch + c) * 4);
#pragma unroll
                for (int j = 0; j < 4; ++j) {
                    const int tt = n * 64 + tok - 3 + j;
                    if (tt >= 0) {
                        const u32x4 xv = *(const u32x4*)(Z + ((size_t)b * SEQ + tt) * ZW + ch);
                        y[0] += wc[0][j] * lo_bf(xv.x); y[1] += wc[1][j] * hi_bf(xv.x);
                        y[2] += wc[2][j] * lo_bf(xv.y); y[3] += wc[3][j] * hi_bf(xv.y);
                        y[4] += wc[4][j] * lo_bf(xv.z); y[5] += wc[5][j] * hi_bf(xv.z);
                        y[6] += wc[6][j] * lo_bf(xv.w); y[7] += wc[7][j] * hi_bf(xv.w);
                    }
                }
                float ss = 0.f;
#pragma unroll
                for (int c = 0; c < 8; ++c) { y[c] = siluf_(y[c]); ss += y[c] * y[c]; }
                if (mat < 2) {
                    ss += shx(ss, 1, lane); ss += shx(ss, 2, lane); ss += shx(ss, 4, lane); ss += shx(ss, 8, lane);
                    const float inv = rsqrtf(ss + EPS) * (mat == 0 ? 0.08838834764831845f : 1.f);
#pragma unroll
                    for (int c = 0; c < 8; ++c) y[c] *= inv;
                    u32x4 o; o.x = pk_bf16(y[0], y[1]); o.y = pk_bf16(y[2], y[3]); o.z = pk_bf16(y[4], y[5]); o.w = pk_bf16(y[6], y[7]);
                    if (mat == 0) *(LAS u32x4*)(QS + tok * 136 + c8) = o;
                    else { *(LAS u32x4*)(KS + tok * 136 + c8) = o;
#pragma unroll
                        for (int c = 0; c < 8; ++c) KF[tok * 128 + c8 + c] = y[c]; }
                } else {
#pragma unroll
                    for (int c = 0; c < 8; ++c) VF[tok * 128 + c8 + c] = y[c];
                }
            }
        }
        if (t < 64) {
            const float db = SMp[(row0 + t) * 32 + h], da = SMp[(row0 + t) * 32 + 8 + h];
            const float be = sigmoidf_(db);
            float g = -expf(p->in[6][layer * 8 + h]) * softplusf_(da + p->in[7][layer * 8 + h]);
#pragma unroll
            for (int o = 1; o < 64; o <<= 1) { const float v = shup(g, o, lane); if (lane >= o) g += v; }
            GC[t] = g; BE[t] = be; EG[t] = expf(g); GC[192 + t] = be * expf(g);
        }
        __syncthreads();
#pragma unroll
        for (int tt = 0; tt < 2; ++tt) {
            const int tile = wv * 2 + tt, mi = tile >> 2, ni = tile & 3;
            f32x4 aK = {0.f, 0.f, 0.f, 0.f}, aQ = {0.f, 0.f, 0.f, 0.f};
#pragma unroll
            for (int ks = 0; ks < 4; ++ks) {
                const bf16x8 bfr = *(const LAS bf16x8*)(KS + (ni * 16 + fr) * 136 + ks * 32 + fq * 8);
                const bf16x8 ak = *(const LAS bf16x8*)(KS + (mi * 16 + fr) * 136 + ks * 32 + fq * 8);
                const bf16x8 aq = *(const LAS bf16x8*)(QS + (mi * 16 + fr) * 136 + ks * 32 + fq * 8);
                aK = mfma16(ak, bfr, aK); aQ = mfma16(aq, bfr, aQ);
            }
            const int j = ni * 16 + fr; const float gj = GC[j];
#pragma unroll
            for (int r = 0; r < 4; ++r) {
                const int i = mi * 16 + fq * 4 + r;
                const float dec = (i >= j) ? expf(GC[i] - gj) : 0.f;
                LS[i * 68 + j] = (i > j) ? BE[i] * aK[r] * dec : 0.f;
                it[32768 + i * 64 + j] = f2bf(aQ[r] * dec);
            }
        }
        __syncthreads();
        if (t < 256) {
            const bool isw = t >= 128; const int cc = t & 127;
            bf16_t* op = it + (isw ? 8192 : 0) + cc;
            LAS const float* src = isw ? KF : VF;
            float x[64];
            int z0; asm volatile("v_mov_b32 %0, 0" : "=v"(z0));
            LAS const float* LSv = LS + z0;
            LAS const float* facp = (isw ? (GC + 192) : BE) + z0;
#pragma unroll
            for (int i = 0; i < 64; ++i) {
                float s = facp[i] * src[i * 128 + cc];
#pragma unroll
                for (int j = 0; j < i; ++j) s -= LSv[i * 68 + j] * x[j];
                x[i] = s;
                op[i * 128] = f2bf(s);
            }
        } else {
            const int t2 = t - 256;
            { const int i = t2 >> 2, cs = (t2 & 3) * 32; const float e = EG[i];
#pragma unroll
              for (int q = 0; q < 4; ++q) { const u32x4 w = *(const LAS u32x4*)(QS + i * 136 + cs + q * 8);
                  u32x4 o; o.x = pk_bf16(lo_bf(w.x) * e, hi_bf(w.x) * e); o.y = pk_bf16(lo_bf(w.y) * e, hi_bf(w.y) * e); o.z = pk_bf16(lo_bf(w.z) * e, hi_bf(w.z) * e); o.w = pk_bf16(lo_bf(w.w) * e, hi_bf(w.w) * e);
                  *(u32x4*)(it + 16384 + i * 128 + cs + q * 8) = o; } }
            { const int d = t2 >> 1, hf = t2 & 1; const float gl = GC[63];
#pragma unroll
              for (int q = 0; q < 4; ++q) { float v[8];
#pragma unroll
                  for (int e = 0; e < 8; ++e) { const int i = hf * 32 + q * 8 + e; v[e] = KF[i * 128 + d] * expf(gl - GC[i]); }
                  u32x4 o; o.x = pk_bf16(v[0], v[1]); o.y = pk_bf16(v[2], v[3]); o.z = pk_bf16(v[4], v[5]); o.w = pk_bf16(v[6], v[7]);
                  *(u32x4*)(it + 24576 + d * 64 + hf * 32 + q * 8) = o; } }
            if (t2 == 0) GLAST[item] = expf(GC[63]);
        }
        __syncthreads();
    }
}

__device__ void gla_prep(LAS unsigned char* lds, PPtr p, int layer, const int wid_s) {
    const int t = fresh_tid(wid_s), wv = t >> 6, lane = t & 63, fr = lane & 15, fq = lane >> 4;
    LAS bf16_t* QA = (LAS bf16_t*)(lds + 32768);
    LAS bf16_t* KD = (LAS bf16_t*)(lds + 50176);
    LAS float* TOT = (LAS float*)(lds + 67584);
    const bf16_t* Z = (const bf16_t*)(p->ws + WS_Z);
    const float* SMp = (const float*)(p->ws + WS_SM);
    unsigned char* GLP = p->ws + WS_GLP;
    for (int item = fresh_bid(); item < 1024; item += fresh_gdim()) {
        const int n = item & 63, h = (item >> 6) & 3, b = item >> 8;
        const size_t row0 = (size_t)b * SEQ + n * 64;
        bf16_t* it = (bf16_t*)(GLP + (size_t)item * GL_ITEM);
        const int d = t & 127, iq = __builtin_amdgcn_readfirstlane(t >> 7);
        float wup[16];
#pragma unroll
        for (int r = 0; r < 16; ++r) wup[r] = p->in[10][(size_t)layer * 16 * 512 + r * 512 + h * 128 + d];
        const float bup = p->in[11][layer * 512 + h * 128 + d];
        float la[16]; float run = 0.f;
#pragma unroll
        for (int ii = 0; ii < 16; ++ii) {
            const float* gl = SMp + (row0 + iq * 16 + ii) * 32 + 16;
            float dot = bup;
#pragma unroll
            for (int r = 0; r < 16; ++r) dot += gl[r] * wup[r];
            const float ls = fminf(dot, 0.f) - log1pf(__expf(-fabsf(dot)));
            run += ls * (1.f / 16.f); la[ii] = run;
        }
        TOT[iq * 128 + d] = run;
        __syncthreads();
        float off = 0.f, blast = 0.f;
#pragma unroll
        for (int q = 0; q < 4; ++q) { const float v = TOT[q * 128 + d]; blast += v; if (q < iq) off += v; }
        float kdv[16];
#pragma unroll
        for (int ii = 0; ii < 16; ++ii) {
            const int i = iq * 16 + ii; const float bc = la[ii] + off;
            const float q = bf2f(Z[(row0 + i) * ZW + GQ + h * 128 + d]) * 0.08838834764831845f;
            const float k = bf2f(Z[(row0 + i) * ZW + GK + h * 128 + d]);
            it[i * 128 + d] = f2bf(q * __expf(bc));
            QA[i * 136 + d] = f2bf(q * __expf(bc - blast));
            const float kd = k * __expf(blast - bc);
            KD[i * 136 + d] = f2bf(kd); kdv[ii] = kd;
        }
        { u32x4 o0, o1;
          o0.x = pk_bf16(kdv[0], kdv[1]); o0.y = pk_bf16(kdv[2], kdv[3]); o0.z = pk_bf16(kdv[4], kdv[5]); o0.w = pk_bf16(kdv[6], kdv[7]);
          o1.x = pk_bf16(kdv[8], kdv[9]); o1.y = pk_bf16(kdv[10], kdv[11]); o1.z = pk_bf16(kdv[12], kdv[13]); o1.w = pk_bf16(kdv[14], kdv[15]);
          *(u32x4*)(it + 8192 + d * 64 + iq * 16) = o0; *(u32x4*)(it + 8192 + d * 64 + iq * 16 + 8) = o1; }
        if (iq == 0) ((float*)((unsigned char*)it + 73728))[d] = __expf(blast);
        __syncthreads();
#pragma unroll
        for (int tt = 0; tt < 2; ++tt) {
            const int tile = wv * 2 + tt, mi = tile >> 2, ni = tile & 3;
            f32x4 a = {0.f, 0.f, 0.f, 0.f};
#pragma unroll
            for (int ks = 0; ks < 4; ++ks) {
                const bf16x8 bfr = *(const LAS bf16x8*)(KD + (ni * 16 + fr) * 136 + ks * 32 + fq * 8);
                const bf16x8 aq = *(const LAS bf16x8*)(QA + (mi * 16 + fr) * 136 + ks * 32 + fq * 8);
                a = mfma16(aq, bfr, a);
            }
            const int j = ni * 16 + fr;
#pragma unroll
            for (int r = 0; r < 4; ++r) { const int i = mi * 16 + fq * 4 + r; it[16384 + i * 64 + j] = f2bf(i >= j ? a[r] : 0.f); }
        }
        { const int e = t & 255, hf = t >> 8;
#pragma unroll
          for (int q = 0; q < 4; ++q) { bf16_t v[8];
#pragma unroll
              for (int e2 = 0; e2 < 8; ++e2) v[e2] = Z[(row0 + hf * 32 + q * 8 + e2) * ZW + GV + h * 256 + e];
              u32x4 o; o.x = v[0] | ((unsigned)v[1] << 16); o.y = v[2] | ((unsigned)v[3] << 16); o.z = v[4] | ((unsigned)v[5] << 16); o.w = v[6] | ((unsigned)v[7] << 16);
              *(u32x4*)(it + 20480 + e * 64 + hf * 32 + q * 8) = o; } }
        __syncthreads();
    }
}

__device__ void dn_scan(LAS unsigned char* lds, PPtr p, int bh, int es, const int wid_s) {
    const int t = fresh_tid(wid_s), wv = t >> 6, lane = t & 63, fr = lane & 15, fq = lane >> 4;
    const int mt = wv & 3, et = wv >> 2;
    LAS bf16_t* ST = (LAS bf16_t*)lds;
    LAS bf16_t* VT = (LAS bf16_t*)(lds + 8704);
    const bf16_t* DNP = (const bf16_t*)(p->ws + WS_DNP);
    const float* GLAST = (const float*)(p->ws + WS_MISC);
    bf16_t* OA = (bf16_t*)(p->ws + WS_H);
    for (int i = t; i < 32 * 136 / 2; i += 512) ((LAS unsigned*)ST)[i] = 0u;
    f32x4 S0 = {0.f, 0.f, 0.f, 0.f}, S1 = {0.f, 0.f, 0.f, 0.f};
    __syncthreads();
    const int b = bh >> 3, h = bh & 7;
#pragma unroll 1
    for (int n = 0; n < 64; ++n) {
        const bf16_t* it = DNP + (size_t)(bh * 64 + n) * 36864;
        bf16x8 wf[4], qf[4], af[2], kf[2];
#pragma unroll
        for (int ks = 0; ks < 4; ++ks) { wf[ks] = *(const bf16x8*)(it + 8192 + (mt * 16 + fr) * 128 + ks * 32 + fq * 8); qf[ks] = *(const bf16x8*)(it + 16384 + (mt * 16 + fr) * 128 + ks * 32 + fq * 8); }
#pragma unroll
        for (int ks = 0; ks < 2; ++ks) { af[ks] = *(const bf16x8*)(it + 32768 + (mt * 16 + fr) * 64 + ks * 32 + fq * 8); kf[ks] = *(const bf16x8*)(it + 24576 + (wv * 16 + fr) * 64 + ks * 32 + fq * 8); }
        float uv[4];
#pragma unroll
        for (int r = 0; r < 4; ++r) uv[r] = bf2f(it[(mt * 16 + fq * 4 + r) * 128 + es * 32 + et * 16 + fr]);
        const float gl = GLAST[bh * 64 + n];
        f32x4 P = {0.f, 0.f, 0.f, 0.f}, Q = {0.f, 0.f, 0.f, 0.f};
#pragma unroll
        for (int ks = 0; ks < 4; ++ks) { const bf16x8 bfr = *(const LAS bf16x8*)(ST + (et * 16 + fr) * 136 + ks * 32 + fq * 8); P = mfma16(wf[ks], bfr, P); Q = mfma16(qf[ks], bfr, Q); }
        const f32x4 vn = {uv[0] - P[0], uv[1] - P[1], uv[2] - P[2], uv[3] - P[3]};
        *(LAS u32x2*)(VT + (et * 16 + fr) * 72 + mt * 16 + fq * 4) = pk4(vn);
        __syncthreads();
#pragma unroll
        for (int ks = 0; ks < 2; ++ks) { const bf16x8 bfr = *(const LAS bf16x8*)(VT + (et * 16 + fr) * 72 + ks * 32 + fq * 8); Q = mfma16(af[ks], bfr, Q); }
#pragma unroll
        for (int r = 0; r < 4; ++r) OA[((size_t)b * SEQ + n * 64 + mt * 16 + fq * 4 + r) * 1024 + h * 128 + es * 32 + et * 16 + fr] = f2bf(Q[r]);
        S0 *= gl; S1 *= gl;
#pragma unroll
        for (int ks = 0; ks < 2; ++ks) {
            const bf16x8 b0 = *(const LAS bf16x8*)(VT + fr * 72 + ks * 32 + fq * 8);
            const bf16x8 b1 = *(const LAS bf16x8*)(VT + (16 + fr) * 72 + ks * 32 + fq * 8);
            S0 = mfma16(kf[ks], b0, S0); S1 = mfma16(kf[ks], b1, S1);
        }
        *(LAS u32x2*)(ST + fr * 136 + wv * 16 + fq * 4) = pk4(S0);
        *(LAS u32x2*)(ST + (16 + fr) * 136 + wv * 16 + fq * 4) = pk4(S1);
        __syncthreads();
    }
}

__device__ void gla_scan(LAS unsigned char* lds, PPtr p, int bh, int es, const int wid_s) {
    const int t = fresh_tid(wid_s), wv = t >> 6, lane = t & 63, fr = lane & 15, fq = lane >> 4;
    const int mt = wv & 3, eh = wv >> 2;
    LAS bf16_t* STb = (LAS bf16_t*)lds;
    const unsigned char* GLP = p->ws + WS_GLP;
    bf16_t* OB = (bf16_t*)(p->ws + WS_H) + (size_t)MTOK * 1024;
    for (int i = t; i < 64 * 136 / 2; i += 512) ((LAS unsigned*)STb)[i] = 0u;
    f32x4 S[4];
#pragma unroll
    for (int e = 0; e < 4; ++e) S[e] = (f32x4){0.f, 0.f, 0.f, 0.f};
    __syncthreads();
    const int b = bh >> 2, h = bh & 3;
#pragma unroll 1
    for (int n = 0; n < 64; ++n) {
        const unsigned char* itb = GLP + (size_t)(bh * 64 + n) * GL_ITEM;
        const bf16_t* it = (const bf16_t*)itb;
        LAS bf16_t* cur = STb + (n & 1) * (64 * 136);
        LAS bf16_t* nxt = STb + ((n + 1) & 1) * (64 * 136);
        bf16x8 qf[4], af[2], kf[2], vB[4][2], vO[2][2];
#pragma unroll
        for (int ks = 0; ks < 4; ++ks) qf[ks] = *(const bf16x8*)(it + (mt * 16 + fr) * 128 + ks * 32 + fq * 8);
#pragma unroll
        for (int ks = 0; ks < 2; ++ks) { af[ks] = *(const bf16x8*)(it + 16384 + (mt * 16 + fr) * 64 + ks * 32 + fq * 8); kf[ks] = *(const bf16x8*)(it + 8192 + (wv * 16 + fr) * 64 + ks * 32 + fq * 8); }
#pragma unroll
        for (int e = 0; e < 4; ++e)
#pragma unroll
            for (int ks = 0; ks < 2; ++ks) vB[e][ks] = *(const bf16x8*)(it + 20480 + (es * 64 + e * 16 + fr) * 64 + ks * 32 + fq * 8);
#pragma unroll
        for (int e2 = 0; e2 < 2; ++e2)
#pragma unroll
            for (int ks = 0; ks < 2; ++ks) vO[e2][ks] = *(const bf16x8*)(it + 20480 + (es * 64 + (eh * 2 + e2) * 16 + fr) * 64 + ks * 32 + fq * 8);
        const f32x4 al = *(const f32x4*)((const float*)(itb + 73728) + wv * 16 + fq * 4);
#pragma unroll
        for (int e2 = 0; e2 < 2; ++e2) {
            const int etile = eh * 2 + e2;
            f32x4 O = {0.f, 0.f, 0.f, 0.f};
#pragma unroll
            for (int ks = 0; ks < 4; ++ks) { const bf16x8 bfr = *(const LAS bf16x8*)(cur + (etile * 16 + fr) * 136 + ks * 32 + fq * 8); O = mfma16(qf[ks], bfr, O); }
#pragma unroll
            for (int ks = 0; ks < 2; ++ks) O = mfma16(af[ks], vO[e2][ks], O);
#pragma unroll
            for (int r = 0; r < 4; ++r) OB[((size_t)b * SEQ + n * 64 + mt * 16 + fq * 4 + r) * 1024 + h * 256 + es * 64 + etile * 16 + fr] = f2bf(O[r]);
        }
#pragma unroll
        for (int e = 0; e < 4; ++e) {
            S[e] *= al;
#pragma unroll
            for (int ks = 0; ks < 2; ++ks) S[e] = mfma16(kf[ks], vB[e][ks], S[e]);
            *(LAS u32x2*)(nxt + (e * 16 + fr) * 136 + wv * 16 + fq * 4) = pk4(S[e]);
        }
        __syncthreads();
    }
}

__device__ void s5_scan(LAS unsigned char* ldsw, PPtr p, int layer, int b, int g, const int wid_s) {
    const int lane = fresh_tid(wid_s) & 63, fr = lane & 15, fq = lane >> 4;
    bf16_t* Z = (bf16_t*)(p->ws + WS_Z);
    const float* lam_re = p->in[14] + (size_t)(layer * 64 + g) * 64;
    const float* lam_im = p->in[15] + (size_t)(layer * 64 + g) * 64;
    const float dt = expf(p->in[16][layer * 64 + g]);
    const float* b_re = p->in[17] + (size_t)(layer * 64 + g) * 64 * 16;
    const float* b_im = p->in[18] + (size_t)(layer * 64 + g) * 64 * 16;
    const float* c_re = p->in[19] + (size_t)(layer * 64 + g) * 16 * 64;
    const float* c_im = p->in[20] + (size_t)(layer * 64 + g) * 16 * 64;
    const float dsk = p->in[21][layer * 1024 + g * 16 + fr];
    float ar, ai;
    { const float lr = fminf(lam_re[lane], -1e-4f), li = lam_im[lane]; const float mag = expf(lr * dt); ar = mag * cosf(li * dt); ai = mag * sinf(li * dt); }
    bf16x8 bB[8];
#pragma unroll
    for (int nt = 0; nt < 8; ++nt) {
        const int pp = (nt * 16 + fr) & 63;
        const float lr = fminf(lam_re[pp], -1e-4f), li = lam_im[pp]; const float mag = expf(lr * dt);
        const float a_r = mag * cosf(li * dt), a_i = mag * sinf(li * dt), nr = a_r - 1.f, den = lr * lr + li * li;
        const float zr = (nr * lr + a_i * li) / den, zi = (a_i * lr - nr * li) / den;
        float v[8];
#pragma unroll
        for (int j = 0; j < 8; ++j) {
            float val = 0.f;
            if (fq < 2) { const float br = b_re[pp * 16 + fq * 8 + j], bi = b_im[pp * 16 + fq * 8 + j]; val = (nt >= 4) ? (zr * bi + zi * br) : (zr * br - zi * bi); }
            v[j] = val;
        }
        u32x4 o; o.x = pk_bf16(v[0], v[1]); o.y = pk_bf16(v[2], v[3]); o.z = pk_bf16(v[4], v[5]); o.w = pk_bf16(v[6], v[7]);
        bB[nt] = __builtin_bit_cast(bf16x8, o);
    }
    bf16x8 cB[4];
#pragma unroll
    for (int ks = 0; ks < 4; ++ks) {
        const int kb = ks * 32 + fq * 8;
        float v[8];
#pragma unroll
        for (int j = 0; j < 8; ++j) v[j] = (ks < 2) ? c_re[fr * 64 + kb + j] : -c_im[fr * 64 + kb - 64 + j];
        u32x4 o; o.x = pk_bf16(v[0], v[1]); o.y = pk_bf16(v[2], v[3]); o.z = pk_bf16(v[4], v[5]); o.w = pk_bf16(v[6], v[7]);
        cB[ks] = __builtin_bit_cast(bf16x8, o);
    }
    LAS float* BU = (LAS float*)ldsw;
    LAS bf16_t* X = (LAS bf16_t*)(ldsw + 8192);
    float xr = 0.f, xi = 0.f;
#pragma unroll 1
    for (int tile = 0; tile < 256; ++tile) {
        const size_t row0 = (size_t)b * SEQ + tile * 16;
        u32x4 uraw = {0u, 0u, 0u, 0u};
        if (fq < 2) uraw = *(const u32x4*)(Z + (row0 + fr) * ZW + SU + g * 16 + fq * 8);
        const bf16x8 ua = __builtin_bit_cast(bf16x8, uraw);
#pragma unroll
        for (int nt = 0; nt < 8; ++nt) {
            f32x4 acc = {0.f, 0.f, 0.f, 0.f};
            acc = mfma16(ua, bB[nt], acc);
#pragma unroll
            for (int r = 0; r < 4; ++r) BU[(fq * 4 + r) * 128 + nt * 16 + fr] = acc[r];
        }
        asm volatile("s_waitcnt lgkmcnt(0)" ::: "memory");
#pragma unroll
        for (int tt = 0; tt < 16; ++tt) {
            const float bur = BU[tt * 128 + lane], bui = BU[tt * 128 + 64 + lane];
            const float nxr = ar * xr - ai * xi + bur, nxi = ar * xi + ai * xr + bui;
            xr = nxr; xi = nxi;
            X[tt * 136 + lane] = f2bf(xr); X[tt * 136 + 64 + lane] = f2bf(xi);
        }
        asm volatile("s_waitcnt lgkmcnt(0)" ::: "memory");
        f32x4 acc = {0.f, 0.f, 0.f, 0.f};
#pragma unroll
        for (int ks = 0; ks < 4; ++ks) { const bf16x8 xa = *(const LAS bf16x8*)(X + fr * 136 + ks * 32 + fq * 8); acc = mfma16(xa, cB[ks], acc); }
#pragma unroll
        for (int r = 0; r < 4; ++r) {
            bf16_t* zp = Z + (row0 + fq * 4 + r) * ZW + SU + g * 16 + fr;
            const float u = bf2f(*zp);
            *zp = f2bf(geluf_(acc[r] + dsk * u));
        }
        asm volatile("s_waitcnt lgkmcnt(0)" ::: "memory");
    }
}

template <int W> __device__ void head_norm_gate(bf16_t* O, const bf16_t* Zg  , const float* nw, const int wid_s) {
    constexpr int LPG = W / 8;
    const size_t ngroups = (size_t)MTOK * (1024 / W);
    const int t_ = fresh_tid(wid_s), lane_ = t_ & 63;
    const size_t gthreads = (size_t)fresh_gdim() * 512, gid = (size_t)fresh_bid() * 512 + t_;
    for (size_t idx = gid; idx < ngroups * LPG; idx += gthreads) {
        const size_t grp = idx / LPG; const int l = (int)(idx % LPG);
        const size_t row = grp / (1024 / W); const int hh = (int)(grp % (1024 / W));
        const int col = hh * W + l * 8;
        bf16_t* op = O + row * 1024 + col;
        const u32x4 w = *(const u32x4*)op;
        float v[8] = {lo_bf(w.x), hi_bf(w.x), lo_bf(w.y), hi_bf(w.y), lo_bf(w.z), hi_bf(w.z), lo_bf(w.w), hi_bf(w.w)};
        float ss = 0.f;
#pragma unroll
        for (int c = 0; c < 8; ++c) ss += v[c] * v[c];
#pragma unroll
        for (int o = 1; o < LPG; o <<= 1) ss += shx(ss, o, lane_);
        const float inv = rsqrtf(ss * (1.f / W) + EPS);
        const u32x4 gz = *(const u32x4*)(Zg + row * ZW + col);
        const float gzv[8] = {lo_bf(gz.x), hi_bf(gz.x), lo_bf(gz.y), hi_bf(gz.y), lo_bf(gz.z), hi_bf(gz.z), lo_bf(gz.w), hi_bf(gz.w)};
#pragma unroll
        for (int c = 0; c < 8; ++c) v[c] = v[c] * inv * nw[l * 8 + c] * siluf_(gzv[c]);
        u32x4 o; o.x = pk_bf16(v[0], v[1]); o.y = pk_bf16(v[2], v[3]); o.z = pk_bf16(v[4], v[5]); o.w = pk_bf16(v[6], v[7]);
        *(u32x4*)op = o;
    }
}

__device__ void xattn(LAS unsigned char* lds, const bf16_t* XQ, const bf16_t* Kb, const bf16_t* VTg, bf16_t* XO, const int wid_s) {
    const int t = fresh_tid(wid_s), wv = t >> 6, lane = t & 63, fr = lane & 15, fq = lane >> 4;
    LAS bf16_t* Pw = (LAS bf16_t*)(lds + wv * 8448);
    for (int item = fresh_bid(); item < 512; item += fresh_gdim()) {
        const int qt = item & 31, hd = (item >> 5) & 3, b = item >> 7;
        const size_t r0 = (size_t)b * SEQ + qt * 128 + wv * 16;
        bf16x8 qf[4];
#pragma unroll
        for (int ks = 0; ks < 4; ++ks) qf[ks] = *(const bf16x8*)(XQ + (r0 + fr) * 512 + hd * 128 + ks * 32 + fq * 8);
        f32x4 s[16];
#pragma unroll
        for (int nt = 0; nt < 16; ++nt) {
            f32x4 a = {0.f, 0.f, 0.f, 0.f};
#pragma unroll
            for (int ks = 0; ks < 4; ++ks) { const bf16x8 kfr = *(const bf16x8*)(Kb + ((size_t)b * 256 + nt * 16 + fr) * 512 + hd * 128 + ks * 32 + fq * 8); a = mfma16(qf[ks], kfr, a); }
            s[nt] = a * 0.08838834764831845f;
        }
        float mx[4], sm[4];
#pragma unroll
        for (int r = 0; r < 4; ++r) {
            float m = s[0][r];
#pragma unroll
            for (int nt = 1; nt < 16; ++nt) m = fmaxf(m, s[nt][r]);
            m = fmaxf(m, shx(m, 1, lane)); m = fmaxf(m, shx(m, 2, lane)); m = fmaxf(m, shx(m, 4, lane)); m = fmaxf(m, shx(m, 8, lane));
            mx[r] = m;
            float su = 0.f;
#pragma unroll
            for (int nt = 0; nt < 16; ++nt) { const float e = __expf(s[nt][r] - m); s[nt][r] = e; su += e; }
            su += shx(su, 1, lane); su += shx(su, 2, lane); su += shx(su, 4, lane); su += shx(su, 8, lane);
            sm[r] = 1.f / su;
        }
#pragma unroll
        for (int nt = 0; nt < 16; ++nt)
#pragma unroll
            for (int r = 0; r < 4; ++r) Pw[(fq * 4 + r) * 264 + nt * 16 + fr] = f2bf(s[nt][r] * sm[r]);
        __syncthreads();
        bf16x8 pf[8];
#pragma unroll
        for (int ks = 0; ks < 8; ++ks) pf[ks] = *(const LAS bf16x8*)(Pw + fr * 264 + ks * 32 + fq * 8);
#pragma unroll
        for (int dtile = 0; dtile < 8; ++dtile) {
            f32x4 o = {0.f, 0.f, 0.f, 0.f};
#pragma unroll
            for (int ks = 0; ks < 8; ++ks) { const bf16x8 vfr = *(const bf16x8*)(VTg + ((size_t)(b * 4 + hd) * 128 + dtile * 16 + fr) * 256 + ks * 32 + fq * 8); o = mfma16(pf[ks], vfr, o); }
#pragma unroll
            for (int r = 0; r < 4; ++r) XO[(r0 + fq * 4 + r) * 512 + hd * 128 + dtile * 16 + fr] = f2bf(o[r]);
        }
        __syncthreads();
    }
}

__device__ void ffn_act(const bf16_t* G, const bf16_t* U, const float* cw, bf16_t* ACT, const int wid_s) {
    const size_t nitems = (size_t)(FF / 8) * (MTOK / 16);
    const size_t gthreads = (size_t)fresh_gdim() * 512, gid = (size_t)fresh_bid() * 512 + fresh_tid(wid_s);
    for (size_t idx = gid; idx < nitems; idx += gthreads) {
        const int cg = (int)(idx % (FF / 8)); const int tb = (int)(idx / (FF / 8));
        const int c0 = cg * 8, t0 = tb * 16;
        float w0[8], w1[8], w2[8];
#pragma unroll
        for (int c = 0; c < 8; ++c) { w0[c] = cw[(c0 + c) * 3]; w1[c] = cw[(c0 + c) * 3 + 1]; w2[c] = cw[(c0 + c) * 3 + 2]; }
        float g2[8], g1[8];
        const bool start = (t0 & (SEQ - 1)) == 0;
        { u32x4 a = {0u, 0u, 0u, 0u}, bq = {0u, 0u, 0u, 0u};
          if (!start) { a = *(const u32x4*)(G + (size_t)(t0 - 2) * FF + c0); bq = *(const u32x4*)(G + (size_t)(t0 - 1) * FF + c0); }
          g2[0] = lo_bf(a.x); g2[1] = hi_bf(a.x); g2[2] = lo_bf(a.y); g2[3] = hi_bf(a.y); g2[4] = lo_bf(a.z); g2[5] = hi_bf(a.z); g2[6] = lo_bf(a.w); g2[7] = hi_bf(a.w);
          g1[0] = lo_bf(bq.x); g1[1] = hi_bf(bq.x); g1[2] = lo_bf(bq.y); g1[3] = hi_bf(bq.y); g1[4] = lo_bf(bq.z); g1[5] = hi_bf(bq.z); g1[6] = lo_bf(bq.w); g1[7] = hi_bf(bq.w); }
#pragma unroll 4
        for (int tt = 0; tt < 16; ++tt) {
            const u32x4 a = *(const u32x4*)(G + (size_t)(t0 + tt) * FF + c0);
            const u32x4 uq = *(const u32x4*)(U + (size_t)(t0 + tt) * FF + c0);
            const float g0[8] = {lo_bf(a.x), hi_bf(a.x), lo_bf(a.y), hi_bf(a.y), lo_bf(a.z), hi_bf(a.z), lo_bf(a.w), hi_bf(a.w)};
            const float uu[8] = {lo_bf(uq.x), hi_bf(uq.x), lo_bf(uq.y), hi_bf(uq.y), lo_bf(uq.z), hi_bf(uq.z), lo_bf(uq.w), hi_bf(uq.w)};
            float r[8];
#pragma unroll
            for (int c = 0; c < 8; ++c) { const float y = w0[c] * g2[c] + w1[c] * g1[c] + w2[c] * g0[c]; r[c] = geluf_(y) * uu[c]; g2[c] = g1[c]; g1[c] = g0[c]; }
            u32x4 o; o.x = pk_bf16(r[0], r[1]); o.y = pk_bf16(r[2], r[3]); o.z = pk_bf16(r[4], r[5]); o.w = pk_bf16(r[6], r[7]);
            *(u32x4*)(ACT + (size_t)(t0 + tt) * FF + c0) = o;
        }
    }
}

__device__ void convert_layer_small(LAS float* ldsf, PPtr p, int l, const int wid_s) {
    unsigned char* ws = p->ws;
    convert_w(ldsf, p->in[4] + (size_t)l * 2048 * 14368, (bf16_t*)(ws + WS_WA), 2048, 14368, ZN, 1, wid_s);
    convert_w(ldsf, p->in[9] + (size_t)l * 1024 * 2048, (bf16_t*)(ws + WS_WDN), 1024, 2048, 2048, 0, wid_s);
    convert_w(ldsf, p->in[13] + (size_t)l * 1024 * 2048, (bf16_t*)(ws + WS_WGLA), 1024, 2048, 2048, 0, wid_s);
    convert_w(ldsf, p->in[22] + (size_t)l * 1024 * 4096, (bf16_t*)(ws + WS_WGLU), 1024, 4096, 4096, 2, wid_s);
    convert_w(ldsf, p->in[23] + (size_t)l * 2048 * 2048, (bf16_t*)(ws + WS_WMIX), 2048, 2048, 2048, 0, wid_s);
    convert_w(ldsf, p->in[27] + (size_t)l * 2048 * 512, (bf16_t*)(ws + WS_WXQ), 2048, 512, 512, 0, wid_s);
    convert_w(ldsf, p->in[28] + (size_t)l * 2048 * 1024, (bf16_t*)(ws + WS_WXKV), 2048, 1024, 1024, 0, wid_s);
    convert_w(ldsf, p->in[29] + (size_t)l * 512 * 2048, (bf16_t*)(ws + WS_WXO), 512, 2048, 2048, 0, wid_s);
}
__device__ void convert_layer_ffn(LAS float* ldsf, PPtr p, int l, const int wid_s) {
    unsigned char* ws = p->ws;
    convert_w(ldsf, p->in[32] + (size_t)l * 2048 * 11264, (bf16_t*)(ws + WS_WA), 2048, 11264, 11264, 3, wid_s);
    convert_w(ldsf, p->in[34] + (size_t)l * 5632 * 2048, (bf16_t*)(ws + WS_WA + 46137344), 5632, 2048, 2048, 0, wid_s);
}


#ifdef DEBUG_NAN
__device__ __noinline__ void chk_f32(const float* q, size_t n, unsigned bit, unsigned* flag) {
    const size_t gthreads = (size_t)gridDim.x * 512, gid = (size_t)blockIdx.x * 512 + threadIdx.x; bool bad = false;
    for (size_t i = gid; i < n; i += gthreads) { const float v = q[i]; if (!(fabsf(v) < 1e30f)) bad = true; }
    if (bad) atomicOr(flag, 1u << bit);
}
__device__ __noinline__ void chk_bf16(const bf16_t* q, size_t n, unsigned bit, unsigned* flag) {
    const size_t gthreads = (size_t)gridDim.x * 512, gid = (size_t)blockIdx.x * 512 + threadIdx.x; bool bad = false;
    for (size_t i = gid; i < n; i += gthreads) { const float v = bf2f(q[i]); if (!(fabsf(v) < 1e30f)) bad = true; }
    if (bad) atomicOr(flag, 1u << bit);
}
#define CHKF(ptr, n, bit) do { if (l == DEBUG_NAN - 1) { chk_f32(ptr, n, bit, (unsigned*)(PP()->ws + WS_MISC + 32768)); } gsync(grid); } while (0)
#define CHKB(ptr, n, bit) do { if (l == DEBUG_NAN - 1) { chk_bf16(ptr, n, bit, (unsigned*)(PP()->ws + WS_MISC + 32768)); } gsync(grid); } while (0)
#else
#define CHKF(ptr, n, bit) do {} while (0)
#define CHKB(ptr, n, bit) do {} while (0)
#endif
#ifndef PMASK
#define PMASK 0xFFFFFFFFu
#endif
#define ON(k) ((PMASK >> (k)) & 1u)
constexpr size_t WS_LIMIT = 941621248;
static_assert(WS_END <= WS_LIMIT, "workspace map exceeds the guaranteed workspace size");
static_assert(WS_DNP + (size_t)MTOK * FF * 2 <= WS_MISC, "ACT does not fit");
static_assert((size_t)MTOK * FF * 2 * 2 <= SZ_Z, "G,U do not fit in Z");

#define m_ws (PP()->ws)
#define m_Z ((bf16_t*)(m_ws + WS_Z))
#define m_Y ((float*)(m_ws + WS_Z))
#define m_SMp ((float*)(m_ws + WS_SM))
#define m_H ((bf16_t*)(m_ws + WS_H))
#define m_OA m_H
#define m_OB (m_H + (size_t)MTOK * 1024)
#define m_MRG ((float*)(m_ws + WS_DNP))
#define m_XQ ((bf16_t*)(m_ws + WS_DNP))
#define m_XO ((bf16_t*)(m_ws + WS_DNP + (size_t)MTOK * 512 * 2))
#define m_ACT ((bf16_t*)(m_ws + WS_DNP))
#define m_MB ((bf16_t*)(m_ws + WS_GLP))
#define m_MEMN ((bf16_t*)(m_ws + WS_GLP))
#define m_KB ((bf16_t*)(m_ws + WS_GLP + 4194304))
#define m_VTG ((bf16_t*)(m_ws + WS_GLP + 5242880))
#define m_G ((bf16_t*)(m_ws + WS_Z))
#define m_U ((bf16_t*)(m_ws + WS_Z + (size_t)MTOK * FF * 2))
#define m_xs (PP()->out)
#define p PP()
__global__ void __launch_bounds__(512, 2) fwd_megakernel(Params p_unused) {
    extern __shared__ __attribute__((aligned(16))) unsigned char lds_raw[];
    LAS unsigned char* lds = (LAS unsigned char*)lds_raw;
    LAS float* ldsf = (LAS float*)lds_raw;
    cg::grid_group grid = cg::this_grid();
    if ((threadIdx.x & 63) == 0) ((LAS int*)(lds + 131072))[__builtin_amdgcn_s_getreg(10244) & 63] = (int)(threadIdx.x >> 6);
    __syncthreads();
    constexpr int wid_s = 0;
    if (ON(0)) convert_layer_small(ldsf, p, 0, wid_s);
    if (ON(1)) norm_rows(p->in[0], nullptr, nullptr, m_xs, p->in[2], m_H, MTOK, wid_s);
    gsync(grid);

#pragma unroll 1
    for (int l = 0; l < 2; ++l) {
        if (ON(2)) { EpiZ e; e.Z = m_Z; e.SMp = m_SMp; run_gemm(lds, m_H, DM, (const bf16_t*)(m_ws + WS_WA), MTOK, ZN, DM, e, wid_s); }
        gsync(grid);

#ifdef DEBUG_Z
        {
            unsigned long long* cw = (unsigned long long*)(PP()->ws + WS_MISC + 32768);
            const size_t gthreads = (size_t)gridDim.x * 512, gid = (size_t)blockIdx.x * 512 + threadIdx.x;
            const bf16_t* zz = m_Z; const bf16_t* wa = (const bf16_t*)(m_ws + WS_WA);
            unsigned long long c = 0, mi = ~0ull, cwa = 0;
            for (size_t i = gid; i < (size_t)MTOK * ZW; i += gthreads) { const float v = bf2f(zz[i]); if (!(fabsf(v) < 1e30f)) { ++c; if (i < mi) mi = i; } }
            for (size_t i = gid; i < (size_t)ZN * 2048; i += gthreads) { const float v = bf2f(wa[i]); if (!(fabsf(v) < 1e30f)) ++cwa; }
            if (c) { atomicAdd(cw, c); atomicMin(cw + 1, mi); }
            if (cwa) atomicAdd(cw + 2, cwa);
            gsync(grid);
            const unsigned long long C = cw[0], MI = cw[1], WB = cw[2];
            const int pnf = (int)((MI % ZW) / 256), pmf = (int)((MI / ZW) / 256);
            const int wb = WB == 0 ? 0 : (WB < 1000 ? 1 : 2), zb = C < 10000 ? 0 : (C < 10000000 ? 1 : 2);
            const float e1 = exp10f(10.f + (float)(pmf / 4));
            const float v1 = (10.f + pnf) * e1, v2 = (10.f + 10.f * (3 * wb + zb)) * e1 * 0.01f;
            float* o = PP()->out;
            for (size_t i = gid; i < (size_t)MTOK * DM; i += gthreads) o[i] = (i == 0) ? v1 : v2;
            return;
        }
#endif

        CHKB(m_H, (size_t)MTOK * DM, 0); CHKB(m_Z, (size_t)MTOK * ZW, 1); CHKF(m_SMp, (size_t)MTOK * 32, 2);
        if (ON(3)) dn_prep(lds, p, l, wid_s);
        if (ON(4)) gla_prep(lds, p, l, wid_s);
        if (ON(0)) convert_layer_ffn(ldsf, p, l, wid_s);
        gsync(grid);
        CHKB((const bf16_t*)(m_ws + WS_DNP), (size_t)DN_ITEM * 1024, 3); CHKB((const bf16_t*)(m_ws + WS_GLP), (size_t)GL_ITEM * 512, 4);
        for (int role = blockIdx.x; role < 256; role += gridDim.x) {
            if (role < 128) { if (ON(5)) dn_scan(lds, p, role >> 2, role & 3, wid_s); }
            else if (role < 192) { if (ON(6)) gla_scan(lds, p, (role - 128) >> 2, (role - 128) & 3, wid_s); }
            else { const int wv = fresh_tid(wid_s) >> 6; if (ON(7) && wv < 4) { const int pair = (role - 192) * 4 + wv; s5_scan(lds + wv * 12544, p, l, pair >> 6, pair & 63, wid_s); } }
            __syncthreads();
        }
        gsync(grid);
        CHKB(m_OA, (size_t)MTOK * 1024, 5); CHKB(m_OB, (size_t)MTOK * 1024, 6); CHKB(m_Z, (size_t)MTOK * ZW, 7);
        if (ON(8)) head_norm_gate<128>(m_OA, m_Z + ZZ, p->in[8] + l * 128, wid_s);
        if (ON(8)) head_norm_gate<256>(m_OB, m_Z + GR, p->in[12] + l * 256, wid_s);
        if (ON(9)) { EpiGLU e; e.Z = m_Z; e.MRG = m_MRG; run_gemm(lds, m_Z + SU, ZW, (const bf16_t*)(m_ws + WS_WGLU), MTOK, 4096, 1024, e, wid_s); }
        gsync(grid);
        CHKB(m_OA, (size_t)MTOK * 2048, 8); CHKF(m_MRG, (size_t)MTOK * DM, 9);
        if (ON(10)) { EpiAcc<false> e; e.Z = m_Z; e.MRG = m_MRG; e.MB = nullptr; e.goff = 0; run_gemm(lds, m_OA, 1024, (const bf16_t*)(m_ws + WS_WDN), MTOK, DM, 1024, e, wid_s); }
        if (ON(10)) { EpiAcc<true> e; e.Z = m_Z; e.MRG = m_MRG; e.MB = m_MB; e.goff = 2048; run_gemm(lds, m_OB, 1024, (const bf16_t*)(m_ws + WS_WGLA), MTOK, DM, 1024, e, wid_s); }
        gsync(grid);
        CHKB(m_MB, (size_t)MTOK * DM, 10);
        if (ON(11)) { EpiF32 e; e.C = m_Y; e.ldc = DM; run_gemm(lds, m_MB, DM, (const bf16_t*)(m_ws + WS_WMIX), MTOK, DM, DM, e, wid_s); }
        gsync(grid);
        CHKF(m_Y, (size_t)MTOK * DM, 11);
        if (ON(1)) norm_rows(m_xs, m_Y, p->in[3] + l * DM, m_xs, p->in[24] + l * DM, m_H, MTOK, wid_s);
        if (ON(1)) norm_rows(p->in[1], nullptr, nullptr, nullptr, p->in[26] + l * DM, m_MEMN, 1024, wid_s);
        gsync(grid);
        CHKF(m_xs, (size_t)MTOK * DM, 12); CHKB(m_H, (size_t)MTOK * DM, 13);
        if (ON(12)) { EpiBf16 e; e.C = m_XQ; e.ldc = 512; run_gemm(lds, m_H, DM, (const bf16_t*)(m_ws + WS_WXQ), MTOK, 512, DM, e, wid_s); }
        if (ON(13)) { EpiKV e; e.Kb = m_KB; e.VT = m_VTG; run_gemm(lds, m_MEMN, DM, (const bf16_t*)(m_ws + WS_WXKV), 1024, 1024, DM, e, wid_s, 128); }
        gsync(grid);
        CHKB(m_XQ, (size_t)MTOK * 512, 14); CHKB(m_KB, (size_t)1024 * 1024, 15);
        if (ON(14)) xattn(lds, m_XQ, m_KB, m_VTG, m_XO, wid_s);
        gsync(grid);
        CHKB(m_XO, (size_t)MTOK * 512, 16);
        if (ON(11)) { EpiF32 e; e.C = m_Y; e.ldc = DM; run_gemm(lds, m_XO, 512, (const bf16_t*)(m_ws + WS_WXO), MTOK, DM, 512, e, wid_s); }
        gsync(grid);
        CHKF(m_Y, (size_t)MTOK * DM, 17);
        if (ON(1)) norm_rows(m_xs, m_Y, p->in[25] + l * DM, m_xs, p->in[30] + l * DM, m_H, MTOK, wid_s);
        gsync(grid);
        CHKF(m_xs, (size_t)MTOK * DM, 18);
        if (ON(15)) { EpiFFN e; e.G = m_G; e.U = m_U; run_gemm(lds, m_H, DM, (const bf16_t*)(m_ws + WS_WA), MTOK, 2 * FF, DM, e, wid_s); }
        gsync(grid);
        CHKB(m_G, (size_t)MTOK * FF * 2, 19);
        if (ON(16)) ffn_act(m_G, m_U, p->in[33] + (size_t)l * FF * 3, m_ACT, wid_s);
        gsync(grid);
        CHKB(m_ACT, (size_t)MTOK * FF, 20);
        if (ON(11)) { EpiF32 e; e.C = m_Y; e.ldc = DM; run_gemm(lds, m_ACT, FF, (const bf16_t*)(m_ws + WS_WA + 46137344), MTOK, DM, FF, e, wid_s); }
        gsync(grid);
        CHKF(m_Y, (size_t)MTOK * DM, 21);
        if (l == 0) {
            if (ON(1)) norm_rows(m_xs, m_Y, p->in[31] + l * DM, m_xs, p->in[2] + DM, m_H, MTOK, wid_s);
            if (ON(0)) convert_layer_small(ldsf, p, 1, wid_s);
        } else {
            if (ON(1)) norm_rows(m_xs, m_Y, p->in[31] + l * DM, m_xs, nullptr, nullptr, MTOK, wid_s);
        }
        gsync(grid);
        }
#ifdef DEBUG_NAN
    { const unsigned f = *(volatile unsigned*)(PP()->ws + WS_MISC + 32768); int idx = -1; for (int k = 0; k < 32; ++k) if ((f >> k) & 1u) { idx = k; break; }
      bool finalbad = false; const size_t gthreads = (size_t)gridDim.x * 512, gid = (size_t)blockIdx.x * 512 + threadIdx.x;
      const float val = idx < 0 ? 16.f : exp2f(5.f + idx);
      float* o = PP()->out;
      for (size_t i = gid; i < (size_t)MTOK * DM; i += gthreads) { if (idx >= 0) o[i] = val; else { const float v = o[i]; if (!(fabsf(v) < 1e30f)) o[i] = 16.f; } } }
#endif
}

#undef m_ws
#undef m_Z
#undef m_Y
#undef m_SMp
#undef m_H
#undef m_OA
#undef m_OB
#undef m_MRG
#undef m_XQ
#undef m_XO
#undef m_ACT
#undef m_MB
#undef m_MEMN
#undef m_KB
#undef m_VTG
#undef m_G
#undef m_U
#undef m_xs
#undef p
extern "C" void kernel_launch(void* const* d_in, const int* in_sizes, int n_in,
                              void* d_out, int out_size, void* d_ws, size_t ws_size,
                              hipStream_t stream) {
    static int grid_blocks = 0;
    constexpr int kDynLds = 131072 + 256;
    if (!grid_blocks) {
        int dev = 0, cus = 0, per_cu = 0;
        (void)hipGetDevice(&dev);
        (void)hipDeviceGetAttribute(&cus, hipDeviceAttributeMultiprocessorCount, dev);
        if (hipFuncSetAttribute((const void*)fwd_megakernel, hipFuncAttributeMaxDynamicSharedMemorySize, kDynLds) != hipSuccess) fprintf(stderr, "hipFuncSetAttribute failed\n");
        if (hipOccupancyMaxActiveBlocksPerMultiprocessor(&per_cu, (const void*)fwd_megakernel, 512, kDynLds) != hipSuccess || per_cu < 1) { fprintf(stderr, "occupancy query: %d\n", per_cu); per_cu = 1; }
        (void)hipGetLastError();
        grid_blocks = cus;
        if (n_in != 35 || ws_size < WS_END) fprintf(stderr, "kernel_launch: unexpected n_in %d or ws_size %zu (< %zu)\n", n_in, ws_size, (size_t)WS_END);
    }
    Params hp{};
    for (int i = 0; i < 35; ++i) hp.in[i] = (const float*)d_in[i];
    hp.out = (float*)d_out; hp.ws = (unsigned char*)d_ws;
    void* args[] = {&hp};
    hipError_t e = hipLaunchCooperativeKernel((const void*)fwd_megakernel, dim3(grid_blocks), dim3(512), args, kDynLds, stream);
    if (e != hipSuccess) fprintf(stderr, "cooperative launch failed: %s (grid %d)\n", hipGetErrorString(e), grid_blocks);
}
```

```cpp
#include <hip/hip_runtime.h>
#include <hip/hip_cooperative_groups.h>
#include <cstdio>
#include <type_traits>
namespace cg = cooperative_groups;

#define LAS __attribute__((address_space(3)))
typedef unsigned short bf16_t;
typedef short bf16x8 __attribute__((ext_vector_type(8)));
typedef float f32x4 __attribute__((ext_vector_type(4)));
typedef unsigned u32x2 __attribute__((ext_vector_type(2)));
typedef unsigned u32x4 __attribute__((ext_vector_type(4)));

constexpr int MTOK = 16384, DM = 2048, SEQ = 4096, NB = 4;
constexpr int ZW = 14336;
constexpr int ZN = 14592;
constexpr int ZQ = 0, ZK = 1024, ZV = 2048, ZZ = 3072, GQ = 4096, GK = 4608, GV = 5120, GR = 6144, SU = 7168, GT = 8192;
constexpr int FF = 5632;
constexpr float EPS = 1e-6f;

constexpr size_t WS_WA   = 0;
constexpr size_t SZ_WA   = 69206016;
constexpr size_t WS_WDN  = WS_WA + SZ_WA;
constexpr size_t WS_WGLA = WS_WDN + 4194304;
constexpr size_t WS_WGLU = WS_WGLA + 4194304;
constexpr size_t WS_WMIX = WS_WGLU + 8388608;
constexpr size_t WS_WXQ  = WS_WMIX + 8388608;
constexpr size_t WS_WXKV = WS_WXQ + 2097152;
constexpr size_t WS_WXO  = WS_WXKV + 4194304;
constexpr size_t WS_Z    = WS_WXO + 2097152;
constexpr size_t SZ_Z    = (size_t)MTOK * ZW * 2;
constexpr size_t WS_SM   = WS_Z + SZ_Z;
constexpr size_t WS_H    = WS_SM + (size_t)MTOK * 32 * 4;
constexpr size_t WS_DNP  = WS_H + (size_t)MTOK * DM * 2;
constexpr size_t DN_ITEM = 73728;
constexpr size_t WS_GLP  = WS_DNP + DN_ITEM * 2048;
constexpr size_t GL_ITEM = 74240;
constexpr size_t WS_MISC = WS_GLP + GL_ITEM * 1024;
constexpr size_t WS_BAR  = WS_MISC + 16384;
constexpr size_t WS_END  = WS_MISC + 65536;

struct Params { const float* in[35]; float* out; unsigned char* ws; };
typedef const __attribute__((address_space(4))) Params* PPtr;
__device__ __forceinline__ int fresh_tid(int) {
    int hw = __builtin_amdgcn_s_getreg(10244) & 63; asm volatile("" : "+s"(hw));
    const int w = __builtin_amdgcn_readfirstlane(*(const volatile LAS int*)((LAS unsigned char*)nullptr + 131072 + hw * 4));
    const int ln = __builtin_amdgcn_mbcnt_hi(~0u, __builtin_amdgcn_mbcnt_lo(~0u, 0u)); int t = w * 64 + ln; asm volatile("" : "+v"(t)); return t; }
__device__ __forceinline__ int fresh_bid() { int b = blockIdx.x; asm volatile("" : "+s"(b)); return b; }
__device__ __forceinline__ int fresh_gdim() { int b = gridDim.x; asm volatile("" : "+s"(b)); return b; }
__device__ __forceinline__ PPtr PP() { auto kp = __builtin_amdgcn_kernarg_segment_ptr(); asm volatile("" : "+s"(kp)); return (PPtr)kp; }

__device__ __forceinline__ float bf2f(bf16_t v) { return __uint_as_float(((unsigned)v) << 16); }
typedef float f32x2_t __attribute__((ext_vector_type(2)));
typedef __bf16 bf16x2_t __attribute__((ext_vector_type(2)));
__device__ __forceinline__ unsigned pk_bf16(float lo, float hi) { const f32x2_t v = {lo, hi}; const bf16x2_t b = __builtin_convertvector(v, bf16x2_t); return __builtin_bit_cast(unsigned, b); }
__device__ __forceinline__ bf16_t f2bf(float f) { return (bf16_t)(pk_bf16(f, 0.f) & 0xffffu); }
__device__ __forceinline__ float sigmoidf_(float x) { return 1.f / (1.f + __expf(-x)); }
__device__ __forceinline__ float siluf_(float x) { return x * sigmoidf_(x); }
__device__ __forceinline__ float geluf_(float x) { const float u = 1.5957691216057308f * (x + 0.044715f * x * x * x); return x * sigmoidf_(u); }
__device__ __forceinline__ float softplusf_(float x) { return x > 20.f ? x : log1pf(__expf(x)); }
__device__ __forceinline__ float shx(float v, int mask, int lane) { return __int_as_float(__builtin_amdgcn_ds_bpermute((lane ^ mask) << 2, __float_as_int(v))); }
__device__ __forceinline__ float shup(float v, int delta, int lane) { return __int_as_float(__builtin_amdgcn_ds_bpermute((lane - delta) << 2, __float_as_int(v))); }
__device__ __forceinline__ float lo_bf(unsigned w) { return __uint_as_float(w << 16); }
__device__ __forceinline__ float hi_bf(unsigned w) { return __uint_as_float(w & 0xffff0000u); }
__device__ __forceinline__ f32x4 mfma16(bf16x8 a, bf16x8 b, f32x4 c) { return __builtin_amdgcn_mfma_f32_16x16x32_bf16(a, b, c, 0, 0, 0); }

__device__ __forceinline__ void gsync(cg::grid_group& grid) {
    __builtin_amdgcn_fence(__ATOMIC_RELEASE, "agent");
    asm volatile("s_waitcnt vmcnt(0) lgkmcnt(0)" ::: "memory");
    grid.sync();
    __builtin_amdgcn_fence(__ATOMIC_ACQUIRE, "agent");
    asm volatile("s_waitcnt vmcnt(0)" ::: "memory");
#ifdef EXTRA_SYNC
    __builtin_amdgcn_fence(__ATOMIC_RELEASE, "agent");
    asm volatile("s_waitcnt vmcnt(0) lgkmcnt(0)" ::: "memory");
    grid.sync();
    __builtin_amdgcn_fence(__ATOMIC_ACQUIRE, "agent");
    asm volatile("s_waitcnt vmcnt(0)" ::: "memory");
#endif
}


#define XB_TMO      128
#define XB_XCNT(j)  (256  + 64 * (j))
#define XB_XSUB(j)  (1280 + 64 * (j))
#define XB_XGEN(j)  (2304 + 64 * (j))
#define XB_TOP      3328
#define XB_TOPGEN   3392
#define XCD_BAR_WORDS 3456
#define XB_SPIN_CAP (1u << 20)
constexpr int XB_LDS_OFF = 131072 + 256;
__device__ __forceinline__ unsigned xb_ld(unsigned* p)              { return __hip_atomic_load(p, __ATOMIC_RELAXED, __HIP_MEMORY_SCOPE_AGENT); }
__device__ __forceinline__ unsigned xb_add(unsigned* p, unsigned v) { return __hip_atomic_fetch_add(p, v, __ATOMIC_RELAXED, __HIP_MEMORY_SCOPE_AGENT); }
__device__ __forceinline__ unsigned xb_xcc_id() { return (unsigned)__builtin_amdgcn_s_getreg((3 << 11) | 20) & 0xFu; }
#define XB_SPIN(cond, bar) do { unsigned _sp = 0; while (cond) { __builtin_amdgcn_s_sleep(1); \
    if ((++_sp & 255u) == 0u) { if (xb_ld(&(bar)[XB_TMO])) break; if (_sp > XB_SPIN_CAP) { atomicAdd(&(bar)[XB_TMO], 1u); break; } } } } while (0)
__device__ __forceinline__ void xcd_barrier_complete(unsigned* bar, unsigned x, unsigned& nloc, unsigned& nx) {
    const unsigned G = gridDim.x;
    unsigned sum, cnt, mine, sp = 0u;
    for (;;) {
        sum = 0u; cnt = 0u; mine = 0u;
#pragma unroll
        for (unsigned j = 0; j < 16; ++j) { const unsigned c = xb_ld(&bar[XB_XCNT(j)]); sum += c; cnt += (c > 0u) ? 1u : 0u; mine = (j == x) ? c : mine; }
        if (sum == G) break;
        __builtin_amdgcn_s_sleep(1);
        if ((++sp & 255u) == 0u) { if (xb_ld(&bar[XB_TMO])) break; if (sp > XB_SPIN_CAP) { atomicAdd(&bar[XB_TMO], 1u); break; } }
    }
    nloc = mine > 0u ? mine : 1u; nx = cnt > 0u ? cnt : 1u;
}
__device__ __forceinline__ void xbar(const int wid_s) {
    asm volatile("s_waitcnt vmcnt(0)" ::: "memory");
    __syncthreads();
    unsigned* bar = (unsigned*)(PP()->ws + WS_BAR);
    if (fresh_tid(wid_s) == 0) {
        volatile LAS unsigned* st = (volatile LAS unsigned*)((LAS unsigned char*)nullptr + XB_LDS_OFF);
        const unsigned x = xb_xcc_id();
        __builtin_amdgcn_s_waitcnt(0);
        unsigned nloc = st[0], nx = st[1];
        if (nloc == 0u) { xcd_barrier_complete(bar, x, nloc, nx); st[0] = nloc; st[1] = nx; }
        const unsigned old = xb_add(&bar[XB_XSUB(x)], 1u);
        const unsigned gen = old / nloc;
        if (old + 1u == (gen + 1u) * nloc) {
            __builtin_amdgcn_fence(__ATOMIC_RELEASE, "agent");
            asm volatile("s_waitcnt vmcnt(0)" ::: "memory");
            const unsigned og = xb_add(&bar[XB_TOP], 1u);
            const unsigned tg = og / nx;
            if (og + 1u == (tg + 1u) * nx) xb_add(&bar[XB_TOPGEN], 1u);
            else XB_SPIN(xb_ld(&bar[XB_TOPGEN]) == tg, bar);
            __builtin_amdgcn_fence(__ATOMIC_ACQUIRE, "agent");
            xb_add(&bar[XB_XGEN(x)], 1u);
            asm volatile("s_waitcnt vmcnt(0)" ::: "memory");
        } else {
            XB_SPIN(xb_ld(&bar[XB_XGEN(x)]) == gen, bar);
            __builtin_amdgcn_fence(__ATOMIC_ACQUIRE, "agent");
            asm volatile("s_waitcnt vmcnt(0)" ::: "memory");
        }
    }
    __syncthreads();
}

constexpr int BM = 256, BK = 64, HALF = 128, HTB = HALF * BK * 2, STAGE_BYTES = 8 * HTB, NXCD = 8, WGM = 8;
__device__ __forceinline__ int lds_byte(int r, int c) { const int st = (r >> 4) * 2 + (c >> 5), rr = r & 15, cc = c & 31, ob = rr * 64 + cc * 2; return st * 1024 + (ob ^ (((ob >> 9) & 1) << 5)); }
__device__ __forceinline__ void stage_rc(int b, int& R, int& C) { const int st = b / 1024, sb = b % 1024, swz = sb ^ (((sb >> 9) & 1) << 5); R = (st >> 1) * 16 + swz / 64; C = (st & 1) * 32 + (swz % 64) / 2; }
struct Unit { int pm, pn; };
struct Gemm { const bf16_t* A; const bf16_t* Bt; int M, N, K, lda; };
struct StaticOrder {
    int nM, nN, nwg, G, c;
    __device__ void init(int M, int N, int G_, int c_) { nM = M / BM; nN = N / BM; nwg = nM * nN; G = G_; c = c_; }
    __device__ bool next(int i, Unit& u) const {
        const long L = (long)i * G + c; if (L >= nwg) return false;
        int wgid = (int)L; { const int q = nwg / NXCD, r = nwg % NXCD, xcd = wgid % NXCD, off = wgid / NXCD; wgid = (xcd < r ? xcd * (q + 1) : r * (q + 1) + (xcd - r) * q) + off; }
        const int nig = WGM * nN, gid = wgid / nig, fm = gid * WGM, gsz = (nM - fm) < WGM ? (nM - fm) : WGM;
        u.pm = fm + ((wgid % nig) % gsz); u.pn = (wgid % nig) / gsz; return true;
    }
};

template <class Epi>
__device__ __forceinline__ void gemm_phase(LAS unsigned char* lds, const Gemm g, const StaticOrder& S, const Epi& E, const int wid_s) {
    const int tid = fresh_tid(wid_s), wid = __builtin_amdgcn_readfirstlane(tid >> 6), lane = tid & 63, wr = wid >> 2, wc = wid & 3, fr = lane & 15, fq = lane >> 4;
    const int K = g.K, nt = K / BK, lda = g.lda;
    unsigned voffA[2], voffB[2];
#pragma unroll
    for (int i = 0; i < 2; ++i) { int R, C; stage_rc(tid * 16 + i * 8192, R, C); voffA[i] = (unsigned)(R * lda + C) * 2u; voffB[i] = (unsigned)(R * K + C) * 2u; }
    const size_t kstep = (size_t)(BK * 2);
    const size_t hstepA = (size_t)HALF * lda * 2, hstepB = (size_t)HALF * K * 2;
    const size_t tstepA = 2 * hstepA, tstepB = 2 * hstepB;
    const unsigned ldsw = (unsigned)wid * 1024u;
    const int aoff = lds_byte(wr * 64 + fr, fq * 8), boff = lds_byte(wc * 32 + fr, fq * 8);
#define PG8_SA(b, h) (((b) * 2 + (h)) * HTB)
#define PG8_SB(b, h) ((4 + (b) * 2 + (h)) * HTB)
#define PG8_STAGE(bufoff, gbase, voff) do { _Pragma("unroll") for (int _i = 0; _i < 2; ++_i) \
        __builtin_amdgcn_global_load_lds((const unsigned*)((const char*)(gbase) + (voff)[_i]), (LAS unsigned*)(lds + (bufoff) + ldsw + _i * 8192), 16, 0, 0); } while (0)
#define PG8_LDA(dst, b, h) do { _Pragma("unroll") for (int m = 0; m < 4; ++m) _Pragma("unroll") for (int k = 0; k < 2; ++k) dst[m][k] = *(const LAS bf16x8*)(lds + PG8_SA(b, h) + aoff + m * 2048 + k * 1024); } while (0)
#define PG8_LDB(dst, b, h) do { _Pragma("unroll") for (int n = 0; n < 2; ++n) _Pragma("unroll") for (int k = 0; k < 2; ++k) dst[n][k] = *(const LAS bf16x8*)(lds + PG8_SB(b, h) + boff + n * 2048 + k * 1024); } while (0)
#define PG8_MMA(ai, bj, At, Bt) do { __builtin_amdgcn_s_setprio(1); _Pragma("unroll") for (int m = 0; m < 4; ++m) _Pragma("unroll") for (int n = 0; n < 2; ++n) _Pragma("unroll") for (int k = 0; k < 2; ++k) \
        acc[ai][bj][m][n] = __builtin_amdgcn_mfma_f32_16x16x32_bf16(Bt[n][k], At[m][k], acc[ai][bj][m][n], 0, 0, 0); __builtin_amdgcn_s_setprio(0); } while (0)
#define PG8_WAIT_V(n) asm volatile("s_waitcnt vmcnt(" #n ")" ::: "memory")
#define PG8_WAIT_L(n) asm volatile("s_waitcnt lgkmcnt(" #n ")" ::: "memory")
#define PG8_BAR __builtin_amdgcn_s_barrier()
#define PG8_SCHED __builtin_amdgcn_sched_barrier(0)
    Unit cur, nxt; int ui = 0;
    if (!S.next(0, cur)) return;
    f32x4 acc[2][2][4][2];
#pragma unroll
    for (int a = 0; a < 2; ++a)
#pragma unroll
        for (int b = 0; b < 2; ++b)
#pragma unroll
            for (int m = 0; m < 4; ++m)
#pragma unroll
                for (int n = 0; n < 2; ++n) acc[a][b][m][n] = (f32x4){0.f, 0.f, 0.f, 0.f};
    bf16x8 At[4][2], B0[2][2], B1[2][2];
    const char* cA = (const char*)g.A + (size_t)cur.pm * tstepA; const char* cB = (const char*)g.Bt + (size_t)cur.pn * tstepB;
    PG8_STAGE(PG8_SB(0, 0), cB, voffB); PG8_STAGE(PG8_SA(0, 0), cA, voffA); PG8_STAGE(PG8_SB(0, 1), cB + hstepB, voffB); PG8_STAGE(PG8_SA(0, 1), cA + hstepA, voffA);
    if (wr == 1) PG8_BAR;
    PG8_WAIT_V(4); PG8_BAR;
    PG8_STAGE(PG8_SB(1, 0), cB + kstep, voffB); PG8_STAGE(PG8_SA(1, 0), cA + kstep, voffA); PG8_STAGE(PG8_SB(1, 1), cB + hstepB + kstep, voffB);
    PG8_WAIT_V(6); PG8_BAR;
    for (;;) {
        const bool has_next = S.next(ui + 1, nxt);
        const char* nA = has_next ? (const char*)g.A + (size_t)nxt.pm * tstepA : cA; const char* nB = has_next ? (const char*)g.Bt + (size_t)nxt.pn * tstepB : cB;
        for (int t = 0; t < nt; t += 2) {
            const bool last = (t == nt - 2);
            const char* a1 = cA + (size_t)(t + 1) * kstep;
            const char* a2 = last ? nA : cA + (size_t)(t + 2) * kstep; const char* b2 = last ? nB : cB + (size_t)(t + 2) * kstep;
            const char* a3 = a2 + kstep; const char* b3 = b2 + kstep;
            PG8_LDB(B0, 0, 0); PG8_SCHED; PG8_LDA(At, 0, 0); PG8_STAGE(PG8_SA(1, 1), a1 + hstepA, voffA);
            PG8_WAIT_L(8); PG8_BAR; PG8_WAIT_L(0); PG8_MMA(0, 0, At, B0); PG8_BAR; PG8_SCHED;
            PG8_LDB(B1, 0, 1); PG8_STAGE(PG8_SB(0, 0), b2, voffB);
            PG8_BAR; PG8_WAIT_L(0); PG8_MMA(0, 1, At, B1); PG8_BAR;
            PG8_LDA(At, 0, 1); PG8_STAGE(PG8_SA(0, 0), a2, voffA);
            PG8_BAR; PG8_WAIT_L(0); PG8_MMA(1, 0, At, B0); PG8_BAR; PG8_SCHED;
            PG8_STAGE(PG8_SB(0, 1), b2 + hstepB, voffB);
            PG8_WAIT_V(6); PG8_BAR; PG8_MMA(1, 1, At, B1); PG8_BAR;
            PG8_LDB(B0, 1, 0); PG8_SCHED; PG8_LDA(At, 1, 0); PG8_STAGE(PG8_SA(0, 1), a2 + hstepA, voffA);
            PG8_WAIT_L(8); PG8_BAR; PG8_WAIT_L(0); PG8_MMA(0, 0, At, B0); PG8_BAR; PG8_SCHED;
            PG8_LDB(B1, 1, 1); PG8_STAGE(PG8_SB(1, 0), b3, voffB);
            PG8_BAR; PG8_WAIT_L(0); PG8_MMA(0, 1, At, B1); PG8_BAR;
            PG8_LDA(At, 1, 1); PG8_STAGE(PG8_SA(1, 0), a3, voffA);
            PG8_BAR; PG8_WAIT_L(0); PG8_MMA(1, 0, At, B0); PG8_BAR; PG8_SCHED;
            PG8_STAGE(PG8_SB(1, 1), b3 + hstepB, voffB);
            PG8_WAIT_V(6); PG8_BAR; PG8_MMA(1, 1, At, B1); PG8_BAR;
        }
        E(acc, cur, wr, wc, fr, fq);
        if (!has_next) break;
#pragma unroll
        for (int a = 0; a < 2; ++a)
#pragma unroll
            for (int b = 0; b < 2; ++b)
#pragma unroll
                for (int m = 0; m < 4; ++m)
#pragma unroll
                    for (int n = 0; n < 2; ++n) acc[a][b][m][n] = (f32x4){0.f, 0.f, 0.f, 0.f};
        cur = nxt; cA = nA; cB = nB; ++ui;
    }
    PG8_WAIT_V(0);
    if (wr == 0) PG8_BAR;
    PG8_BAR;
#undef PG8_SA
#undef PG8_SB
#undef PG8_STAGE
#undef PG8_LDA
#undef PG8_LDB
#undef PG8_MMA
#undef PG8_WAIT_V
#undef PG8_WAIT_L
#undef PG8_BAR
#undef PG8_SCHED
}

typedef const f32x4 (&AccRef)[2][2][4][2];
__device__ __forceinline__ u32x2 pk4(f32x4 v) { u32x2 r; r.x = pk_bf16(v[0], v[1]); r.y = pk_bf16(v[2], v[3]); return r; }
__device__ __forceinline__ f32x4 ld_bf4(const bf16_t* p) { const u32x2 w = *(const u32x2*)p; return (f32x4){lo_bf(w.x), hi_bf(w.x), lo_bf(w.y), hi_bf(w.y)}; }
__device__ __forceinline__ f32x4 sig4(f32x4 v) { return (f32x4){sigmoidf_(v[0]), sigmoidf_(v[1]), sigmoidf_(v[2]), sigmoidf_(v[3])}; }

struct EpiZ { bf16_t* Z; float* SMp;
    __device__ __forceinline__ void operator()(AccRef acc, const Unit& u, int wr, int wc, int fr, int fq) const {
        const int row0 = u.pm * BM + wr * 64 + fr;
        if (u.pn < 56) {
#pragma unroll
            for (int ai = 0; ai < 2; ++ai)
#pragma unroll
                for (int m = 0; m < 4; ++m) { bf16_t* rp = Z + (size_t)(row0 + ai * HALF + m * 16) * ZW + u.pn * BM + wc * 32 + 4 * fq;
#pragma unroll
                    for (int bj = 0; bj < 2; ++bj)
#pragma unroll
                        for (int n = 0; n < 2; ++n) *(u32x2*)(rp + bj * HALF + n * 16) = pk4(acc[ai][bj][m][n]); }
        } else if (wc == 0) {
#pragma unroll
            for (int ai = 0; ai < 2; ++ai)
#pragma unroll
                for (int m = 0; m < 4; ++m) { float* rp = SMp + (size_t)(row0 + ai * HALF + m * 16) * 32 + 4 * fq;
#pragma unroll
                    for (int n = 0; n < 2; ++n) *(f32x4*)(rp + n * 16) = acc[ai][0][m][n]; }
        }
    }
};
struct EpiF32 { float* C; int ldc;
    __device__ __forceinline__ void operator()(AccRef acc, const Unit& u, int wr, int wc, int fr, int fq) const {
        const int row0 = u.pm * BM + wr * 64 + fr, col0 = u.pn * BM + wc * 32 + 4 * fq;
#pragma unroll
        for (int ai = 0; ai < 2; ++ai)
#pragma unroll
            for (int m = 0; m < 4; ++m) { float* rp = C + (size_t)(row0 + ai * HALF + m * 16) * ldc + col0;
#pragma unroll
                for (int bj = 0; bj < 2; ++bj)
#pragma unroll
                    for (int n = 0; n < 2; ++n) *(f32x4*)(rp + bj * HALF + n * 16) = acc[ai][bj][m][n]; }
    }
};
struct EpiBf16 { bf16_t* C; int ldc;
    __device__ __forceinline__ void operator()(AccRef acc, const Unit& u, int wr, int wc, int fr, int fq) const {
        const int row0 = u.pm * BM + wr * 64 + fr, col0 = u.pn * BM + wc * 32 + 4 * fq;
#pragma unroll
        for (int ai = 0; ai < 2; ++ai)
#pragma unroll
            for (int m = 0; m < 4; ++m) { bf16_t* rp = C + (size_t)(row0 + ai * HALF + m * 16) * ldc + col0;
#pragma unroll
                for (int bj = 0; bj < 2; ++bj)
#pragma unroll
                    for (int n = 0; n < 2; ++n) *(u32x2*)(rp + bj * HALF + n * 16) = pk4(acc[ai][bj][m][n]); }
    }
};
struct EpiGLU { const bf16_t* Z; float* MRG;
    __device__ __forceinline__ void operator()(AccRef acc, const Unit& u, int wr, int wc, int fr, int fq) const {
        const int row0 = u.pm * BM + wr * 64 + fr;
#pragma unroll
        for (int ai = 0; ai < 2; ++ai)
#pragma unroll
            for (int m = 0; m < 4; ++m) { const int row = row0 + ai * HALF + m * 16;
#pragma unroll
                for (int bj = 0; bj < 2; ++bj) { const int oc = (u.pn * BM + bj * HALF + wc * 32) / 2 + 4 * fq;
                    const f32x4 gt = sig4(ld_bf4(Z + (size_t)row * ZW + GT + 4096 + oc));
                    const f32x4 a = acc[ai][bj][m][0], b = sig4(acc[ai][bj][m][1]);
                    *(f32x4*)(MRG + (size_t)row * DM + oc) = gt * a * b; } }
    }
};
template <bool FINAL> struct EpiAcc { const bf16_t* Z; float* MRG; bf16_t* MB; int goff;
    __device__ __forceinline__ void operator()(AccRef acc, const Unit& u, int wr, int wc, int fr, int fq) const {
        const int row0 = u.pm * BM + wr * 64 + fr, col0 = u.pn * BM + wc * 32 + 4 * fq;
#pragma unroll
        for (int ai = 0; ai < 2; ++ai)
#pragma unroll
            for (int m = 0; m < 4; ++m) { const int row = row0 + ai * HALF + m * 16;
#pragma unroll
                for (int bj = 0; bj < 2; ++bj)
#pragma unroll
                    for (int n = 0; n < 2; ++n) { const int c = col0 + bj * HALF + n * 16;
                        const f32x4 gt = sig4(ld_bf4(Z + (size_t)row * ZW + GT + goff + c));
                        const f32x4 v = *(const f32x4*)(MRG + (size_t)row * DM + c) + gt * acc[ai][bj][m][n];
                        if (FINAL) *(u32x2*)(MB + (size_t)row * DM + c) = pk4(v); else *(f32x4*)(MRG + (size_t)row * DM + c) = v; } }
    }
};
struct EpiKV { bf16_t* Kb; bf16_t* VT;
    __device__ __forceinline__ void operator()(AccRef acc, const Unit& u, int wr, int wc, int fr, int fq) const {
        const int row0 = u.pm * BM + wr * 64 + fr, col0 = u.pn * BM + wc * 32 + 4 * fq;
#pragma unroll
        for (int ai = 0; ai < 2; ++ai)
#pragma unroll
            for (int m = 0; m < 4; ++m) { const int row = row0 + ai * HALF + m * 16;
#pragma unroll
                for (int bj = 0; bj < 2; ++bj)
#pragma unroll
                    for (int n = 0; n < 2; ++n) { const int c = col0 + bj * HALF + n * 16; const f32x4 v = acc[ai][bj][m][n];
                        if (c < 512) *(u32x2*)(Kb + (size_t)row * 512 + c) = pk4(v);
                        else { const int cc = c - 512, b = row >> 8, key = row & 255;
#pragma unroll
                            for (int i = 0; i < 4; ++i) VT[((size_t)(b * 4 + ((cc + i) >> 7)) * 128 + ((cc + i) & 127)) * 256 + key] = f2bf(v[i]); } } }
    }
};
struct EpiFFN { bf16_t* G; bf16_t* U;
    __device__ __forceinline__ void operator()(AccRef acc, const Unit& u, int wr, int wc, int fr, int fq) const {
        const int row0 = u.pm * BM + wr * 64 + fr;
#pragma unroll
        for (int ai = 0; ai < 2; ++ai)
#pragma unroll
            for (int m = 0; m < 4; ++m) { const int row = row0 + ai * HALF + m * 16;
#pragma unroll
                for (int bj = 0; bj < 2; ++bj) { const int oc = (u.pn * BM + bj * HALF + wc * 32) / 2 + 4 * fq;
                    *(u32x2*)(G + (size_t)row * FF + oc) = pk4(acc[ai][bj][m][0]);
                    *(u32x2*)(U + (size_t)row * FF + oc) = pk4(acc[ai][bj][m][1]); } }
    }
};

template <class Epi> __device__ __forceinline__ void run_gemm(LAS unsigned char* lds, const bf16_t* A, int lda, const bf16_t* Bt, int M, int N, int K, const Epi& E, const int wid_s, int shift = 0) {
    Gemm g; g.A = A; g.Bt = Bt; g.M = M; g.N = N; g.K = K; g.lda = lda;
    StaticOrder S; S.init(M, N, (int)fresh_gdim(), (int)((fresh_bid() + fresh_gdim() - shift) % fresh_gdim()));
    gemm_phase<Epi>(lds, g, S, E, wid_s);
}

__device__ __forceinline__ int src_col(int kind, int n) {
    if (kind == 0) return n;
    if (kind == 1) {
        if (n < 4096) return n;
        if (n < 6144) return n + 16;
        if (n < 14336) return n + 32;
        if (n < 14352) return n - 14336 + 4096;
        if (n < 14368) return n - 14352 + 6160;
        return -1;
    }
    const int g = n >> 5, r = n & 31, half = (kind == 2) ? 2048 : FF;
    return r < 16 ? g * 16 + r : half + g * 16 + (r - 16);
}
__device__ void convert_w(LAS float* ldsf, const float* __restrict__ W, bf16_t* __restrict__ Wt, int K, int Nsrc, int Ndst, int kind, const int wid_s) {
    const int t = fresh_tid(wid_s), ntn = Ndst >> 6, ntiles = ntn * (K >> 6);
    for (int tile = fresh_bid(); tile < ntiles; tile += fresh_gdim()) {
        const int n0 = (tile % ntn) << 6, k0 = (tile / ntn) << 6;
        const int nn = t & 63, kq = t >> 6;
        const int sc = src_col(kind, n0 + nn);
#pragma unroll
        for (int i = 0; i < 8; ++i) { const int k = kq + 8 * i; const float v = sc >= 0 ? W[(size_t)(k0 + k) * Nsrc + sc] : 0.f; ldsf[nn * 65 + k] = v; }
        __syncthreads();
        const int row = t >> 3, seg = (t & 7) * 8;
        float v[8];
#pragma unroll
        for (int j = 0; j < 8; ++j) v[j] = ldsf[row * 65 + seg + j];
        u32x4 o; o.x = pk_bf16(v[0], v[1]); o.y = pk_bf16(v[2], v[3]); o.z = pk_bf16(v[4], v[5]); o.w = pk_bf16(v[6], v[7]);
        *(u32x4*)(Wt + (size_t)(n0 + row) * K + k0 + seg) = o;
        __syncthreads();
    }
}

__device__ __forceinline__ float wave_sum(float v, int lane) {
#pragma unroll
    for (int o = 32; o >= 1; o >>= 1) v += shx(v, o, lane);
    return v;
}
__device__ void norm_rows(const float* xin, const float* y, const float* gpost, float* xout, const float* gpre, bf16_t* hout, int nrows, const int wid_s) {
    const int t_ = fresh_tid(wid_s); const int lane = t_ & 63, gw = fresh_bid() * 8 + (t_ >> 6), nw = fresh_gdim() * 8;
    for (int row = gw; row < nrows; row += nw) {
        f32x4 v[8];
        const float* xr = xin + (size_t)row * DM;
#pragma unroll
        for (int i = 0; i < 8; ++i) v[i] = *(const f32x4*)(xr + (i * 64 + lane) * 4);
        if (y) {
            f32x4 yv[8]; float ss = 0.f;
            const float* yr = y + (size_t)row * DM;
#pragma unroll
            for (int i = 0; i < 8; ++i) { yv[i] = *(const f32x4*)(yr + (i * 64 + lane) * 4); ss += yv[i][0] * yv[i][0] + yv[i][1] * yv[i][1] + yv[i][2] * yv[i][2] + yv[i][3] * yv[i][3]; }
            ss = wave_sum(ss, lane);
            const float inv = rsqrtf(ss * (1.f / DM) + EPS);
#pragma unroll
            for (int i = 0; i < 8; ++i) { const f32x4 gp = *(const f32x4*)(gpost + (i * 64 + lane) * 4); v[i] += yv[i] * inv * gp; }
        }
        if (xout) {
            float* xo = xout + (size_t)row * DM;
#pragma unroll
            for (int i = 0; i < 8; ++i) *(f32x4*)(xo + (i * 64 + lane) * 4) = v[i];
        }
        if (hout) {
            float ss = 0.f;
#pragma unroll
            for (int i = 0; i < 8; ++i) ss += v[i][0] * v[i][0] + v[i][1] * v[i][1] + v[i][2] * v[i][2] + v[i][3] * v[i][3];
            ss = wave_sum(ss, lane);
            const float inv = rsqrtf(ss * (1.f / DM) + EPS);
            bf16_t* ho = hout + (size_t)row * DM;
#pragma unroll
            for (int i = 0; i < 8; ++i) { const f32x4 gp = *(const f32x4*)(gpre + (i * 64 + lane) * 4); *(u32x2*)(ho + (i * 64 + lane) * 4) = pk4(v[i] * inv * gp); }
        }
    }
}

__device__ void dn_prep(LAS unsigned char* lds, PPtr p, int layer, const int wid_s) {
    const int t = fresh_tid(wid_s), wv = t >> 6, lane = t & 63, fr = lane & 15, fq = lane >> 4;
    LAS bf16_t* QS = (LAS bf16_t*)lds;
    LAS bf16_t* KS = (LAS bf16_t*)(lds + 17408);
    LAS float* KF = (LAS float*)(lds + 34816);
    LAS float* VF = (LAS float*)(lds + 67584);
    LAS float* LS = (LAS float*)(lds + 100352);
    LAS float* GC = (LAS float*)(lds + 117760);
    LAS float* BE = GC + 64;
    LAS float* EG = GC + 128;
    const bf16_t* Z = (const bf16_t*)(p->ws + WS_Z);
    const float* SMp = (const float*)(p->ws + WS_SM);
    bf16_t* DNP = (bf16_t*)(p->ws + WS_DNP);
    float* GLAST = (float*)(p->ws + WS_MISC);
    const float* convw = p->in[5] + (size_t)layer * 3072 * 4;
    for (int item = fresh_bid(); item < 2048; item += fresh_gdim()) {
        const int n = item & 63, h = (item >> 6) & 7, b = item >> 9;
        const size_t row0 = (size_t)b * SEQ + n * 64;
        bf16_t* it = DNP + (size_t)item * 36864;
#pragma unroll 1
        for (int pass = 0; pass < 2; ++pass) {
            const int tok = pass * 32 + (t >> 4), c8 = (t & 15) * 8;
#pragma unroll
            for (int mat = 0; mat < 3; ++mat) {
                const int ch = mat * 1024 + h * 128 + c8;
                float y[8];
#pragma unroll
                for (int c = 0; c < 8; ++c) y[c] = 0.f;
                f32x4 wc[8];
#pragma unroll
                for (int c = 0; c < 8; ++c) wc[c] = *(const f32x4*)(convw + (size_t)(ch + c) * 4);
#pragma unroll
                for (int j = 0; j < 4; ++j) {
                    const int tt = n * 64 + tok - 3 + j;
                    if (tt >= 0) {
                        const u32x4 xv = *(const u32x4*)(Z + ((size_t)b * SEQ + tt) * ZW + ch);
                        y[0] += wc[0][j] * lo_bf(xv.x); y[1] += wc[1][j] * hi_bf(xv.x);
                        y[2] += wc[2][j] * lo_bf(xv.y); y[3] += wc[3][j] * hi_bf(xv.y);
                        y[4] += wc[4][j] * lo_bf(xv.z); y[5] += wc[5][j] * hi_bf(xv.z);
                        y[6] += wc[6][j] * lo_bf(xv.w); y[7] += wc[7][j] * hi_bf(xv.w);
                    }
                }
                float ss = 0.f;
#pragma unroll
                for (int c = 0; c < 8; ++c) { y[c] = siluf_(y[c]); ss += y[c] * y[c]; }
                if (mat < 2) {
                    ss += shx(ss, 1, lane); ss += shx(ss, 2, lane); ss += shx(ss, 4, lane); ss += shx(ss, 8, lane);
                    const float inv = rsqrtf(ss + EPS) * (mat == 0 ? 0.08838834764831845f : 1.f);
#pragma unroll
                    for (int c = 0; c < 8; ++c) y[c] *= inv;
                    u32x4 o; o.x = pk_bf16(y[0], y[1]); o.y = pk_bf16(y[2], y[3]); o.z = pk_bf16(y[4], y[5]); o.w = pk_bf16(y[6], y[7]);
                    if (mat == 0) *(LAS u32x4*)(QS + tok * 136 + c8) = o;
                    else { *(LAS u32x4*)(KS + tok * 136 + c8) = o;
#pragma unroll
                        for (int c = 0; c < 8; ++c) KF[tok * 128 + c8 + c] = y[c]; }
                } else {
#pragma unroll
                    for (int c = 0; c < 8; ++c) VF[tok * 128 + c8 + c] = y[c];
                }
            }
        }
        if (t < 64) {
            const float db = SMp[(row0 + t) * 32 + h], da = SMp[(row0 + t) * 32 + 8 + h];
            const float be = sigmoidf_(db);
            float g = -expf(p->in[6][layer * 8 + h]) * softplusf_(da + p->in[7][layer * 8 + h]);
#pragma unroll
            for (int o = 1; o < 64; o <<= 1) { const float v = shup(g, o, lane); if (lane >= o) g += v; }
            GC[t] = g; BE[t] = be; EG[t] = expf(g); GC[192 + t] = be * expf(g);
        }
        __syncthreads();
#pragma unroll
        for (int tt = 0; tt < 2; ++tt) {
            const int tile = wv * 2 + tt, mi = tile >> 2, ni = tile & 3;
            f32x4 aK = {0.f, 0.f, 0.f, 0.f}, aQ = {0.f, 0.f, 0.f, 0.f};
#pragma unroll
            for (int ks = 0; ks < 4; ++ks) {
                const bf16x8 bfr = *(const LAS bf16x8*)(KS + (ni * 16 + fr) * 136 + ks * 32 + fq * 8);
                const bf16x8 ak = *(const LAS bf16x8*)(KS + (mi * 16 + fr) * 136 + ks * 32 + fq * 8);
                const bf16x8 aq = *(const LAS bf16x8*)(QS + (mi * 16 + fr) * 136 + ks * 32 + fq * 8);
                aK = mfma16(ak, bfr, aK); aQ = mfma16(aq, bfr, aQ);
            }
            const int j = ni * 16 + fr; const float gj = GC[j];
#pragma unroll
            for (int r = 0; r < 4; ++r) {
                const int i = mi * 16 + fq * 4 + r;
                const float dec = (i >= j) ? expf(GC[i] - gj) : 0.f;
                LS[i * 68 + j] = (i > j) ? BE[i] * aK[r] * dec : 0.f;
                it[32768 + i * 64 + j] = f2bf(aQ[r] * dec);
            }
        }
        __syncthreads();
        if (t < 256) {
            const bool isw = t >= 128; const int cc = t & 127;
            bf16_t* op = it + (isw ? 8192 : 0) + cc;
            LAS const float* src = isw ? KF : VF;
            float x[64];
            int z0; asm volatile("v_mov_b32 %0, 0" : "=v"(z0));
            LAS const float* LSv = LS + z0;
            LAS const float* facp = (isw ? (GC + 192) : BE) + z0;
#pragma unroll
            for (int i = 0; i < 64; ++i) {
                float s = facp[i] * src[i * 128 + cc];
#pragma unroll
                for (int j = 0; j < i; ++j) s -= LSv[i * 68 + j] * x[j];
                x[i] = s;
                op[i * 128] = f2bf(s);
                asm volatile("" ::: "memory");
            }
        } else {
            const int t2 = t - 256;
            { const int i = t2 >> 2, cs = (t2 & 3) * 32; const float e = EG[i];
#pragma unroll
              for (int q = 0; q < 4; ++q) { const u32x4 w = *(const LAS u32x4*)(QS + i * 136 + cs + q * 8);
                  u32x4 o; o.x = pk_bf16(lo_bf(w.x) * e, hi_bf(w.x) * e); o.y = pk_bf16(lo_bf(w.y) * e, hi_bf(w.y) * e); o.z = pk_bf16(lo_bf(w.z) * e, hi_bf(w.z) * e); o.w = pk_bf16(lo_bf(w.w) * e, hi_bf(w.w) * e);
                  *(u32x4*)(it + 16384 + i * 128 + cs + q * 8) = o; } }
            { const int d = t2 >> 1, hf = t2 & 1; const float gl = GC[63];
#pragma unroll
              for (int q = 0; q < 4; ++q) { float v[8];
#pragma unroll
                  for (int e = 0; e < 8; ++e) { const int i = hf * 32 + q * 8 + e; v[e] = KF[i * 128 + d] * expf(gl - GC[i]); }
                  u32x4 o; o.x = pk_bf16(v[0], v[1]); o.y = pk_bf16(v[2], v[3]); o.z = pk_bf16(v[4], v[5]); o.w = pk_bf16(v[6], v[7]);
                  *(u32x4*)(it + 24576 + d * 64 + hf * 32 + q * 8) = o; } }
            if (t2 == 0) GLAST[item] = expf(GC[63]);
        }
        __syncthreads();
    }
}

__device__ void gla_prep(LAS unsigned char* lds, PPtr p, int layer, const int wid_s) {
    const int t = fresh_tid(wid_s), wv = t >> 6, lane = t & 63, fr = lane & 15, fq = lane >> 4;
    LAS bf16_t* QA = (LAS bf16_t*)(lds + 32768);
    LAS bf16_t* KD = (LAS bf16_t*)(lds + 50176);
    LAS float* TOT = (LAS float*)(lds + 67584);
    const bf16_t* Z = (const bf16_t*)(p->ws + WS_Z);
    const float* SMp = (const float*)(p->ws + WS_SM);
    unsigned char* GLP = p->ws + WS_GLP;
    for (int item = fresh_bid(); item < 1024; item += fresh_gdim()) {
        const int n = item & 63, h = (item >> 6) & 3, b = item >> 8;
        const size_t row0 = (size_t)b * SEQ + n * 64;
        bf16_t* it = (bf16_t*)(GLP + (size_t)item * GL_ITEM);
        const int d = t & 127, iq = __builtin_amdgcn_readfirstlane(t >> 7);
        float wup[16];
#pragma unroll
        for (int r = 0; r < 16; ++r) wup[r] = p->in[10][(size_t)layer * 16 * 512 + r * 512 + h * 128 + d];
        const float bup = p->in[11][layer * 512 + h * 128 + d];
        float la[16]; float run = 0.f;
#pragma unroll
        for (int ii = 0; ii < 16; ++ii) {
            const float* gl = SMp + (row0 + iq * 16 + ii) * 32 + 16;
            float dot = bup;
#pragma unroll
            for (int r = 0; r < 16; ++r) dot += gl[r] * wup[r];
            const float ls = fminf(dot, 0.f) - log1pf(__expf(-fabsf(dot)));
            run += ls * (1.f / 16.f); la[ii] = run;
        }
        TOT[iq * 128 + d] = run;
        __syncthreads();
        float off = 0.f, blast = 0.f;
#pragma unroll
        for (int q = 0; q < 4; ++q) { const float v = TOT[q * 128 + d]; blast += v; if (q < iq) off += v; }
        float kdv[16];
#pragma unroll
        for (int ii = 0; ii < 16; ++ii) {
            const int i = iq * 16 + ii; const float bc = la[ii] + off;
            const float q = bf2f(Z[(row0 + i) * ZW + GQ + h * 128 + d]) * 0.08838834764831845f;
            const float k = bf2f(Z[(row0 + i) * ZW + GK + h * 128 + d]);
            it[i * 128 + d] = f2bf(q * __expf(bc));
            QA[i * 136 + d] = f2bf(q * __expf(bc - blast));
            const float kd = k * __expf(blast - bc);
            KD[i * 136 + d] = f2bf(kd); kdv[ii] = kd;
        }
        { u32x4 o0, o1;
          o0.x = pk_bf16(kdv[0], kdv[1]); o0.y = pk_bf16(kdv[2], kdv[3]); o0.z = pk_bf16(kdv[4], kdv[5]); o0.w = pk_bf16(kdv[6], kdv[7]);
          o1.x = pk_bf16(kdv[8], kdv[9]); o1.y = pk_bf16(kdv[10], kdv[11]); o1.z = pk_bf16(kdv[12], kdv[13]); o1.w = pk_bf16(kdv[14], kdv[15]);
          *(u32x4*)(it + 8192 + d * 64 + iq * 16) = o0; *(u32x4*)(it + 8192 + d * 64 + iq * 16 + 8) = o1; }
        if (iq == 0) ((float*)((unsigned char*)it + 73728))[d] = __expf(blast);
        __syncthreads();
#pragma unroll
        for (int tt = 0; tt < 2; ++tt) {
            const int tile = wv * 2 + tt, mi = tile >> 2, ni = tile & 3;
            f32x4 a = {0.f, 0.f, 0.f, 0.f};
#pragma unroll
            for (int ks = 0; ks < 4; ++ks) {
                const bf16x8 bfr = *(const LAS bf16x8*)(KD + (ni * 16 + fr) * 136 + ks * 32 + fq * 8);
                const bf16x8 aq = *(const LAS bf16x8*)(QA + (mi * 16 + fr) * 136 + ks * 32 + fq * 8);
                a = mfma16(aq, bfr, a);
            }
            const int j = ni * 16 + fr;
#pragma unroll
            for (int r = 0; r < 4; ++r) { const int i = mi * 16 + fq * 4 + r; it[16384 + i * 64 + j] = f2bf(i >= j ? a[r] : 0.f); }
        }
        { const int e = t & 255, hf = t >> 8;
#pragma unroll
          for (int q = 0; q < 4; ++q) { bf16_t v[8];
#pragma unroll
              for (int e2 = 0; e2 < 8; ++e2) v[e2] = Z[(row0 + hf * 32 + q * 8 + e2) * ZW + GV + h * 256 + e];
              u32x4 o; o.x = v[0] | ((unsigned)v[1] << 16); o.y = v[2] | ((unsigned)v[3] << 16); o.z = v[4] | ((unsigned)v[5] << 16); o.w = v[6] | ((unsigned)v[7] << 16);
              *(u32x4*)(it + 20480 + e * 64 + hf * 32 + q * 8) = o; } }
        __syncthreads();
    }
}

__device__ void dn_scan(LAS unsigned char* lds, PPtr p, int bh, int es, const int wid_s) {
    const int t = fresh_tid(wid_s), wv = t >> 6, lane = t & 63, fr = lane & 15, fq = lane >> 4;
    const int mt = wv & 3, et = wv >> 2;
    LAS bf16_t* ST = (LAS bf16_t*)lds;
    LAS bf16_t* VT = (LAS bf16_t*)(lds + 8704);
    const bf16_t* DNP = (const bf16_t*)(p->ws + WS_DNP);
    const float* GLAST = (const float*)(p->ws + WS_MISC);
    bf16_t* OA = (bf16_t*)(p->ws + WS_H);
    for (int i = t; i < 32 * 136 / 2; i += 512) ((LAS unsigned*)ST)[i] = 0u;
    f32x4 S0 = {0.f, 0.f, 0.f, 0.f}, S1 = {0.f, 0.f, 0.f, 0.f};
    __syncthreads();
    const int b = bh >> 3, h = bh & 7;
    struct DF { bf16x8 wf[4], qf[4], af[2], kf[2]; float uv[4]; float gl; };
    auto dload = [&](int n) __attribute__((always_inline)) {
        DF f; const bf16_t* it = DNP + (size_t)(bh * 64 + n) * 36864;
#pragma unroll
        for (int ks = 0; ks < 4; ++ks) { f.wf[ks] = *(const bf16x8*)(it + 8192 + (mt * 16 + fr) * 128 + ks * 32 + fq * 8); f.qf[ks] = *(const bf16x8*)(it + 16384 + (mt * 16 + fr) * 128 + ks * 32 + fq * 8); }
#pragma unroll
        for (int ks = 0; ks < 2; ++ks) { f.af[ks] = *(const bf16x8*)(it + 32768 + (mt * 16 + fr) * 64 + ks * 32 + fq * 8); f.kf[ks] = *(const bf16x8*)(it + 24576 + (wv * 16 + fr) * 64 + ks * 32 + fq * 8); }
#pragma unroll
        for (int r = 0; r < 4; ++r) f.uv[r] = bf2f(it[(mt * 16 + fq * 4 + r) * 128 + es * 32 + et * 16 + fr]);
        f.gl = GLAST[bh * 64 + n];
        return f; };
    DF cf = dload(0);
#pragma unroll 1
    for (int n = 0; n < 64; ++n) {
        const DF nf = dload(n < 63 ? n + 1 : 63);
        const bf16x8 (&wf)[4] = cf.wf; const bf16x8 (&qf)[4] = cf.qf; const bf16x8 (&af)[2] = cf.af; const bf16x8 (&kf)[2] = cf.kf; const float (&uv)[4] = cf.uv; const float gl = cf.gl;
        f32x4 P = {0.f, 0.f, 0.f, 0.f}, Q = {0.f, 0.f, 0.f, 0.f};
#pragma unroll
        for (int ks = 0; ks < 4; ++ks) { const bf16x8 bfr = *(const LAS bf16x8*)(ST + (et * 16 + fr) * 136 + ks * 32 + fq * 8); P = mfma16(wf[ks], bfr, P); Q = mfma16(qf[ks], bfr, Q); }
        const f32x4 vn = {uv[0] - P[0], uv[1] - P[1], uv[2] - P[2], uv[3] - P[3]};
        *(LAS u32x2*)(VT + (et * 16 + fr) * 72 + mt * 16 + fq * 4) = pk4(vn);
        __syncthreads();
#pragma unroll
        for (int ks = 0; ks < 2; ++ks) { const bf16x8 bfr = *(const LAS bf16x8*)(VT + (et * 16 + fr) * 72 + ks * 32 + fq * 8); Q = mfma16(af[ks], bfr, Q); }
#pragma unroll
        for (int r = 0; r < 4; ++r) OA[((size_t)b * SEQ + n * 64 + mt * 16 + fq * 4 + r) * 1024 + h * 128 + es * 32 + et * 16 + fr] = f2bf(Q[r]);
        S0 *= gl; S1 *= gl;
#pragma unroll
        for (int ks = 0; ks < 2; ++ks) {
            const bf16x8 b0 = *(const LAS bf16x8*)(VT + fr * 72 + ks * 32 + fq * 8);
            const bf16x8 b1 = *(const LAS bf16x8*)(VT + (16 + fr) * 72 + ks * 32 + fq * 8);
            S0 = mfma16(kf[ks], b0, S0); S1 = mfma16(kf[ks], b1, S1);
        }
        *(LAS u32x2*)(ST + fr * 136 + wv * 16 + fq * 4) = pk4(S0);
        *(LAS u32x2*)(ST + (16 + fr) * 136 + wv * 16 + fq * 4) = pk4(S1);
        __syncthreads();
        cf = nf;
    }
}

__device__ void gla_scan(LAS unsigned char* lds, PPtr p, int bh, int es, const int wid_s) {
    const int t = fresh_tid(wid_s), wv = t >> 6, lane = t & 63, fr = lane & 15, fq = lane >> 4;
    const int mt = wv & 3, eh = wv >> 2;
    LAS bf16_t* STb = (LAS bf16_t*)lds;
    const unsigned char* GLP = p->ws + WS_GLP;
    bf16_t* OB = (bf16_t*)(p->ws + WS_H) + (size_t)MTOK * 1024;
    for (int i = t; i < 64 * 136 / 2; i += 512) ((LAS unsigned*)STb)[i] = 0u;
    f32x4 S[4];
#pragma unroll
    for (int e = 0; e < 4; ++e) S[e] = (f32x4){0.f, 0.f, 0.f, 0.f};
    __syncthreads();
    const int b = bh >> 2, h = bh & 3;
    struct GF { bf16x8 qf[4], af[2], kf[2], vB[4][2]; f32x4 al; };
    auto gload = [&](int n) __attribute__((always_inline)) {
        GF f; const unsigned char* itb = GLP + (size_t)(bh * 64 + n) * GL_ITEM; const bf16_t* it = (const bf16_t*)itb;
#pragma unroll
        for (int ks = 0; ks < 4; ++ks) f.qf[ks] = *(const bf16x8*)(it + (mt * 16 + fr) * 128 + ks * 32 + fq * 8);
#pragma unroll
        for (int ks = 0; ks < 2; ++ks) { f.af[ks] = *(const bf16x8*)(it + 16384 + (mt * 16 + fr) * 64 + ks * 32 + fq * 8); f.kf[ks] = *(const bf16x8*)(it + 8192 + (wv * 16 + fr) * 64 + ks * 32 + fq * 8); }
#pragma unroll
        for (int e = 0; e < 4; ++e)
#pragma unroll
            for (int ks = 0; ks < 2; ++ks) f.vB[e][ks] = *(const bf16x8*)(it + 20480 + (es * 64 + e * 16 + fr) * 64 + ks * 32 + fq * 8);
        f.al = *(const f32x4*)((const float*)(itb + 73728) + wv * 16 + fq * 4);
        return f; };
    GF cf = gload(0);
#pragma unroll 1
    for (int n = 0; n < 64; ++n) {
        const GF nf = gload(n < 63 ? n + 1 : 63);
        LAS bf16_t* cur = STb + (n & 1) * (64 * 136);
        LAS bf16_t* nxt = STb + ((n + 1) & 1) * (64 * 136);
        const bf16x8 (&qf)[4] = cf.qf; const bf16x8 (&af)[2] = cf.af; const bf16x8 (&kf)[2] = cf.kf; const bf16x8 (&vB)[4][2] = cf.vB; const f32x4 al = cf.al;
        bf16x8 vO[2][2];
#pragma unroll
        for (int e2 = 0; e2 < 2; ++e2)
#pragma unroll
            for (int ks = 0; ks < 2; ++ks) vO[e2][ks] = eh ? vB[2 + e2][ks] : vB[e2][ks];
#pragma unroll
        for (int e2 = 0; e2 < 2; ++e2) {
            const int etile = eh * 2 + e2;
            f32x4 O = {0.f, 0.f, 0.f, 0.f};
#pragma unroll
            for (int ks = 0; ks < 4; ++ks) { const bf16x8 bfr = *(const LAS bf16x8*)(cur + (etile * 16 + fr) * 136 + ks * 32 + fq * 8); O = mfma16(qf[ks], bfr, O); }
#pragma unroll
            for (int ks = 0; ks < 2; ++ks) O = mfma16(af[ks], vO[e2][ks], O);
#pragma unroll
            for (int r = 0; r < 4; ++r) OB[((size_t)b * SEQ + n * 64 + mt * 16 + fq * 4 + r) * 1024 + h * 256 + es * 64 + etile * 16 + fr] = f2bf(O[r]);
        }
#pragma unroll
        for (int e = 0; e < 4; ++e) {
            S[e] *= al;
#pragma unroll
            for (int ks = 0; ks < 2; ++ks) S[e] = mfma16(kf[ks], vB[e][ks], S[e]);
            *(LAS u32x2*)(nxt + (e * 16 + fr) * 136 + wv * 16 + fq * 4) = pk4(S[e]);
        }
        __syncthreads();
        cf = nf;
    }
}

__device__ void s5_scan(LAS unsigned char* ldsw, PPtr p, int layer, int b, int g, const int wid_s) {
    const int lane = fresh_tid(wid_s) & 63, fr = lane & 15, fq = lane >> 4;
    bf16_t* Z = (bf16_t*)(p->ws + WS_Z);
    const float* lam_re = p->in[14] + (size_t)(layer * 64 + g) * 64;
    const float* lam_im = p->in[15] + (size_t)(layer * 64 + g) * 64;
    const float dt = expf(p->in[16][layer * 64 + g]);
    const float* b_re = p->in[17] + (size_t)(layer * 64 + g) * 64 * 16;
    const float* b_im = p->in[18] + (size_t)(layer * 64 + g) * 64 * 16;
    const float* c_re = p->in[19] + (size_t)(layer * 64 + g) * 16 * 64;
    const float* c_im = p->in[20] + (size_t)(layer * 64 + g) * 16 * 64;
    const float dsk = p->in[21][layer * 1024 + g * 16 + fr];
    float ar, ai;
    { const float lr = fminf(lam_re[lane], -1e-4f), li = lam_im[lane]; const float mag = expf(lr * dt); ar = mag * cosf(li * dt); ai = mag * sinf(li * dt); }
    bf16x8 bB[8];
#pragma unroll
    for (int nt = 0; nt < 8; ++nt) {
        const int pp = (nt * 16 + fr) & 63;
        const float lr = fminf(lam_re[pp], -1e-4f), li = lam_im[pp]; const float mag = expf(lr * dt);
        const float a_r = mag * cosf(li * dt), a_i = mag * sinf(li * dt), nr = a_r - 1.f, den = lr * lr + li * li;
        const float zr = (nr * lr + a_i * li) / den, zi = (a_i * lr - nr * li) / den;
        float v[8];
#pragma unroll
        for (int j = 0; j < 8; ++j) {
            float val = 0.f;
            if (fq < 2) { const float br = b_re[pp * 16 + fq * 8 + j], bi = b_im[pp * 16 + fq * 8 + j]; val = (nt >= 4) ? (zr * bi + zi * br) : (zr * br - zi * bi); }
            v[j] = val;
        }
        u32x4 o; o.x = pk_bf16(v[0], v[1]); o.y = pk_bf16(v[2], v[3]); o.z = pk_bf16(v[4], v[5]); o.w = pk_bf16(v[6], v[7]);
        bB[nt] = __builtin_bit_cast(bf16x8, o);
    }
    bf16x8 cB[4];
#pragma unroll
    for (int ks = 0; ks < 4; ++ks) {
        const int kb = ks * 32 + fq * 8;
        float v[8];
#pragma unroll
        for (int j = 0; j < 8; ++j) v[j] = (ks < 2) ? c_re[fr * 64 + kb + j] : -c_im[fr * 64 + kb - 64 + j];
        u32x4 o; o.x = pk_bf16(v[0], v[1]); o.y = pk_bf16(v[2], v[3]); o.z = pk_bf16(v[4], v[5]); o.w = pk_bf16(v[6], v[7]);
        cB[ks] = __builtin_bit_cast(bf16x8, o);
    }
    LAS float* BU = (LAS float*)ldsw;
    LAS bf16_t* X = (LAS bf16_t*)(ldsw + 8192);
    float xr = 0.f, xi = 0.f;
    struct UF { u32x4 ur; bf16_t ue[4]; };
    auto uload = [&](int tile) __attribute__((always_inline)) {
        UF f; const size_t row0 = (size_t)b * SEQ + tile * 16;
        f.ur = (u32x4){0u, 0u, 0u, 0u};
        if (fq < 2) f.ur = *(const u32x4*)(Z + (row0 + fr) * ZW + SU + g * 16 + fq * 8);
#pragma unroll
        for (int r = 0; r < 4; ++r) f.ue[r] = Z[(row0 + fq * 4 + r) * ZW + SU + g * 16 + fr];
        return f; };
    UF u0 = uload(0), u1 = uload(1);
#pragma unroll 1
    for (int tile = 0; tile < 256; ++tile) {
        const size_t row0 = (size_t)b * SEQ + tile * 16;
        const UF u2 = uload(tile < 254 ? tile + 2 : 255);
        const bf16x8 ua = __builtin_bit_cast(bf16x8, u0.ur);
#pragma unroll
        for (int nt = 0; nt < 8; ++nt) {
            f32x4 acc = {0.f, 0.f, 0.f, 0.f};
            acc = mfma16(ua, bB[nt], acc);
#pragma unroll
            for (int r = 0; r < 4; ++r) BU[(fq * 4 + r) * 128 + nt * 16 + fr] = acc[r];
        }
        asm volatile("s_waitcnt lgkmcnt(0)" ::: "memory");
#pragma unroll
        for (int tt = 0; tt < 16; ++tt) {
            const float bur = BU[tt * 128 + lane], bui = BU[tt * 128 + 64 + lane];
            const float nxr = ar * xr - ai * xi + bur, nxi = ar * xi + ai * xr + bui;
            xr = nxr; xi = nxi;
            X[tt * 136 + lane] = f2bf(xr); X[tt * 136 + 64 + lane] = f2bf(xi);
        }
        asm volatile("s_waitcnt lgkmcnt(0)" ::: "memory");
        f32x4 acc = {0.f, 0.f, 0.f, 0.f};
#pragma unroll
        for (int ks = 0; ks < 4; ++ks) { const bf16x8 xa = *(const LAS bf16x8*)(X + fr * 136 + ks * 32 + fq * 8); acc = mfma16(xa, cB[ks], acc); }
#pragma unroll
        for (int r = 0; r < 4; ++r) {
            bf16_t* zp = Z + (row0 + fq * 4 + r) * ZW + ZQ + g * 16 + fr;
            const float u = bf2f(u0.ue[r]);
            *zp = f2bf(geluf_(acc[r] + dsk * u));
        }
        asm volatile("s_waitcnt lgkmcnt(0)" ::: "memory");
        u0 = u1; u1 = u2;
    }
}

template <int W> __device__ void head_norm_gate(bf16_t* O, const bf16_t* Zg  , const float* nw, const int wid_s) {
    constexpr int LPG = W / 8;
    const size_t ngroups = (size_t)MTOK * (1024 / W);
    const int t_ = fresh_tid(wid_s), lane_ = t_ & 63;
    const size_t gthreads = (size_t)fresh_gdim() * 512, gid = (size_t)fresh_bid() * 512 + t_;
    for (size_t idx = gid; idx < ngroups * LPG; idx += gthreads) {
        const size_t grp = idx / LPG; const int l = (int)(idx % LPG);
        const size_t row = grp / (1024 / W); const int hh = (int)(grp % (1024 / W));
        const int col = hh * W + l * 8;
        bf16_t* op = O + row * 1024 + col;
        const u32x4 w = *(const u32x4*)op;
        float v[8] = {lo_bf(w.x), hi_bf(w.x), lo_bf(w.y), hi_bf(w.y), lo_bf(w.z), hi_bf(w.z), lo_bf(w.w), hi_bf(w.w)};
        float ss = 0.f;
#pragma unroll
        for (int c = 0; c < 8; ++c) ss += v[c] * v[c];
#pragma unroll
        for (int o = 1; o < LPG; o <<= 1) ss += shx(ss, o, lane_);
        const float inv = rsqrtf(ss * (1.f / W) + EPS);
        const u32x4 gz = *(const u32x4*)(Zg + row * ZW + col);
        const float gzv[8] = {lo_bf(gz.x), hi_bf(gz.x), lo_bf(gz.y), hi_bf(gz.y), lo_bf(gz.z), hi_bf(gz.z), lo_bf(gz.w), hi_bf(gz.w)};
#pragma unroll
        for (int c = 0; c < 8; ++c) v[c] = v[c] * inv * nw[l * 8 + c] * siluf_(gzv[c]);
        u32x4 o; o.x = pk_bf16(v[0], v[1]); o.y = pk_bf16(v[2], v[3]); o.z = pk_bf16(v[4], v[5]); o.w = pk_bf16(v[6], v[7]);
        *(u32x4*)op = o;
    }
}

__device__ void xattn(LAS unsigned char* lds, const bf16_t* XQ, const bf16_t* Kb, const bf16_t* VTg, bf16_t* XO, const int wid_s) {
    const int t = fresh_tid(wid_s), wv = t >> 6, lane = t & 63, fr = lane & 15, fq = lane >> 4;
    LAS bf16_t* Pw = (LAS bf16_t*)(lds + wv * 8448);
    for (int item = fresh_bid(); item < 512; item += fresh_gdim()) {
        const int qt = item & 31, hd = (item >> 5) & 3, b = item >> 7;
        const size_t r0 = (size_t)b * SEQ + qt * 128 + wv * 16;
        bf16x8 qf[4];
#pragma unroll
        for (int ks = 0; ks < 4; ++ks) qf[ks] = *(const bf16x8*)(XQ + (r0 + fr) * 512 + hd * 128 + ks * 32 + fq * 8);
        f32x4 s[16];
#pragma unroll
        for (int nt = 0; nt < 16; ++nt) {
            f32x4 a = {0.f, 0.f, 0.f, 0.f};
#pragma unroll
            for (int ks = 0; ks < 4; ++ks) { const bf16x8 kfr = *(const bf16x8*)(Kb + ((size_t)b * 256 + nt * 16 + fr) * 512 + hd * 128 + ks * 32 + fq * 8); a = mfma16(qf[ks], kfr, a); }
            s[nt] = a * 0.08838834764831845f;
        }
        float mx[4], sm[4];
#pragma unroll
        for (int r = 0; r < 4; ++r) {
            float m = s[0][r];
#pragma unroll
            for (int nt = 1; nt < 16; ++nt) m = fmaxf(m, s[nt][r]);
            m = fmaxf(m, shx(m, 1, lane)); m = fmaxf(m, shx(m, 2, lane)); m = fmaxf(m, shx(m, 4, lane)); m = fmaxf(m, shx(m, 8, lane));
            mx[r] = m;
            float su = 0.f;
#pragma unroll
            for (int nt = 0; nt < 16; ++nt) { const float e = __expf(s[nt][r] - m); s[nt][r] = e; su += e; }
            su += shx(su, 1, lane); su += shx(su, 2, lane); su += shx(su, 4, lane); su += shx(su, 8, lane);
            sm[r] = 1.f / su;
        }
#pragma unroll
        for (int nt = 0; nt < 16; ++nt)
#pragma unroll
            for (int r = 0; r < 4; ++r) Pw[(fq * 4 + r) * 264 + nt * 16 + fr] = f2bf(s[nt][r] * sm[r]);
        __syncthreads();
        bf16x8 pf[8];
#pragma unroll
        for (int ks = 0; ks < 8; ++ks) pf[ks] = *(const LAS bf16x8*)(Pw + fr * 264 + ks * 32 + fq * 8);
#pragma unroll
        for (int dtile = 0; dtile < 8; ++dtile) {
            f32x4 o = {0.f, 0.f, 0.f, 0.f};
#pragma unroll
            for (int ks = 0; ks < 8; ++ks) { const bf16x8 vfr = *(const bf16x8*)(VTg + ((size_t)(b * 4 + hd) * 128 + dtile * 16 + fr) * 256 + ks * 32 + fq * 8); o = mfma16(pf[ks], vfr, o); }
#pragma unroll
            for (int r = 0; r < 4; ++r) XO[(r0 + fq * 4 + r) * 512 + hd * 128 + dtile * 16 + fr] = f2bf(o[r]);
        }
        __syncthreads();
    }
}

__device__ void ffn_act(const bf16_t* G, const bf16_t* U, const float* cw, bf16_t* ACT, const int wid_s) {
    const size_t nitems = (size_t)(FF / 8) * (MTOK / 16);
    const size_t gthreads = (size_t)fresh_gdim() * 512, gid = (size_t)fresh_bid() * 512 + fresh_tid(wid_s);
    for (size_t idx = gid; idx < nitems; idx += gthreads) {
        const int cg = (int)(idx % (FF / 8)); const int tb = (int)(idx / (FF / 8));
        const int c0 = cg * 8, t0 = tb * 16;
        float w0[8], w1[8], w2[8];
#pragma unroll
        for (int c = 0; c < 8; ++c) { w0[c] = cw[(c0 + c) * 3]; w1[c] = cw[(c0 + c) * 3 + 1]; w2[c] = cw[(c0 + c) * 3 + 2]; }
        float g2[8], g1[8];
        const bool start = (t0 & (SEQ - 1)) == 0;
        { u32x4 a = {0u, 0u, 0u, 0u}, bq = {0u, 0u, 0u, 0u};
          if (!start) { a = *(const u32x4*)(G + (size_t)(t0 - 2) * FF + c0); bq = *(const u32x4*)(G + (size_t)(t0 - 1) * FF + c0); }
          g2[0] = lo_bf(a.x); g2[1] = hi_bf(a.x); g2[2] = lo_bf(a.y); g2[3] = hi_bf(a.y); g2[4] = lo_bf(a.z); g2[5] = hi_bf(a.z); g2[6] = lo_bf(a.w); g2[7] = hi_bf(a.w);
          g1[0] = lo_bf(bq.x); g1[1] = hi_bf(bq.x); g1[2] = lo_bf(bq.y); g1[3] = hi_bf(bq.y); g1[4] = lo_bf(bq.z); g1[5] = hi_bf(bq.z); g1[6] = lo_bf(bq.w); g1[7] = hi_bf(bq.w); }
#pragma unroll 4
        for (int tt = 0; tt < 16; ++tt) {
            const u32x4 a = *(const u32x4*)(G + (size_t)(t0 + tt) * FF + c0);
            const u32x4 uq = *(const u32x4*)(U + (size_t)(t0 + tt) * FF + c0);
            const float g0[8] = {lo_bf(a.x), hi_bf(a.x), lo_bf(a.y), hi_bf(a.y), lo_bf(a.z), hi_bf(a.z), lo_bf(a.w), hi_bf(a.w)};
            const float uu[8] = {lo_bf(uq.x), hi_bf(uq.x), lo_bf(uq.y), hi_bf(uq.y), lo_bf(uq.z), hi_bf(uq.z), lo_bf(uq.w), hi_bf(uq.w)};
            float r[8];
#pragma unroll
            for (int c = 0; c < 8; ++c) { const float y = w0[c] * g2[c] + w1[c] * g1[c] + w2[c] * g0[c]; r[c] = geluf_(y) * uu[c]; g2[c] = g1[c]; g1[c] = g0[c]; }
            u32x4 o; o.x = pk_bf16(r[0], r[1]); o.y = pk_bf16(r[2], r[3]); o.z = pk_bf16(r[4], r[5]); o.w = pk_bf16(r[6], r[7]);
            *(u32x4*)(ACT + (size_t)(t0 + tt) * FF + c0) = o;
        }
    }
}

__device__ void convert_layer_small(LAS float* ldsf, PPtr p, int l, const int wid_s) {
    unsigned char* ws = p->ws;
    convert_w(ldsf, p->in[4] + (size_t)l * 2048 * 14368, (bf16_t*)(ws + WS_WA), 2048, 14368, ZN, 1, wid_s);
    convert_w(ldsf, p->in[9] + (size_t)l * 1024 * 2048, (bf16_t*)(ws + WS_WDN), 1024, 2048, 2048, 0, wid_s);
    convert_w(ldsf, p->in[13] + (size_t)l * 1024 * 2048, (bf16_t*)(ws + WS_WGLA), 1024, 2048, 2048, 0, wid_s);
    convert_w(ldsf, p->in[22] + (size_t)l * 1024 * 4096, (bf16_t*)(ws + WS_WGLU), 1024, 4096, 4096, 2, wid_s);
    convert_w(ldsf, p->in[23] + (size_t)l * 2048 * 2048, (bf16_t*)(ws + WS_WMIX), 2048, 2048, 2048, 0, wid_s);
    convert_w(ldsf, p->in[27] + (size_t)l * 2048 * 512, (bf16_t*)(ws + WS_WXQ), 2048, 512, 512, 0, wid_s);
    convert_w(ldsf, p->in[28] + (size_t)l * 2048 * 1024, (bf16_t*)(ws + WS_WXKV), 2048, 1024, 1024, 0, wid_s);
    convert_w(ldsf, p->in[29] + (size_t)l * 512 * 2048, (bf16_t*)(ws + WS_WXO), 512, 2048, 2048, 0, wid_s);
}
__device__ void convert_layer_ffn(LAS float* ldsf, PPtr p, int l, const int wid_s) {
    unsigned char* ws = p->ws;
    convert_w(ldsf, p->in[32] + (size_t)l * 2048 * 11264, (bf16_t*)(ws + WS_WA), 2048, 11264, 11264, 3, wid_s);
    convert_w(ldsf, p->in[34] + (size_t)l * 5632 * 2048, (bf16_t*)(ws + WS_WA + 46137344), 5632, 2048, 2048, 0, wid_s);
}


#ifdef DEBUG_NAN
__device__ __noinline__ void chk_f32(const float* q, size_t n, unsigned bit, unsigned* flag) {
    const size_t gthreads = (size_t)gridDim.x * 512, gid = (size_t)blockIdx.x * 512 + threadIdx.x; bool bad = false;
    for (size_t i = gid; i < n; i += gthreads) { const float v = q[i]; if (!(fabsf(v) < 1e30f)) bad = true; }
    if (bad) atomicOr(flag, 1u << bit);
}
__device__ __noinline__ void chk_bf16(const bf16_t* q, size_t n, unsigned bit, unsigned* flag) {
    const size_t gthreads = (size_t)gridDim.x * 512, gid = (size_t)blockIdx.x * 512 + threadIdx.x; bool bad = false;
    for (size_t i = gid; i < n; i += gthreads) { const float v = bf2f(q[i]); if (!(fabsf(v) < 1e30f)) bad = true; }
    if (bad) atomicOr(flag, 1u << bit);
}
#define CHKF(ptr, n, bit) do { if (l == DEBUG_NAN - 1) { chk_f32(ptr, n, bit, (unsigned*)(PP()->ws + WS_MISC + 32768)); } gsync(grid); } while (0)
#define CHKB(ptr, n, bit) do { if (l == DEBUG_NAN - 1) { chk_bf16(ptr, n, bit, (unsigned*)(PP()->ws + WS_MISC + 32768)); } xbar(wid_s); } while (0)
#else
#define CHKF(ptr, n, bit) do {} while (0)
#define CHKB(ptr, n, bit) do {} while (0)
#endif
#ifndef PMASK
#define PMASK 0xFFFFFFFFu
#endif
#define ON(k) ((PMASK >> (k)) & 1u)
constexpr size_t WS_LIMIT = 941621248;
static_assert(WS_END <= WS_LIMIT, "workspace map exceeds the guaranteed workspace size");
static_assert(WS_DNP + (size_t)MTOK * FF * 2 <= WS_MISC, "ACT does not fit");
static_assert((size_t)MTOK * FF * 2 * 2 <= SZ_Z, "G,U do not fit in Z");

#define m_ws (PP()->ws)
#define m_Z ((bf16_t*)(m_ws + WS_Z))
#define m_Y ((float*)(m_ws + WS_Z))
#define m_SMp ((float*)(m_ws + WS_SM))
#define m_H ((bf16_t*)(m_ws + WS_H))
#define m_OA m_H
#define m_OB (m_H + (size_t)MTOK * 1024)
#define m_MRG ((float*)(m_ws + WS_DNP))
#define m_XQ ((bf16_t*)(m_ws + WS_DNP))
#define m_XO ((bf16_t*)(m_ws + WS_DNP + (size_t)MTOK * 512 * 2))
#define m_ACT ((bf16_t*)(m_ws + WS_DNP))
#define m_MB ((bf16_t*)(m_ws + WS_GLP))
#define m_MEMN ((bf16_t*)(m_ws + WS_GLP))
#define m_KB ((bf16_t*)(m_ws + WS_GLP + 4194304))
#define m_VTG ((bf16_t*)(m_ws + WS_GLP + 5242880))
#define m_G ((bf16_t*)(m_ws + WS_Z))
#define m_U ((bf16_t*)(m_ws + WS_Z + (size_t)MTOK * FF * 2))
#define m_xs (PP()->out)
#define p PP()
__global__ void __launch_bounds__(512, 2) fwd_megakernel(Params p_unused) {
    extern __shared__ __attribute__((aligned(16))) unsigned char lds_raw[];
    LAS unsigned char* lds = (LAS unsigned char*)lds_raw;
    LAS float* ldsf = (LAS float*)lds_raw;
    cg::grid_group grid = cg::this_grid();
    if ((threadIdx.x & 63) == 0) ((LAS int*)(lds + 131072))[__builtin_amdgcn_s_getreg(10244) & 63] = (int)(threadIdx.x >> 6);
    { unsigned* bar0 = (unsigned*)(PP()->ws + WS_BAR);
      if (threadIdx.x == 0) { volatile LAS unsigned* st = (volatile LAS unsigned*)(lds + XB_LDS_OFF); st[0] = 0u; st[1] = 0u;
          (void)xb_add(&bar0[XB_XCNT(xb_xcc_id())], 1u); } }
    __syncthreads();
    constexpr int wid_s = 0;
    if (ON(0)) convert_layer_small(ldsf, p, 0, wid_s);
    if (ON(1)) norm_rows(p->in[0], nullptr, nullptr, m_xs, p->in[2], m_H, MTOK, wid_s);
    xbar(wid_s);

#pragma unroll 1
    for (int l = 0; l < 2; ++l) {
        if (ON(2)) { EpiZ e; e.Z = m_Z; e.SMp = m_SMp; run_gemm(lds, m_H, DM, (const bf16_t*)(m_ws + WS_WA), MTOK, ZN, DM, e, wid_s); }
#ifdef REPEAT_PH1
        { EpiZ e; e.Z = m_Z; e.SMp = m_SMp; run_gemm(lds, m_H, DM, (const bf16_t*)(m_ws + WS_WA), MTOK, ZN, DM, e, wid_s); }
#endif
        xbar(wid_s);

#ifdef DEBUG_Z
        {
            unsigned long long* cw = (unsigned long long*)(PP()->ws + WS_MISC + 32768);
            const size_t gthreads = (size_t)gridDim.x * 512, gid = (size_t)blockIdx.x * 512 + threadIdx.x;
            const bf16_t* zz = m_Z; const bf16_t* wa = (const bf16_t*)(m_ws + WS_WA);
            unsigned long long c = 0, mi = ~0ull, cwa = 0;
            for (size_t i = gid; i < (size_t)MTOK * ZW; i += gthreads) { const float v = bf2f(zz[i]); if (!(fabsf(v) < 1e30f)) { ++c; if (i < mi) mi = i; } }
            for (size_t i = gid; i < (size_t)ZN * 2048; i += gthreads) { const float v = bf2f(wa[i]); if (!(fabsf(v) < 1e30f)) ++cwa; }
            if (c) { atomicAdd(cw, c); atomicMin(cw + 1, mi); }
            if (cwa) atomicAdd(cw + 2, cwa);
            xbar(wid_s);
            const unsigned long long C = cw[0], MI = cw[1], WB = cw[2];
            const int pnf = (int)((MI % ZW) / 256), pmf = (int)((MI / ZW) / 256);
            const int wb = WB == 0 ? 0 : (WB < 1000 ? 1 : 2), zb = C < 10000 ? 0 : (C < 10000000 ? 1 : 2);
            const float e1 = exp10f(10.f + (float)(pmf / 4));
            const float v1 = (10.f + pnf) * e1, v2 = (10.f + 10.f * (3 * wb + zb)) * e1 * 0.01f;
            float* o = PP()->out;
            for (size_t i = gid; i < (size_t)MTOK * DM; i += gthreads) o[i] = (i == 0) ? v1 : v2;
            return;
        }
#endif

        CHKB(m_H, (size_t)MTOK * DM, 0); CHKB(m_Z, (size_t)MTOK * ZW, 1); CHKF(m_SMp, (size_t)MTOK * 32, 2);
        if (ON(3)) dn_prep(lds, p, l, wid_s);
        if (ON(4)) gla_prep(lds, p, l, wid_s);
        if (ON(0)) convert_layer_ffn(ldsf, p, l, wid_s);
        xbar(wid_s);
        CHKB((const bf16_t*)(m_ws + WS_DNP), (size_t)DN_ITEM * 1024, 3); CHKB((const bf16_t*)(m_ws + WS_GLP), (size_t)GL_ITEM * 512, 4);
        for (int role = blockIdx.x; role < 256; role += gridDim.x) {
            if (role < 128) { if (ON(5)) dn_scan(lds, p, role >> 2, role & 3, wid_s); }
            else if (role < 192) { if (ON(6)) gla_scan(lds, p, (role - 128) >> 2, (role - 128) & 3, wid_s); }
            else { const int wv = fresh_tid(wid_s) >> 6; if (ON(7) && wv < 4) { const int pair = (role - 192) * 4 + wv; s5_scan(lds + wv * 12544, p, l, pair >> 6, pair & 63, wid_s); } }
            __syncthreads();
        }
        xbar(wid_s);
#ifdef REPEAT_PH3
        for (int role = blockIdx.x; role < 256; role += gridDim.x) {
            if (role < 128) { if (ON(5)) dn_scan(lds, p, role >> 2, role & 3, wid_s); }
            else if (role < 192) { if (ON(6)) gla_scan(lds, p, (role - 128) >> 2, (role - 128) & 3, wid_s); }
            else { const int wv = fresh_tid(wid_s) >> 6; if (ON(7) && wv < 4) { const int pair = (role - 192) * 4 + wv; s5_scan(lds + wv * 12544, p, l, pair >> 6, pair & 63, wid_s); } }
            __syncthreads();
        }
        xbar(wid_s);
#endif
        CHKB(m_OA, (size_t)MTOK * 1024, 5); CHKB(m_OB, (size_t)MTOK * 1024, 6); CHKB(m_Z, (size_t)MTOK * ZW, 7);
        if (ON(8)) head_norm_gate<128>(m_OA, m_Z + ZZ, p->in[8] + l * 128, wid_s);
        if (ON(8)) head_norm_gate<256>(m_OB, m_Z + GR, p->in[12] + l * 256, wid_s);
        if (ON(9)) { EpiGLU e; e.Z = m_Z; e.MRG = m_MRG; run_gemm(lds, m_Z + ZQ, ZW, (const bf16_t*)(m_ws + WS_WGLU), MTOK, 4096, 1024, e, wid_s); }
        xbar(wid_s);
        CHKB(m_OA, (size_t)MTOK * 2048, 8); CHKF(m_MRG, (size_t)MTOK * DM, 9);
        if (ON(10)) { EpiAcc<false> e; e.Z = m_Z; e.MRG = m_MRG; e.MB = nullptr; e.goff = 0; run_gemm(lds, m_OA, 1024, (const bf16_t*)(m_ws + WS_WDN), MTOK, DM, 1024, e, wid_s); }
        if (ON(10)) { EpiAcc<true> e; e.Z = m_Z; e.MRG = m_MRG; e.MB = m_MB; e.goff = 2048; run_gemm(lds, m_OB, 1024, (const bf16_t*)(m_ws + WS_WGLA), MTOK, DM, 1024, e, wid_s); }
        xbar(wid_s);
        CHKB(m_MB, (size_t)MTOK * DM, 10);
        if (ON(11)) { EpiF32 e; e.C = m_Y; e.ldc = DM; run_gemm(lds, m_MB, DM, (const bf16_t*)(m_ws + WS_WMIX), MTOK, DM, DM, e, wid_s); }
        xbar(wid_s);
        CHKF(m_Y, (size_t)MTOK * DM, 11);
        if (ON(1)) norm_rows(m_xs, m_Y, p->in[3] + l * DM, m_xs, p->in[24] + l * DM, m_H, MTOK, wid_s);
        if (ON(1)) norm_rows(p->in[1], nullptr, nullptr, nullptr, p->in[26] + l * DM, m_MEMN, 1024, wid_s);
        xbar(wid_s);
        CHKF(m_xs, (size_t)MTOK * DM, 12); CHKB(m_H, (size_t)MTOK * DM, 13);
        if (ON(12)) { EpiBf16 e; e.C = m_XQ; e.ldc = 512; run_gemm(lds, m_H, DM, (const bf16_t*)(m_ws + WS_WXQ), MTOK, 512, DM, e, wid_s); }
        if (ON(13)) { EpiKV e; e.Kb = m_KB; e.VT = m_VTG; run_gemm(lds, m_MEMN, DM, (const bf16_t*)(m_ws + WS_WXKV), 1024, 1024, DM, e, wid_s, 128); }
        xbar(wid_s);
        CHKB(m_XQ, (size_t)MTOK * 512, 14); CHKB(m_KB, (size_t)1024 * 1024, 15);
        if (ON(14)) xattn(lds, m_XQ, m_KB, m_VTG, m_XO, wid_s);
        xbar(wid_s);
        CHKB(m_XO, (size_t)MTOK * 512, 16);
        if (ON(11)) { EpiF32 e; e.C = m_Y; e.ldc = DM; run_gemm(lds, m_XO, 512, (const bf16_t*)(m_ws + WS_WXO), MTOK, DM, 512, e, wid_s); }
        xbar(wid_s);
        CHKF(m_Y, (size_t)MTOK * DM, 17);
        if (ON(1)) norm_rows(m_xs, m_Y, p->in[25] + l * DM, m_xs, p->in[30] + l * DM, m_H, MTOK, wid_s);
        xbar(wid_s);
        CHKF(m_xs, (size_t)MTOK * DM, 18);
        if (ON(15)) { EpiFFN e; e.G = m_G; e.U = m_U; run_gemm(lds, m_H, DM, (const bf16_t*)(m_ws + WS_WA), MTOK, 2 * FF, DM, e, wid_s); }
        xbar(wid_s);
        CHKB(m_G, (size_t)MTOK * FF * 2, 19);
        if (ON(16)) ffn_act(m_G, m_U, p->in[33] + (size_t)l * FF * 3, m_ACT, wid_s);
        xbar(wid_s);
        CHKB(m_ACT, (size_t)MTOK * FF, 20);
        if (ON(11)) { EpiF32 e; e.C = m_Y; e.ldc = DM; run_gemm(lds, m_ACT, FF, (const bf16_t*)(m_ws + WS_WA + 46137344), MTOK, DM, FF, e, wid_s); }
        xbar(wid_s);
        CHKF(m_Y, (size_t)MTOK * DM, 21);
        if (l == 0) {
            if (ON(1)) norm_rows(m_xs, m_Y, p->in[31] + l * DM, m_xs, p->in[2] + DM, m_H, MTOK, wid_s);
            if (ON(0)) convert_layer_small(ldsf, p, 1, wid_s);
        } else {
            if (ON(1)) norm_rows(m_xs, m_Y, p->in[31] + l * DM, m_xs, nullptr, nullptr, MTOK, wid_s);
        }
        xbar(wid_s);
        }
#ifdef DEBUG_NAN
    { const unsigned f = *(volatile unsigned*)(PP()->ws + WS_MISC + 32768); int idx = -1; for (int k = 0; k < 32; ++k) if ((f >> k) & 1u) { idx = k; break; }
      bool finalbad = false; const size_t gthreads = (size_t)gridDim.x * 512, gid = (size_t)blockIdx.x * 512 + threadIdx.x;
      const float val = idx < 0 ? 16.f : exp2f(5.f + idx);
      float* o = PP()->out;
      for (size_t i = gid; i < (size_t)MTOK * DM; i += gthreads) { if (idx >= 0) o[i] = val; else { const float v = o[i]; if (!(fabsf(v) < 1e30f)) o[i] = 16.f; } } }
#endif
}

#undef m_ws
#undef m_Z
#undef m_Y
#undef m_SMp
#undef m_H
#undef m_OA
#undef m_OB
#undef m_MRG
#undef m_XQ
#undef m_XO
#undef m_ACT
#undef m_MB
#undef m_MEMN
#undef m_KB
#undef m_VTG
#undef m_G
#undef m_U
#undef m_xs
#undef p
extern "C" void kernel_launch(void* const* d_in, const int* in_sizes, int n_in,
                              void* d_out, int out_size, void* d_ws, size_t ws_size,
                              hipStream_t stream) {
    static int grid_blocks = 0;
    constexpr int kDynLds = 131072 + 512;
    if (!grid_blocks) {
        int dev = 0, cus = 0, per_cu = 0;
        (void)hipGetDevice(&dev);
        (void)hipDeviceGetAttribute(&cus, hipDeviceAttributeMultiprocessorCount, dev);
        if (hipFuncSetAttribute((const void*)fwd_megakernel, hipFuncAttributeMaxDynamicSharedMemorySize, kDynLds) != hipSuccess) fprintf(stderr, "hipFuncSetAttribute failed\n");
        if (hipOccupancyMaxActiveBlocksPerMultiprocessor(&per_cu, (const void*)fwd_megakernel, 512, kDynLds) != hipSuccess || per_cu < 1) { fprintf(stderr, "occupancy query: %d\n", per_cu); per_cu = 1; }
        (void)hipGetLastError();
        grid_blocks = cus;
        if (n_in != 35 || ws_size < WS_END) fprintf(stderr, "kernel_launch: unexpected n_in %d or ws_size %zu (< %zu)\n", n_in, ws_size, (size_t)WS_END);
    }
    Params hp{};
    for (int i = 0; i < 35; ++i) hp.in[i] = (const float*)d_in[i];
    hp.out = (float*)d_out; hp.ws = (unsigned char*)d_ws;
    (void)hipMemsetAsync((unsigned char*)d_ws + WS_BAR, 0, XCD_BAR_WORDS * 4, stream);
    void* args[] = {&hp};
    hipError_t e = hipLaunchCooperativeKernel((const void*)fwd_megakernel, dim3(grid_blocks), dim3(512), args, kDynLds, stream);
    if (e != hipSuccess) fprintf(stderr, "cooperative launch failed: %s (grid %d)\n", hipGetErrorString(e), grid_blocks);
}
```

```cpp
#include <hip/hip_runtime.h>
#include <hip/hip_cooperative_groups.h>
#include <cstdio>
#include <type_traits>
namespace cg = cooperative_groups;

#define LAS __attribute__((address_space(3)))
typedef unsigned short bf16_t;
typedef short bf16x8 __attribute__((ext_vector_type(8)));
typedef float f32x4 __attribute__((ext_vector_type(4)));
typedef unsigned u32x2 __attribute__((ext_vector_type(2)));
typedef unsigned u32x4 __attribute__((ext_vector_type(4)));

constexpr int MTOK = 16384, DM = 2048, SEQ = 4096, NB = 4;
constexpr int ZW = 14336;
constexpr int ZN = 14592;
constexpr int ZQ = 0, ZK = 1024, ZV = 2048, ZZ = 3072, GQ = 4096, GK = 4608, GV = 5120, GR = 6144, SU = 7168, GT = 8192;
constexpr int FF = 5632;
constexpr float EPS = 1e-6f;

constexpr size_t WS_WA   = 0;
constexpr size_t SZ_WA   = 69206016;
constexpr size_t WS_WDN  = WS_WA + SZ_WA;
constexpr size_t WS_WGLA = WS_WDN + 4194304;
constexpr size_t WS_WGLU = WS_WGLA + 4194304;
constexpr size_t WS_WMIX = WS_WGLU + 8388608;
constexpr size_t WS_WXQ  = WS_WMIX + 8388608;
constexpr size_t WS_WXKV = WS_WXQ + 2097152;
constexpr size_t WS_WXO  = WS_WXKV + 4194304;
constexpr size_t WS_Z    = WS_WXO + 2097152;
constexpr size_t SZ_Z    = (size_t)MTOK * ZW * 2;
constexpr size_t WS_SM   = WS_Z + SZ_Z;
constexpr size_t WS_H    = WS_SM + (size_t)MTOK * 32 * 4;
constexpr size_t WS_DNP  = WS_H + (size_t)MTOK * DM * 2;
constexpr size_t DN_ITEM = 73728;
constexpr size_t WS_GLP  = WS_DNP + DN_ITEM * 2048;
constexpr size_t GL_ITEM = 74240;
constexpr size_t WS_MISC = WS_GLP + GL_ITEM * 1024;
constexpr size_t WS_BAR  = WS_MISC + 16384;
constexpr size_t WS_XS   = WS_MISC + 65536;
constexpr size_t WS_END  = WS_XS + (size_t)MTOK * DM * 2;

struct Params { const float* in[35]; float* out; unsigned char* ws; };
typedef const __attribute__((address_space(4))) Params* PPtr;
__device__ __forceinline__ int fresh_tid(int) {
    int hw = __builtin_amdgcn_s_getreg(10244) & 63; asm volatile("" : "+s"(hw));
    const int w = __builtin_amdgcn_readfirstlane(*(const volatile LAS int*)((LAS unsigned char*)nullptr + 131072 + hw * 4));
    const int ln = __builtin_amdgcn_mbcnt_hi(~0u, __builtin_amdgcn_mbcnt_lo(~0u, 0u)); int t = w * 64 + ln; asm volatile("" : "+v"(t)); return t; }
__device__ __forceinline__ int fresh_bid() { int b = blockIdx.x; asm volatile("" : "+s"(b)); return b; }
__device__ __forceinline__ int fresh_gdim() { int b = gridDim.x; asm volatile("" : "+s"(b)); return b; }
__device__ __forceinline__ PPtr PP() { auto kp = __builtin_amdgcn_kernarg_segment_ptr(); asm volatile("" : "+s"(kp)); return (PPtr)kp; }

__device__ __forceinline__ float bf2f(bf16_t v) { return __uint_as_float(((unsigned)v) << 16); }
typedef float f32x2_t __attribute__((ext_vector_type(2)));
typedef __bf16 bf16x2_t __attribute__((ext_vector_type(2)));
__device__ __forceinline__ unsigned pk_bf16(float lo, float hi) { const f32x2_t v = {lo, hi}; const bf16x2_t b = __builtin_convertvector(v, bf16x2_t); return __builtin_bit_cast(unsigned, b); }
__device__ __forceinline__ bf16_t f2bf(float f) { return (bf16_t)(pk_bf16(f, 0.f) & 0xffffu); }
__device__ __forceinline__ float sigmoidf_(float x) { return 1.f / (1.f + __expf(-x)); }
__device__ __forceinline__ float siluf_(float x) { return x * sigmoidf_(x); }
__device__ __forceinline__ float geluf_(float x) { const float u = 1.5957691216057308f * (x + 0.044715f * x * x * x); return x * sigmoidf_(u); }
__device__ __forceinline__ float softplusf_(float x) { return x > 20.f ? x : log1pf(__expf(x)); }
__device__ __forceinline__ float shx(float v, int mask, int lane) { return __int_as_float(__builtin_amdgcn_ds_bpermute((lane ^ mask) << 2, __float_as_int(v))); }
__device__ __forceinline__ float shup(float v, int delta, int lane) { return __int_as_float(__builtin_amdgcn_ds_bpermute((lane - delta) << 2, __float_as_int(v))); }
__device__ __forceinline__ float lo_bf(unsigned w) { return __uint_as_float(w << 16); }
__device__ __forceinline__ float hi_bf(unsigned w) { return __uint_as_float(w & 0xffff0000u); }
__device__ __forceinline__ f32x4 mfma16(bf16x8 a, bf16x8 b, f32x4 c) { return __builtin_amdgcn_mfma_f32_16x16x32_bf16(a, b, c, 0, 0, 0); }

__device__ __forceinline__ void gsync(cg::grid_group& grid) {
    __builtin_amdgcn_fence(__ATOMIC_RELEASE, "agent");
    asm volatile("s_waitcnt vmcnt(0) lgkmcnt(0)" ::: "memory");
    grid.sync();
    __builtin_amdgcn_fence(__ATOMIC_ACQUIRE, "agent");
    asm volatile("s_waitcnt vmcnt(0)" ::: "memory");
#ifdef EXTRA_SYNC
    __builtin_amdgcn_fence(__ATOMIC_RELEASE, "agent");
    asm volatile("s_waitcnt vmcnt(0) lgkmcnt(0)" ::: "memory");
    grid.sync();
    __builtin_amdgcn_fence(__ATOMIC_ACQUIRE, "agent");
    asm volatile("s_waitcnt vmcnt(0)" ::: "memory");
#endif
}


#define XB_TMO      128
#define XB_XCNT(j)  (256  + 64 * (j))
#define XB_XSUB(j)  (1280 + 64 * (j))
#define XB_XGEN(j)  (2304 + 64 * (j))
#define XB_TOP      3328
#define XB_TOPGEN   3392
#define XCD_BAR_WORDS 3456
#define XB_SPIN_CAP (1u << 20)
constexpr int XB_LDS_OFF = 131072 + 256;
__device__ __forceinline__ unsigned xb_ld(unsigned* p)              { return __hip_atomic_load(p, __ATOMIC_RELAXED, __HIP_MEMORY_SCOPE_AGENT); }
__device__ __forceinline__ unsigned xb_add(unsigned* p, unsigned v) { return __hip_atomic_fetch_add(p, v, __ATOMIC_RELAXED, __HIP_MEMORY_SCOPE_AGENT); }
__device__ __forceinline__ unsigned xb_xcc_id() { return (unsigned)__builtin_amdgcn_s_getreg((3 << 11) | 20) & 0xFu; }
#define XB_SPIN(cond, bar) do { unsigned _sp = 0; while (cond) { __builtin_amdgcn_s_sleep(1); \
    if ((++_sp & 255u) == 0u) { if (xb_ld(&(bar)[XB_TMO])) break; if (_sp > XB_SPIN_CAP) { atomicAdd(&(bar)[XB_TMO], 1u); break; } } } } while (0)
__device__ __forceinline__ void xcd_barrier_complete(unsigned* bar, unsigned x, unsigned& nloc, unsigned& nx) {
    const unsigned G = gridDim.x;
    unsigned sum, cnt, mine, sp = 0u;
    for (;;) {
        sum = 0u; cnt = 0u; mine = 0u;
#pragma unroll
        for (unsigned j = 0; j < 16; ++j) { const unsigned c = xb_ld(&bar[XB_XCNT(j)]); sum += c; cnt += (c > 0u) ? 1u : 0u; mine = (j == x) ? c : mine; }
        if (sum == G) break;
        __builtin_amdgcn_s_sleep(1);
        if ((++sp & 255u) == 0u) { if (xb_ld(&bar[XB_TMO])) break; if (sp > XB_SPIN_CAP) { atomicAdd(&bar[XB_TMO], 1u); break; } }
    }
    nloc = mine > 0u ? mine : 1u; nx = cnt > 0u ? cnt : 1u;
}
__device__ __forceinline__ void xbar(const int wid_s) {
    asm volatile("s_waitcnt vmcnt(0)" ::: "memory");
    __syncthreads();
    unsigned* bar = (unsigned*)(PP()->ws + WS_BAR);
    if (fresh_tid(wid_s) == 0) {
        volatile LAS unsigned* st = (volatile LAS unsigned*)((LAS unsigned char*)nullptr + XB_LDS_OFF);
        const unsigned x = xb_xcc_id();
        __builtin_amdgcn_s_waitcnt(0);
        unsigned nloc = st[0], nx = st[1];
        if (nloc == 0u) { xcd_barrier_complete(bar, x, nloc, nx); st[0] = nloc; st[1] = nx; }
        const unsigned old = xb_add(&bar[XB_XSUB(x)], 1u);
        const unsigned gen = old / nloc;
        if (old + 1u == (gen + 1u) * nloc) {
            __builtin_amdgcn_fence(__ATOMIC_RELEASE, "agent");
            asm volatile("s_waitcnt vmcnt(0)" ::: "memory");
            const unsigned og = xb_add(&bar[XB_TOP], 1u);
            const unsigned tg = og / nx;
            if (og + 1u == (tg + 1u) * nx) xb_add(&bar[XB_TOPGEN], 1u);
            else XB_SPIN(xb_ld(&bar[XB_TOPGEN]) == tg, bar);
            __builtin_amdgcn_fence(__ATOMIC_ACQUIRE, "agent");
            xb_add(&bar[XB_XGEN(x)], 1u);
            asm volatile("s_waitcnt vmcnt(0)" ::: "memory");
        } else {
            XB_SPIN(xb_ld(&bar[XB_XGEN(x)]) == gen, bar);
            __builtin_amdgcn_fence(__ATOMIC_ACQUIRE, "agent");
            asm volatile("s_waitcnt vmcnt(0)" ::: "memory");
        }
    }
    __syncthreads();
}

constexpr int BM = 256, BK = 64, HALF = 128, HTB = HALF * BK * 2, STAGE_BYTES = 8 * HTB, NXCD = 8, WGM = 8;
__device__ __forceinline__ int lds_byte(int r, int c) { const int st = (r >> 4) * 2 + (c >> 5), rr = r & 15, cc = c & 31, ob = rr * 64 + cc * 2; return st * 1024 + (ob ^ (((ob >> 9) & 1) << 5)); }
__device__ __forceinline__ void stage_rc(int b, int& R, int& C) { const int st = b / 1024, sb = b % 1024, swz = sb ^ (((sb >> 9) & 1) << 5); R = (st >> 1) * 16 + swz / 64; C = (st & 1) * 32 + (swz % 64) / 2; }
struct Unit { int pm, pn; };
struct Gemm { const bf16_t* A; const bf16_t* Bt; int M, N, K, lda; };
struct StaticOrder {
    int nM, nN, nwg, G, c;
    __device__ void init(int M, int N, int G_, int c_) { nM = M / BM; nN = N / BM; nwg = nM * nN; G = G_; c = c_; }
    __device__ bool next(int i, Unit& u) const {
        const long L = (long)i * G + c; if (L >= nwg) return false;
        int wgid = (int)L; { const int q = nwg / NXCD, r = nwg % NXCD, xcd = wgid % NXCD, off = wgid / NXCD; wgid = (xcd < r ? xcd * (q + 1) : r * (q + 1) + (xcd - r) * q) + off; }
        const int nig = WGM * nN, gid = wgid / nig, fm = gid * WGM, gsz = (nM - fm) < WGM ? (nM - fm) : WGM;
        u.pm = fm + ((wgid % nig) % gsz); u.pn = (wgid % nig) / gsz; return true;
    }
};

template <class Epi>
__device__ __forceinline__ void gemm_phase(LAS unsigned char* lds, const Gemm g, const StaticOrder& S, const Epi& E, const int wid_s) {
    const int tid = fresh_tid(wid_s), wid = __builtin_amdgcn_readfirstlane(tid >> 6), lane = tid & 63, wr = wid >> 2, wc = wid & 3, fr = lane & 15, fq = lane >> 4;
    const int K = g.K, nt = K / BK, lda = g.lda;
    unsigned voffA[2], voffB[2];
#pragma unroll
    for (int i = 0; i < 2; ++i) { int R, C; stage_rc(tid * 16 + i * 8192, R, C); voffA[i] = (unsigned)(R * lda + C) * 2u; voffB[i] = (unsigned)(R * K + C) * 2u; }
    const size_t kstep = (size_t)(BK * 2);
    const size_t hstepA = (size_t)HALF * lda * 2, hstepB = (size_t)HALF * K * 2;
    const size_t tstepA = 2 * hstepA, tstepB = 2 * hstepB;
    const unsigned ldsw = (unsigned)wid * 1024u;
    const int aoff = lds_byte(wr * 64 + fr, fq * 8), boff = lds_byte(wc * 32 + fr, fq * 8);
#define PG8_SA(b, h) (((b) * 2 + (h)) * HTB)
#define PG8_SB(b, h) ((4 + (b) * 2 + (h)) * HTB)
#define PG8_STAGE(bufoff, gbase, voff) do { _Pragma("unroll") for (int _i = 0; _i < 2; ++_i) \
        __builtin_amdgcn_global_load_lds((const unsigned*)((const char*)(gbase) + (voff)[_i]), (LAS unsigned*)(lds + (bufoff) + ldsw + _i * 8192), 16, 0, 0); } while (0)
#define PG8_LDA(dst, b, h) do { _Pragma("unroll") for (int m = 0; m < 4; ++m) _Pragma("unroll") for (int k = 0; k < 2; ++k) dst[m][k] = *(const LAS bf16x8*)(lds + PG8_SA(b, h) + aoff + m * 2048 + k * 1024); } while (0)
#define PG8_LDB(dst, b, h) do { _Pragma("unroll") for (int n = 0; n < 2; ++n) _Pragma("unroll") for (int k = 0; k < 2; ++k) dst[n][k] = *(const LAS bf16x8*)(lds + PG8_SB(b, h) + boff + n * 2048 + k * 1024); } while (0)
#define PG8_MMA(ai, bj, At, Bt) do { __builtin_amdgcn_s_setprio(1); _Pragma("unroll") for (int m = 0; m < 4; ++m) _Pragma("unroll") for (int n = 0; n < 2; ++n) _Pragma("unroll") for (int k = 0; k < 2; ++k) \
        acc[ai][bj][m][n] = __builtin_amdgcn_mfma_f32_16x16x32_bf16(Bt[n][k], At[m][k], acc[ai][bj][m][n], 0, 0, 0); __builtin_amdgcn_s_setprio(0); } while (0)
#define PG8_WAIT_V(n) asm volatile("s_waitcnt vmcnt(" #n ")" ::: "memory")
#define PG8_WAIT_L(n) asm volatile("s_waitcnt lgkmcnt(" #n ")" ::: "memory")
#define PG8_BAR __builtin_amdgcn_s_barrier()
#define PG8_SCHED __builtin_amdgcn_sched_barrier(0)
    Unit cur, nxt; int ui = 0;
    if (!S.next(0, cur)) return;
    f32x4 acc[2][2][4][2];
#pragma unroll
    for (int a = 0; a < 2; ++a)
#pragma unroll
        for (int b = 0; b < 2; ++b)
#pragma unroll
            for (int m = 0; m < 4; ++m)
#pragma unroll
                for (int n = 0; n < 2; ++n) acc[a][b][m][n] = (f32x4){0.f, 0.f, 0.f, 0.f};
    bf16x8 At[4][2], B0[2][2], B1[2][2];
    const char* cA = (const char*)g.A + (size_t)cur.pm * tstepA; const char* cB = (const char*)g.Bt + (size_t)cur.pn * tstepB;
    PG8_STAGE(PG8_SB(0, 0), cB, voffB); PG8_STAGE(PG8_SA(0, 0), cA, voffA); PG8_STAGE(PG8_SB(0, 1), cB + hstepB, voffB); PG8_STAGE(PG8_SA(0, 1), cA + hstepA, voffA);
    if (wr == 1) PG8_BAR;
    PG8_WAIT_V(4); PG8_BAR;
    PG8_STAGE(PG8_SB(1, 0), cB + kstep, voffB); PG8_STAGE(PG8_SA(1, 0), cA + kstep, voffA); PG8_STAGE(PG8_SB(1, 1), cB + hstepB + kstep, voffB);
    PG8_WAIT_V(6); PG8_BAR;
    for (;;) {
        const bool has_next = S.next(ui + 1, nxt);
        const char* nA = has_next ? (const char*)g.A + (size_t)nxt.pm * tstepA : cA; const char* nB = has_next ? (const char*)g.Bt + (size_t)nxt.pn * tstepB : cB;
        for (int t = 0; t < nt; t += 2) {
            const bool last = (t == nt - 2);
            const char* a1 = cA + (size_t)(t + 1) * kstep;
            const char* a2 = last ? nA : cA + (size_t)(t + 2) * kstep; const char* b2 = last ? nB : cB + (size_t)(t + 2) * kstep;
            const char* a3 = a2 + kstep; const char* b3 = b2 + kstep;
            PG8_LDB(B0, 0, 0); PG8_SCHED; PG8_LDA(At, 0, 0); PG8_STAGE(PG8_SA(1, 1), a1 + hstepA, voffA);
            PG8_WAIT_L(8); PG8_BAR; PG8_WAIT_L(0); PG8_MMA(0, 0, At, B0); PG8_BAR; PG8_SCHED;
            PG8_LDB(B1, 0, 1); PG8_STAGE(PG8_SB(0, 0), b2, voffB);
            PG8_BAR; PG8_WAIT_L(0); PG8_MMA(0, 1, At, B1); PG8_BAR;
            PG8_LDA(At, 0, 1); PG8_STAGE(PG8_SA(0, 0), a2, voffA);
            PG8_BAR; PG8_WAIT_L(0); PG8_MMA(1, 0, At, B0); PG8_BAR; PG8_SCHED;
            PG8_STAGE(PG8_SB(0, 1), b2 + hstepB, voffB);
            PG8_WAIT_V(6); PG8_BAR; PG8_MMA(1, 1, At, B1); PG8_BAR;
            PG8_LDB(B0, 1, 0); PG8_SCHED; PG8_LDA(At, 1, 0); PG8_STAGE(PG8_SA(0, 1), a2 + hstepA, voffA);
            PG8_WAIT_L(8); PG8_BAR; PG8_WAIT_L(0); PG8_MMA(0, 0, At, B0); PG8_BAR; PG8_SCHED;
            PG8_LDB(B1, 1, 1); PG8_STAGE(PG8_SB(1, 0), b3, voffB);
            PG8_BAR; PG8_WAIT_L(0); PG8_MMA(0, 1, At, B1); PG8_BAR;
            PG8_LDA(At, 1, 1); PG8_STAGE(PG8_SA(1, 0), a3, voffA);
            PG8_BAR; PG8_WAIT_L(0); PG8_MMA(1, 0, At, B0); PG8_BAR; PG8_SCHED;
            PG8_STAGE(PG8_SB(1, 1), b3 + hstepB, voffB);
            PG8_WAIT_V(6); PG8_BAR; PG8_MMA(1, 1, At, B1); PG8_BAR;
        }
        E(acc, cur, wr, wc, fr, fq);
        if (!has_next) break;
#pragma unroll
        for (int a = 0; a < 2; ++a)
#pragma unroll
            for (int b = 0; b < 2; ++b)
#pragma unroll
                for (int m = 0; m < 4; ++m)
#pragma unroll
                    for (int n = 0; n < 2; ++n) acc[a][b][m][n] = (f32x4){0.f, 0.f, 0.f, 0.f};
        cur = nxt; cA = nA; cB = nB; ++ui;
    }
    PG8_WAIT_V(0);
    if (wr == 0) PG8_BAR;
    PG8_BAR;
#undef PG8_SA
#undef PG8_SB
#undef PG8_STAGE
#undef PG8_LDA
#undef PG8_LDB
#undef PG8_MMA
#undef PG8_WAIT_V
#undef PG8_WAIT_L
#undef PG8_BAR
#undef PG8_SCHED
}

typedef const f32x4 (&AccRef)[2][2][4][2];
__device__ __forceinline__ u32x2 pk4(f32x4 v) { u32x2 r; r.x = pk_bf16(v[0], v[1]); r.y = pk_bf16(v[2], v[3]); return r; }
__device__ __forceinline__ f32x4 ld_bf4(const bf16_t* p) { const u32x2 w = *(const u32x2*)p; return (f32x4){lo_bf(w.x), hi_bf(w.x), lo_bf(w.y), hi_bf(w.y)}; }
__device__ __forceinline__ f32x4 sig4(f32x4 v) { return (f32x4){sigmoidf_(v[0]), sigmoidf_(v[1]), sigmoidf_(v[2]), sigmoidf_(v[3])}; }

struct EpiZ { bf16_t* Z; float* SMp;
    __device__ __forceinline__ void operator()(AccRef acc, const Unit& u, int wr, int wc, int fr, int fq) const {
        const int row0 = u.pm * BM + wr * 64 + fr;
        if (u.pn < 56) {
#pragma unroll
            for (int ai = 0; ai < 2; ++ai)
#pragma unroll
                for (int m = 0; m < 4; ++m) { bf16_t* rp = Z + (size_t)(row0 + ai * HALF + m * 16) * ZW + u.pn * BM + wc * 32 + 4 * fq;
#pragma unroll
                    for (int bj = 0; bj < 2; ++bj)
#pragma unroll
                        for (int n = 0; n < 2; ++n) *(u32x2*)(rp + bj * HALF + n * 16) = pk4(acc[ai][bj][m][n]); }
        } else if (wc == 0) {
#pragma unroll
            for (int ai = 0; ai < 2; ++ai)
#pragma unroll
                for (int m = 0; m < 4; ++m) { float* rp = SMp + (size_t)(row0 + ai * HALF + m * 16) * 32 + 4 * fq;
#pragma unroll
                    for (int n = 0; n < 2; ++n) *(f32x4*)(rp + n * 16) = acc[ai][0][m][n]; }
        }
    }
};
struct EpiF32 { float* C; int ldc;
    __device__ __forceinline__ void operator()(AccRef acc, const Unit& u, int wr, int wc, int fr, int fq) const {
        const int row0 = u.pm * BM + wr * 64 + fr, col0 = u.pn * BM + wc * 32 + 4 * fq;
#pragma unroll
        for (int ai = 0; ai < 2; ++ai)
#pragma unroll
            for (int m = 0; m < 4; ++m) { float* rp = C + (size_t)(row0 + ai * HALF + m * 16) * ldc + col0;
#pragma unroll
                for (int bj = 0; bj < 2; ++bj)
#pragma unroll
                    for (int n = 0; n < 2; ++n) *(f32x4*)(rp + bj * HALF + n * 16) = acc[ai][bj][m][n]; }
    }
};
struct EpiBf16 { bf16_t* C; int ldc;
    __device__ __forceinline__ void operator()(AccRef acc, const Unit& u, int wr, int wc, int fr, int fq) const {
        const int row0 = u.pm * BM + wr * 64 + fr, col0 = u.pn * BM + wc * 32 + 4 * fq;
#pragma unroll
        for (int ai = 0; ai < 2; ++ai)
#pragma unroll
            for (int m = 0; m < 4; ++m) { bf16_t* rp = C + (size_t)(row0 + ai * HALF + m * 16) * ldc + col0;
#pragma unroll
                for (int bj = 0; bj < 2; ++bj)
#pragma unroll
                    for (int n = 0; n < 2; ++n) *(u32x2*)(rp + bj * HALF + n * 16) = pk4(acc[ai][bj][m][n]); }
    }
};
struct EpiGLU { const bf16_t* Z; float* MRG;
    __device__ __forceinline__ void operator()(AccRef acc, const Unit& u, int wr, int wc, int fr, int fq) const {
        const int row0 = u.pm * BM + wr * 64 + fr;
#pragma unroll
        for (int ai = 0; ai < 2; ++ai)
#pragma unroll
            for (int m = 0; m < 4; ++m) { const int row = row0 + ai * HALF + m * 16;
#pragma unroll
                for (int bj = 0; bj < 2; ++bj) { const int oc = (u.pn * BM + bj * HALF + wc * 32) / 2 + 4 * fq;
                    const f32x4 gt = sig4(ld_bf4(Z + (size_t)row * ZW + GT + 4096 + oc));
                    const f32x4 a = acc[ai][bj][m][0], b = sig4(acc[ai][bj][m][1]);
                    *(f32x4*)(MRG + (size_t)row * DM + oc) = gt * a * b; } }
    }
};
template <bool FINAL> struct EpiAcc { const bf16_t* Z; float* MRG; bf16_t* MB; int goff;
    __device__ __forceinline__ void operator()(AccRef acc, const Unit& u, int wr, int wc, int fr, int fq) const {
        const int row0 = u.pm * BM + wr * 64 + fr, col0 = u.pn * BM + wc * 32 + 4 * fq;
#pragma unroll
        for (int ai = 0; ai < 2; ++ai)
#pragma unroll
            for (int m = 0; m < 4; ++m) { const int row = row0 + ai * HALF + m * 16;
#pragma unroll
                for (int bj = 0; bj < 2; ++bj)
#pragma unroll
                    for (int n = 0; n < 2; ++n) { const int c = col0 + bj * HALF + n * 16;
                        const f32x4 gt = sig4(ld_bf4(Z + (size_t)row * ZW + GT + goff + c));
                        const f32x4 v = *(const f32x4*)(MRG + (size_t)row * DM + c) + gt * acc[ai][bj][m][n];
                        if (FINAL) *(u32x2*)(MB + (size_t)row * DM + c) = pk4(v); else *(f32x4*)(MRG + (size_t)row * DM + c) = v; } }
    }
};
struct EpiKV { bf16_t* Kb; bf16_t* VT;
    __device__ __forceinline__ void operator()(AccRef acc, const Unit& u, int wr, int wc, int fr, int fq) const {
        const int row0 = u.pm * BM + wr * 64 + fr, col0 = u.pn * BM + wc * 32 + 4 * fq;
#pragma unroll
        for (int ai = 0; ai < 2; ++ai)
#pragma unroll
            for (int m = 0; m < 4; ++m) { const int row = row0 + ai * HALF + m * 16;
#pragma unroll
                for (int bj = 0; bj < 2; ++bj)
#pragma unroll
                    for (int n = 0; n < 2; ++n) { const int c = col0 + bj * HALF + n * 16; const f32x4 v = acc[ai][bj][m][n];
                        if (c < 512) *(u32x2*)(Kb + (size_t)row * 512 + c) = pk4(v);
                        else { const int cc = c - 512, b = row >> 8, key = row & 255;
#pragma unroll
                            for (int i = 0; i < 4; ++i) VT[((size_t)(b * 4 + ((cc + i) >> 7)) * 128 + ((cc + i) & 127)) * 256 + key] = f2bf(v[i]); } } }
    }
};
__device__ __forceinline__ float dpp_ror1(float v) { return __int_as_float(__builtin_amdgcn_update_dpp(0, __float_as_int(v), 0x121, 0xF, 0xF, false)); }
__device__ __forceinline__ float dpp_ror2(float v) { return __int_as_float(__builtin_amdgcn_update_dpp(0, __float_as_int(v), 0x122, 0xF, 0xF, false)); }
struct EpiFFN { bf16_t* ACT; bf16_t* GB; bf16_t* UB; const float* cw;
    __device__ __forceinline__ void operator()(AccRef acc, const Unit& u, int wr, int wc, int fr, int fq) const {
#pragma unroll
        for (int ai = 0; ai < 2; ++ai)
#pragma unroll
            for (int bj = 0; bj < 2; ++bj) {
                const int oc = (u.pn * BM + bj * HALF + wc * 32) / 2 + 4 * fq;
                const int rowb = u.pm * BM + ai * HALF + wr * 64;
                const f32x4 wa = *(const f32x4*)(cw + oc * 3), wb = *(const f32x4*)(cw + oc * 3 + 4), wcc = *(const f32x4*)(cw + oc * 3 + 8);
                const float w0[4] = {wa[0], wa[3], wb[2], wcc[1]}, w1[4] = {wa[1], wb[0], wb[3], wcc[2]}, w2[4] = {wa[2], wb[1], wcc[0], wcc[3]};
                f32x4 p1[4], p2[4];
#pragma unroll
                for (int m = 0; m < 4; ++m)
#pragma unroll
                    for (int c = 0; c < 4; ++c) { p1[m][c] = dpp_ror1(acc[ai][bj][m][0][c]); p2[m][c] = dpp_ror2(acc[ai][bj][m][0][c]); }
#pragma unroll
                for (int m = 0; m < 4; ++m) {
                    const f32x4 g = acc[ai][bj][m][0], up = acc[ai][bj][m][1];
                    const int row = rowb + m * 16 + fr;
                    f32x4 r;
#pragma unroll
                    for (int c = 0; c < 4; ++c) {
                        const float q1 = (m == 0) ? p1[0][c] : (fr >= 1 ? p1[m][c] : p1[m - 1][c]);
                        const float q2 = (m == 0) ? p2[0][c] : (fr >= 2 ? p2[m][c] : p2[m - 1][c]);
                        r[c] = geluf_(w0[c] * q2 + w1[c] * q1 + w2[c] * g[c]) * up[c];
                    }
                    if (m > 0 || fr >= 2) *(u32x2*)(ACT + (size_t)row * FF + oc) = pk4(r);
                    if (m == 0 && fr < 2) { *(u32x2*)(GB + (size_t)((rowb >> 6) * 4 + 2 + fr) * FF + oc) = pk4(g); *(u32x2*)(UB + (size_t)((rowb >> 6) * 2 + fr) * FF + oc) = pk4(up); }
                    if (m == 3 && fr >= 14) *(u32x2*)(GB + (size_t)((rowb >> 6) * 4 + (fr - 14)) * FF + oc) = pk4(g);
                }
            }
    }
};

template <class Epi> __device__ __forceinline__ void run_gemm(LAS unsigned char* lds, const bf16_t* A, int lda, const bf16_t* Bt, int M, int N, int K, const Epi& E, const int wid_s, int shift = 0) {
    Gemm g; g.A = A; g.Bt = Bt; g.M = M; g.N = N; g.K = K; g.lda = lda;
    StaticOrder S; S.init(M, N, (int)fresh_gdim(), (int)((fresh_bid() + fresh_gdim() - shift) % fresh_gdim()));
    gemm_phase<Epi>(lds, g, S, E, wid_s);
}

__device__ __forceinline__ int src_col(int kind, int n) {
    if (kind == 0) return n;
    if (kind == 1) {
        if (n < 4096) return n;
        if (n < 6144) return n + 16;
        if (n < 14336) return n + 32;
        if (n < 14352) return n - 14336 + 4096;
        if (n < 14368) return n - 14352 + 6160;
        return -1;
    }
    const int g = n >> 5, r = n & 31, half = (kind == 2) ? 2048 : FF;
    return r < 16 ? g * 16 + r : half + g * 16 + (r - 16);
}
__device__ void convert_w(LAS float* ldsf, const float* __restrict__ W, bf16_t* __restrict__ Wt, int K, int Nsrc, int Ndst, int kind, const int wid_s, int nb = 0, int bi = 0) {
    const int t = fresh_tid(wid_s), ntn = Ndst >> 6, ntiles = ntn * (K >> 7);
    const int nn = t & 63, kq = t >> 6, row = t >> 3, seg = (t & 7) * 16;
    const int g = nb > 0 ? nb : fresh_gdim();
    int tile = nb > 0 ? bi : fresh_bid();
    float v[16];
    auto ld = [&](int tl) __attribute__((always_inline)) {
        const int n0 = (tl % ntn) << 6, k0 = (tl / ntn) << 7;
        const int sc = src_col(kind, n0 + nn);
#pragma unroll
        for (int i = 0; i < 16; ++i) v[i] = sc >= 0 ? W[(size_t)(k0 + kq + 8 * i) * Nsrc + sc] : 0.f;
    };
    if (tile < ntiles) ld(tile);
    for (; tile < ntiles; tile += g) {
        const int n0 = (tile % ntn) << 6, k0 = (tile / ntn) << 7;
#pragma unroll
        for (int i = 0; i < 16; ++i) ldsf[nn * 129 + kq + 8 * i] = v[i];
        __syncthreads();
        if (tile + g < ntiles) ld(tile + g);
        float o[16];
#pragma unroll
        for (int j = 0; j < 16; ++j) o[j] = ldsf[row * 129 + seg + j];
        u32x4 o0, o1;
        o0.x = pk_bf16(o[0], o[1]); o0.y = pk_bf16(o[2], o[3]); o0.z = pk_bf16(o[4], o[5]); o0.w = pk_bf16(o[6], o[7]);
        o1.x = pk_bf16(o[8], o[9]); o1.y = pk_bf16(o[10], o[11]); o1.z = pk_bf16(o[12], o[13]); o1.w = pk_bf16(o[14], o[15]);
        bf16_t* dst = Wt + (size_t)(n0 + row) * K + k0 + seg;
        *(u32x4*)dst = o0; *(u32x4*)(dst + 8) = o1;
        __syncthreads();
    }
}

__device__ __forceinline__ float wave_sum(float v, int lane) {
#pragma unroll
    for (int o = 32; o >= 1; o >>= 1) v += shx(v, o, lane);
    return v;
}
__device__ void norm_rows(const float* xin_f, const bf16_t* xin_b, const bf16_t* y, const float* gpost, float* xout_f, bf16_t* xout_b, const float* gpre, bf16_t* hout, int nrows, const int wid_s) {
    const int t_ = fresh_tid(wid_s); const int lane = t_ & 63, gw = fresh_bid() * 8 + (t_ >> 6), nw = fresh_gdim() * 8;
    for (int row = gw; row < nrows; row += nw) {
        f32x4 v[8];
        if (xin_f) {
            const float* xr = xin_f + (size_t)row * DM;
#pragma unroll
            for (int i = 0; i < 8; ++i) v[i] = *(const f32x4*)(xr + (i * 64 + lane) * 4);
        } else {
            const bf16_t* xr = xin_b + (size_t)row * DM;
#pragma unroll
            for (int i = 0; i < 8; ++i) v[i] = ld_bf4(xr + (i * 64 + lane) * 4);
        }
        if (y) {
            f32x4 yv[8]; float ss = 0.f;
            const bf16_t* yr = y + (size_t)row * DM;
#pragma unroll
            for (int i = 0; i < 8; ++i) { yv[i] = ld_bf4(yr + (i * 64 + lane) * 4); ss += yv[i][0] * yv[i][0] + yv[i][1] * yv[i][1] + yv[i][2] * yv[i][2] + yv[i][3] * yv[i][3]; }
            ss = wave_sum(ss, lane);
            const float inv = rsqrtf(ss * (1.f / DM) + EPS);
#pragma unroll
            for (int i = 0; i < 8; ++i) { const f32x4 gp = *(const f32x4*)(gpost + (i * 64 + lane) * 4); v[i] += yv[i] * inv * gp; }
        }
        if (xout_f) {
            float* xo = xout_f + (size_t)row * DM;
#pragma unroll
            for (int i = 0; i < 8; ++i) *(f32x4*)(xo + (i * 64 + lane) * 4) = v[i];
        }
        if (xout_b) {
            bf16_t* xo = xout_b + (size_t)row * DM;
#pragma unroll
            for (int i = 0; i < 8; ++i) *(u32x2*)(xo + (i * 64 + lane) * 4) = pk4(v[i]);
        }
        if (hout) {
            float ss = 0.f;
#pragma unroll
            for (int i = 0; i < 8; ++i) ss += v[i][0] * v[i][0] + v[i][1] * v[i][1] + v[i][2] * v[i][2] + v[i][3] * v[i][3];
            ss = wave_sum(ss, lane);
            const float inv = rsqrtf(ss * (1.f / DM) + EPS);
            bf16_t* ho = hout + (size_t)row * DM;
#pragma unroll
            for (int i = 0; i < 8; ++i) { const f32x4 gp = *(const f32x4*)(gpre + (i * 64 + lane) * 4); *(u32x2*)(ho + (i * 64 + lane) * 4) = pk4(v[i] * inv * gp); }
        }
    }
}

__device__ void dn_prep(LAS unsigned char* lds, PPtr p, int layer, const int wid_s) {
    const int t = fresh_tid(wid_s), wv = t >> 6, lane = t & 63, fr = lane & 15, fq = lane >> 4;
    LAS bf16_t* QS = (LAS bf16_t*)lds;
    LAS bf16_t* KS = (LAS bf16_t*)(lds + 17408);
    LAS float* KF = (LAS float*)(lds + 34816);
    LAS float* VF = (LAS float*)(lds + 67584);
    LAS float* LS = (LAS float*)(lds + 100352);
    LAS float* GC = (LAS float*)(lds + 117760);
    LAS float* BE = GC + 64;
    LAS float* EG = GC + 128;
    const bf16_t* Z = (const bf16_t*)(p->ws + WS_Z);
    const float* SMp = (const float*)(p->ws + WS_SM);
    bf16_t* DNP = (bf16_t*)(p->ws + WS_DNP);
    float* GLAST = (float*)(p->ws + WS_MISC);
    const float* convw = p->in[5] + (size_t)layer * 3072 * 4;
    for (int item = fresh_bid(); item < 2048; item += fresh_gdim()) {
        const int n = item & 63, h = (item >> 6) & 7, b = item >> 9;
        const size_t row0 = (size_t)b * SEQ + n * 64;
        bf16_t* it = DNP + (size_t)item * 36864;
#pragma unroll 1
        for (int pass = 0; pass < 2; ++pass) {
            const int tok = pass * 32 + (t >> 4), c8 = (t & 15) * 8;
#pragma unroll
            for (int mat = 0; mat < 3; ++mat) {
                const int ch = mat * 1024 + h * 128 + c8;
                float y[8];
#pragma unroll
                for (int c = 0; c < 8; ++c) y[c] = 0.f;
                f32x4 wc[8];
#pragma unroll
                for (int c = 0; c < 8; ++c) wc[c] = *(const f32x4*)(convw + (size_t)(ch + c) * 4);
#pragma unroll
                for (int j = 0; j < 4; ++j) {
                    const int tt = n * 64 + tok - 3 + j;
                    if (tt >= 0) {
                        const u32x4 xv = *(const u32x4*)(Z + ((size_t)b * SEQ + tt) * ZW + ch);
                        y[0] += wc[0][j] * lo_bf(xv.x); y[1] += wc[1][j] * hi_bf(xv.x);
                        y[2] += wc[2][j] * lo_bf(xv.y); y[3] += wc[3][j] * hi_bf(xv.y);
                        y[4] += wc[4][j] * lo_bf(xv.z); y[5] += wc[5][j] * hi_bf(xv.z);
                        y[6] += wc[6][j] * lo_bf(xv.w); y[7] += wc[7][j] * hi_bf(xv.w);
                    }
                }
                float ss = 0.f;
#pragma unroll
                for (int c = 0; c < 8; ++c) { y[c] = siluf_(y[c]); ss += y[c] * y[c]; }
                if (mat < 2) {
                    ss += shx(ss, 1, lane); ss += shx(ss, 2, lane); ss += shx(ss, 4, lane); ss += shx(ss, 8, lane);
                    const float inv = rsqrtf(ss + EPS) * (mat == 0 ? 0.08838834764831845f : 1.f);
#pragma unroll
                    for (int c = 0; c < 8; ++c) y[c] *= inv;
                    u32x4 o; o.x = pk_bf16(y[0], y[1]); o.y = pk_bf16(y[2], y[3]); o.z = pk_bf16(y[4], y[5]); o.w = pk_bf16(y[6], y[7]);
                    if (mat == 0) *(LAS u32x4*)(QS + tok * 136 + c8) = o;
                    else { *(LAS u32x4*)(KS + tok * 136 + c8) = o;
#pragma unroll
                        for (int c = 0; c < 8; ++c) KF[tok * 128 + c8 + c] = y[c]; }
                } else {
#pragma unroll
                    for (int c = 0; c < 8; ++c) VF[tok * 128 + c8 + c] = y[c];
                }
            }
        }
        if (t < 64) {
            const float db = SMp[(row0 + t) * 32 + h], da = SMp[(row0 + t) * 32 + 8 + h];
            const float be = sigmoidf_(db);
            float g = -expf(p->in[6][layer * 8 + h]) * softplusf_(da + p->in[7][layer * 8 + h]);
#pragma unroll
            for (int o = 1; o < 64; o <<= 1) { const float v = shup(g, o, lane); if (lane >= o) g += v; }
            GC[t] = g; BE[t] = be; EG[t] = expf(g); GC[192 + t] = be * expf(g);
        }
        __syncthreads();
#pragma unroll
        for (int tt = 0; tt < 2; ++tt) {
            const int tile = wv * 2 + tt, mi = tile >> 2, ni = tile & 3;
            f32x4 aK = {0.f, 0.f, 0.f, 0.f}, aQ = {0.f, 0.f, 0.f, 0.f};
#pragma unroll
            for (int ks = 0; ks < 4; ++ks) {
                const bf16x8 bfr = *(const LAS bf16x8*)(KS + (ni * 16 + fr) * 136 + ks * 32 + fq * 8);
                const bf16x8 ak = *(const LAS bf16x8*)(KS + (mi * 16 + fr) * 136 + ks * 32 + fq * 8);
                const bf16x8 aq = *(const LAS bf16x8*)(QS + (mi * 16 + fr) * 136 + ks * 32 + fq * 8);
                aK = mfma16(ak, bfr, aK); aQ = mfma16(aq, bfr, aQ);
            }
            const int j = ni * 16 + fr; const float gj = GC[j];
#pragma unroll
            for (int r = 0; r < 4; ++r) {
                const int i = mi * 16 + fq * 4 + r;
                const float dec = (i >= j) ? expf(GC[i] - gj) : 0.f;
                LS[i * 68 + j] = (i > j) ? BE[i] * aK[r] * dec : 0.f;
                it[32768 + i * 64 + j] = f2bf(aQ[r] * dec);
            }
        }
        __syncthreads();
        if (t < 256) {
            const bool isw = t >= 128; const int cc = t & 127;
            bf16_t* op = it + (isw ? 8192 : 0) + cc;
            LAS const float* src = isw ? KF : VF;
            float x[64];
            int z0; asm volatile("v_mov_b32 %0, 0" : "=v"(z0));
            LAS const float* LSv = LS + z0;
            LAS const float* facp = (isw ? (GC + 192) : BE) + z0;
#pragma unroll
            for (int i = 0; i < 64; ++i) {
                float s = facp[i] * src[i * 128 + cc];
#pragma unroll
                for (int j = 0; j < i; ++j) s -= LSv[i * 68 + j] * x[j];
                x[i] = s;
                op[i * 128] = f2bf(s);
                asm volatile("" ::: "memory");
            }
        } else {
            const int t2 = t - 256;
            { const int i = t2 >> 2, cs = (t2 & 3) * 32; const float e = EG[i];
#pragma unroll
              for (int q = 0; q < 4; ++q) { const u32x4 w = *(const LAS u32x4*)(QS + i * 136 + cs + q * 8);
                  u32x4 o; o.x = pk_bf16(lo_bf(w.x) * e, hi_bf(w.x) * e); o.y = pk_bf16(lo_bf(w.y) * e, hi_bf(w.y) * e); o.z = pk_bf16(lo_bf(w.z) * e, hi_bf(w.z) * e); o.w = pk_bf16(lo_bf(w.w) * e, hi_bf(w.w) * e);
                  *(u32x4*)(it + 16384 + i * 128 + cs + q * 8) = o; } }
            { const int d = t2 >> 1, hf = t2 & 1; const float gl = GC[63];
#pragma unroll
              for (int q = 0; q < 4; ++q) { float v[8];
#pragma unroll
                  for (int e = 0; e < 8; ++e) { const int i = hf * 32 + q * 8 + e; v[e] = KF[i * 128 + d] * expf(gl - GC[i]); }
                  u32x4 o; o.x = pk_bf16(v[0], v[1]); o.y = pk_bf16(v[2], v[3]); o.z = pk_bf16(v[4], v[5]); o.w = pk_bf16(v[6], v[7]);
                  *(u32x4*)(it + 24576 + d * 64 + hf * 32 + q * 8) = o; } }
            if (t2 == 0) GLAST[item] = expf(GC[63]);
        }
        __syncthreads();
    }
}

__device__ void gla_prep(LAS unsigned char* lds, PPtr p, int layer, const int wid_s) {
    const int t = fresh_tid(wid_s), wv = t >> 6, lane = t & 63, fr = lane & 15, fq = lane >> 4;
    LAS bf16_t* QA = (LAS bf16_t*)(lds + 32768);
    LAS bf16_t* KD = (LAS bf16_t*)(lds + 50176);
    LAS float* TOT = (LAS float*)(lds + 67584);
    const bf16_t* Z = (const bf16_t*)(p->ws + WS_Z);
    const float* SMp = (const float*)(p->ws + WS_SM);
    unsigned char* GLP = p->ws + WS_GLP;
    for (int item = fresh_bid(); item < 1024; item += fresh_gdim()) {
        const int n = item & 63, h = (item >> 6) & 3, b = item >> 8;
        const size_t row0 = (size_t)b * SEQ + n * 64;
        bf16_t* it = (bf16_t*)(GLP + (size_t)item * GL_ITEM);
        const int d = t & 127, iq = __builtin_amdgcn_readfirstlane(t >> 7);
        float wup[16];
#pragma unroll
        for (int r = 0; r < 16; ++r) wup[r] = p->in[10][(size_t)layer * 16 * 512 + r * 512 + h * 128 + d];
        const float bup = p->in[11][layer * 512 + h * 128 + d];
        float la[16]; float run = 0.f;
#pragma unroll
        for (int ii = 0; ii < 16; ++ii) {
            const float* gl = SMp + (row0 + iq * 16 + ii) * 32 + 16;
            float dot = bup;
#pragma unroll
            for (int r = 0; r < 16; ++r) dot += gl[r] * wup[r];
            const float ls = fminf(dot, 0.f) - log1pf(__expf(-fabsf(dot)));
            run += ls * (1.f / 16.f); la[ii] = run;
        }
        TOT[iq * 128 + d] = run;
        __syncthreads();
        float off = 0.f, blast = 0.f;
#pragma unroll
        for (int q = 0; q < 4; ++q) { const float v = TOT[q * 128 + d]; blast += v; if (q < iq) off += v; }
        float kdv[16];
#pragma unroll
        for (int ii = 0; ii < 16; ++ii) {
            const int i = iq * 16 + ii; const float bc = la[ii] + off;
            const float q = bf2f(Z[(row0 + i) * ZW + GQ + h * 128 + d]) * 0.08838834764831845f;
            const float k = bf2f(Z[(row0 + i) * ZW + GK + h * 128 + d]);
            it[i * 128 + d] = f2bf(q * __expf(bc));
            QA[i * 136 + d] = f2bf(q * __expf(bc - blast));
            const float kd = k * __expf(blast - bc);
            KD[i * 136 + d] = f2bf(kd); kdv[ii] = kd;
        }
        { u32x4 o0, o1;
          o0.x = pk_bf16(kdv[0], kdv[1]); o0.y = pk_bf16(kdv[2], kdv[3]); o0.z = pk_bf16(kdv[4], kdv[5]); o0.w = pk_bf16(kdv[6], kdv[7]);
          o1.x = pk_bf16(kdv[8], kdv[9]); o1.y = pk_bf16(kdv[10], kdv[11]); o1.z = pk_bf16(kdv[12], kdv[13]); o1.w = pk_bf16(kdv[14], kdv[15]);
          *(u32x4*)(it + 8192 + d * 64 + iq * 16) = o0; *(u32x4*)(it + 8192 + d * 64 + iq * 16 + 8) = o1; }
        if (iq == 0) ((float*)((unsigned char*)it + 73728))[d] = __expf(blast);
        __syncthreads();
#pragma unroll
        for (int tt = 0; tt < 2; ++tt) {
            const int tile = wv * 2 + tt, mi = tile >> 2, ni = tile & 3;
            f32x4 a = {0.f, 0.f, 0.f, 0.f};
#pragma unroll
            for (int ks = 0; ks < 4; ++ks) {
                const bf16x8 bfr = *(const LAS bf16x8*)(KD + (ni * 16 + fr) * 136 + ks * 32 + fq * 8);
                const bf16x8 aq = *(const LAS bf16x8*)(QA + (mi * 16 + fr) * 136 + ks * 32 + fq * 8);
                a = mfma16(aq, bfr, a);
            }
            const int j = ni * 16 + fr;
#pragma unroll
            for (int r = 0; r < 4; ++r) { const int i = mi * 16 + fq * 4 + r; it[16384 + i * 64 + j] = f2bf(i >= j ? a[r] : 0.f); }
        }
        { const int e = t & 255, hf = t >> 8;
#pragma unroll
          for (int q = 0; q < 4; ++q) { bf16_t v[8];
#pragma unroll
              for (int e2 = 0; e2 < 8; ++e2) v[e2] = Z[(row0 + hf * 32 + q * 8 + e2) * ZW + GV + h * 256 + e];
              u32x4 o; o.x = v[0] | ((unsigned)v[1] << 16); o.y = v[2] | ((unsigned)v[3] << 16); o.z = v[4] | ((unsigned)v[5] << 16); o.w = v[6] | ((unsigned)v[7] << 16);
              *(u32x4*)(it + 20480 + e * 64 + hf * 32 + q * 8) = o; } }
        __syncthreads();
    }
}

__device__ void dn_scan(LAS unsigned char* lds, PPtr p, int bh, int es, const int wid_s) {
    const int t = fresh_tid(wid_s), wv = t >> 6, lane = t & 63, fr = lane & 15, fq = lane >> 4;
    const int mt = wv & 3, et = wv >> 2;
    LAS bf16_t* ST = (LAS bf16_t*)lds;
    LAS bf16_t* VT = (LAS bf16_t*)(lds + 8704);
    const bf16_t* DNP = (const bf16_t*)(p->ws + WS_DNP);
    const float* GLAST = (const float*)(p->ws + WS_MISC);
    bf16_t* OA = (bf16_t*)(p->ws + WS_H);
    for (int i = t; i < 32 * 136 / 2; i += 512) ((LAS unsigned*)ST)[i] = 0u;
    f32x4 S0 = {0.f, 0.f, 0.f, 0.f}, S1 = {0.f, 0.f, 0.f, 0.f};
    __syncthreads();
    const int b = bh >> 3, h = bh & 7;
    struct DF { bf16x8 wf[4], qf[4], af[2], kf[2]; float uv[4]; float gl; };
    auto dload = [&](int n) __attribute__((always_inline)) {
        DF f; const bf16_t* it = DNP + (size_t)(bh * 64 + n) * 36864;
#pragma unroll
        for (int ks = 0; ks < 4; ++ks) { f.wf[ks] = *(const bf16x8*)(it + 8192 + (mt * 16 + fr) * 128 + ks * 32 + fq * 8); f.qf[ks] = *(const bf16x8*)(it + 16384 + (mt * 16 + fr) * 128 + ks * 32 + fq * 8); }
#pragma unroll
        for (int ks = 0; ks < 2; ++ks) { f.af[ks] = *(const bf16x8*)(it + 32768 + (mt * 16 + fr) * 64 + ks * 32 + fq * 8); f.kf[ks] = *(const bf16x8*)(it + 24576 + (wv * 16 + fr) * 64 + ks * 32 + fq * 8); }
#pragma unroll
        for (int r = 0; r < 4; ++r) f.uv[r] = bf2f(it[(mt * 16 + fq * 4 + r) * 128 + es * 32 + et * 16 + fr]);
        f.gl = GLAST[bh * 64 + n];
        return f; };
    DF cf = dload(0);
#pragma unroll 1
    for (int n = 0; n < 64; ++n) {
        const DF nf = dload(n < 63 ? n + 1 : 63);
        const bf16x8 (&wf)[4] = cf.wf; const bf16x8 (&qf)[4] = cf.qf; const bf16x8 (&af)[2] = cf.af; const bf16x8 (&kf)[2] = cf.kf; const float (&uv)[4] = cf.uv; const float gl = cf.gl;
        f32x4 P = {0.f, 0.f, 0.f, 0.f}, Q = {0.f, 0.f, 0.f, 0.f};
#pragma unroll
        for (int ks = 0; ks < 4; ++ks) { const bf16x8 bfr = *(const LAS bf16x8*)(ST + (et * 16 + fr) * 136 + ks * 32 + fq * 8); P = mfma16(wf[ks], bfr, P); Q = mfma16(qf[ks], bfr, Q); }
        const f32x4 vn = {uv[0] - P[0], uv[1] - P[1], uv[2] - P[2], uv[3] - P[3]};
        *(LAS u32x2*)(VT + (et * 16 + fr) * 72 + mt * 16 + fq * 4) = pk4(vn);
        __syncthreads();
#pragma unroll
        for (int ks = 0; ks < 2; ++ks) { const bf16x8 bfr = *(const LAS bf16x8*)(VT + (et * 16 + fr) * 72 + ks * 32 + fq * 8); Q = mfma16(af[ks], bfr, Q); }
#pragma unroll
        for (int r = 0; r < 4; ++r) OA[((size_t)b * SEQ + n * 64 + mt * 16 + fq * 4 + r) * 1024 + h * 128 + es * 32 + et * 16 + fr] = f2bf(Q[r]);
        S0 *= gl; S1 *= gl;
#pragma unroll
        for (int ks = 0; ks < 2; ++ks) {
            const bf16x8 b0 = *(const LAS bf16x8*)(VT + fr * 72 + ks * 32 + fq * 8);
            const bf16x8 b1 = *(const LAS bf16x8*)(VT + (16 + fr) * 72 + ks * 32 + fq * 8);
            S0 = mfma16(kf[ks], b0, S0); S1 = mfma16(kf[ks], b1, S1);
        }
        *(LAS u32x2*)(ST + fr * 136 + wv * 16 + fq * 4) = pk4(S0);
        *(LAS u32x2*)(ST + (16 + fr) * 136 + wv * 16 + fq * 4) = pk4(S1);
        __syncthreads();
        cf = nf;
    }
}

__device__ void gla_scan(LAS unsigned char* lds, PPtr p, int bh, int es, const int wid_s) {
    const int t = fresh_tid(wid_s), wv = t >> 6, lane = t & 63, fr = lane & 15, fq = lane >> 4;
    const int mt = wv & 3, eh = wv >> 2;
    LAS bf16_t* STb = (LAS bf16_t*)lds;
    const unsigned char* GLP = p->ws + WS_GLP;
    bf16_t* OB = (bf16_t*)(p->ws + WS_H) + (size_t)MTOK * 1024;
    for (int i = t; i < 64 * 136 / 2; i += 512) ((LAS unsigned*)STb)[i] = 0u;
    f32x4 S[4];
#pragma unroll
    for (int e = 0; e < 4; ++e) S[e] = (f32x4){0.f, 0.f, 0.f, 0.f};
    __syncthreads();
    const int b = bh >> 2, h = bh & 3;
    struct GF { bf16x8 qf[4], af[2], kf[2], vB[4][2]; f32x4 al; };
    auto gload = [&](int n) __attribute__((always_inline)) {
        GF f; const unsigned char* itb = GLP + (size_t)(bh * 64 + n) * GL_ITEM; const bf16_t* it = (const bf16_t*)itb;
#pragma unroll
        for (int ks = 0; ks < 4; ++ks) f.qf[ks] = *(const bf16x8*)(it + (mt * 16 + fr) * 128 + ks * 32 + fq * 8);
#pragma unroll
        for (int ks = 0; ks < 2; ++ks) { f.af[ks] = *(const bf16x8*)(it + 16384 + (mt * 16 + fr) * 64 + ks * 32 + fq * 8); f.kf[ks] = *(const bf16x8*)(it + 8192 + (wv * 16 + fr) * 64 + ks * 32 + fq * 8); }
#pragma unroll
        for (int e = 0; e < 4; ++e)
#pragma unroll
            for (int ks = 0; ks < 2; ++ks) f.vB[e][ks] = *(const bf16x8*)(it + 20480 + (es * 64 + e * 16 + fr) * 64 + ks * 32 + fq * 8);
        f.al = *(const f32x4*)((const float*)(itb + 73728) + wv * 16 + fq * 4);
        return f; };
    GF cf = gload(0);
#pragma unroll 1
    for (int n = 0; n < 64; ++n) {
        const GF nf = gload(n < 63 ? n + 1 : 63);
        LAS bf16_t* cur = STb + (n & 1) * (64 * 136);
        LAS bf16_t* nxt = STb + ((n + 1) & 1) * (64 * 136);
        const bf16x8 (&qf)[4] = cf.qf; const bf16x8 (&af)[2] = cf.af; const bf16x8 (&kf)[2] = cf.kf; const bf16x8 (&vB)[4][2] = cf.vB; const f32x4 al = cf.al;
        bf16x8 vO[2][2];
#pragma unroll
        for (int e2 = 0; e2 < 2; ++e2)
#pragma unroll
            for (int ks = 0; ks < 2; ++ks) vO[e2][ks] = eh ? vB[2 + e2][ks] : vB[e2][ks];
#pragma unroll
        for (int e2 = 0; e2 < 2; ++e2) {
            const int etile = eh * 2 + e2;
            f32x4 O = {0.f, 0.f, 0.f, 0.f};
#pragma unroll
            for (int ks = 0; ks < 4; ++ks) { const bf16x8 bfr = *(const LAS bf16x8*)(cur + (etile * 16 + fr) * 136 + ks * 32 + fq * 8); O = mfma16(qf[ks], bfr, O); }
#pragma unroll
            for (int ks = 0; ks < 2; ++ks) O = mfma16(af[ks], vO[e2][ks], O);
#pragma unroll
            for (int r = 0; r < 4; ++r) OB[((size_t)b * SEQ + n * 64 + mt * 16 + fq * 4 + r) * 1024 + h * 256 + es * 64 + etile * 16 + fr] = f2bf(O[r]);
        }
#pragma unroll
        for (int e = 0; e < 4; ++e) {
            S[e] *= al;
#pragma unroll
            for (int ks = 0; ks < 2; ++ks) S[e] = mfma16(kf[ks], vB[e][ks], S[e]);
            *(LAS u32x2*)(nxt + (e * 16 + fr) * 136 + wv * 16 + fq * 4) = pk4(S[e]);
        }
        __syncthreads();
        cf = nf;
    }
}

__device__ __forceinline__ void s5_scan(LAS unsigned char* ldsw, PPtr p, int layer, int b, int g, const int wid_s) {
    const int lane = fresh_tid(wid_s) & 63, fr = lane & 15, fq = lane >> 4;
    bf16_t* Z = (bf16_t*)(p->ws + WS_Z);
    const float* lam_re = p->in[14] + (size_t)(layer * 64 + g) * 64;
    const float* lam_im = p->in[15] + (size_t)(layer * 64 + g) * 64;
    const float dt = expf(p->in[16][layer * 64 + g]);
    const float* b_re = p->in[17] + (size_t)(layer * 64 + g) * 64 * 16;
    const float* b_im = p->in[18] + (size_t)(layer * 64 + g) * 64 * 16;
    const float* c_re = p->in[19] + (size_t)(layer * 64 + g) * 16 * 64;
    const float* c_im = p->in[20] + (size_t)(layer * 64 + g) * 16 * 64;
    const float dsk = p->in[21][layer * 1024 + g * 16 + fr];
    float ar, ai;
    { const float lr = fminf(lam_re[lane], -1e-4f), li = lam_im[lane]; const float mag = expf(lr * dt); ar = mag * cosf(li * dt); ai = mag * sinf(li * dt); }
    bf16x8 bB[8];
#pragma unroll
    for (int nt = 0; nt < 8; ++nt) {
        const int pp = (nt * 16 + fr) & 63;
        const float lr = fminf(lam_re[pp], -1e-4f), li = lam_im[pp]; const float mag = expf(lr * dt);
        const float a_r = mag * cosf(li * dt), a_i = mag * sinf(li * dt), nr = a_r - 1.f, den = lr * lr + li * li;
        const float zr = (nr * lr + a_i * li) / den, zi = (a_i * lr - nr * li) / den;
        float v[8];
#pragma unroll
        for (int j = 0; j < 8; ++j) {
            float val = 0.f;
            if (fq < 2) { const float br = b_re[pp * 16 + fq * 8 + j], bi = b_im[pp * 16 + fq * 8 + j]; val = (nt >= 4) ? (zr * bi + zi * br) : (zr * br - zi * bi); }
            v[j] = val;
        }
        u32x4 o; o.x = pk_bf16(v[0], v[1]); o.y = pk_bf16(v[2], v[3]); o.z = pk_bf16(v[4], v[5]); o.w = pk_bf16(v[6], v[7]);
        bB[nt] = __builtin_bit_cast(bf16x8, o);
    }
    bf16x8 cB[4];
#pragma unroll
    for (int ks = 0; ks < 4; ++ks) {
        const int kb = ks * 32 + fq * 8;
        float v[8];
#pragma unroll
        for (int j = 0; j < 8; ++j) v[j] = (ks < 2) ? c_re[fr * 64 + kb + j] : -c_im[fr * 64 + kb - 64 + j];
        u32x4 o; o.x = pk_bf16(v[0], v[1]); o.y = pk_bf16(v[2], v[3]); o.z = pk_bf16(v[4], v[5]); o.w = pk_bf16(v[6], v[7]);
        cB[ks] = __builtin_bit_cast(bf16x8, o);
    }
    LAS float* BU = (LAS float*)ldsw;
    LAS bf16_t* X = (LAS bf16_t*)(ldsw + 8192);
    float xr = 0.f, xi = 0.f;
    struct UF { u32x4 ur; bf16_t ue[4]; };
    auto uload = [&](int tile) __attribute__((always_inline)) {
        UF f; const size_t row0 = (size_t)b * SEQ + tile * 16;
        f.ur = (u32x4){0u, 0u, 0u, 0u};
        if (fq < 2) f.ur = *(const u32x4*)(Z + (row0 + fr) * ZW + SU + g * 16 + fq * 8);
#pragma unroll
        for (int r = 0; r < 4; ++r) f.ue[r] = Z[(row0 + fq * 4 + r) * ZW + SU + g * 16 + fr];
        return f; };
    UF u0 = uload(0), u1 = uload(1);
#pragma unroll 1
    for (int tile = 0; tile < 256; ++tile) {
        const size_t row0 = (size_t)b * SEQ + tile * 16;
        const UF u2 = uload(tile < 254 ? tile + 2 : 255);
        const bf16x8 ua = __builtin_bit_cast(bf16x8, u0.ur);
#pragma unroll
        for (int nt = 0; nt < 8; ++nt) {
            f32x4 acc = {0.f, 0.f, 0.f, 0.f};
            acc = mfma16(ua, bB[nt], acc);
#pragma unroll
            for (int r = 0; r < 4; ++r) BU[(fq * 4 + r) * 128 + nt * 16 + fr] = acc[r];
        }
        asm volatile("s_waitcnt lgkmcnt(0)" ::: "memory");
#pragma unroll
        for (int tt = 0; tt < 16; ++tt) {
            const float bur = BU[tt * 128 + lane], bui = BU[tt * 128 + 64 + lane];
            const float nxr = ar * xr - ai * xi + bur, nxi = ar * xi + ai * xr + bui;
            xr = nxr; xi = nxi;
            X[tt * 136 + lane] = f2bf(xr); X[tt * 136 + 64 + lane] = f2bf(xi);
        }
        asm volatile("s_waitcnt lgkmcnt(0)" ::: "memory");
        f32x4 acc = {0.f, 0.f, 0.f, 0.f};
#pragma unroll
        for (int ks = 0; ks < 4; ++ks) { const bf16x8 xa = *(const LAS bf16x8*)(X + fr * 136 + ks * 32 + fq * 8); acc = mfma16(xa, cB[ks], acc); }
#pragma unroll
        for (int r = 0; r < 4; ++r) {
            bf16_t* zp = Z + (row0 + fq * 4 + r) * ZW + ZQ + g * 16 + fr;
            const float u = bf2f(u0.ue[r]);
            *zp = f2bf(geluf_(acc[r] + dsk * u));
        }
        asm volatile("s_waitcnt lgkmcnt(0)" ::: "memory");
        u0 = u1; u1 = u2;
    }
}

template <int W> __device__ void head_norm_gate(bf16_t* O, const bf16_t* Zg  , const float* nw, const int wid_s) {
    constexpr int LPG = W / 8;
    const size_t ngroups = (size_t)MTOK * (1024 / W);
    const int t_ = fresh_tid(wid_s), lane_ = t_ & 63;
    const size_t gthreads = (size_t)fresh_gdim() * 512, gid = (size_t)fresh_bid() * 512 + t_;
    for (size_t idx = gid; idx < ngroups * LPG; idx += gthreads) {
        const size_t grp = idx / LPG; const int l = (int)(idx % LPG);
        const size_t row = grp / (1024 / W); const int hh = (int)(grp % (1024 / W));
        const int col = hh * W + l * 8;
        bf16_t* op = O + row * 1024 + col;
        const u32x4 w = *(const u32x4*)op;
        float v[8] = {lo_bf(w.x), hi_bf(w.x), lo_bf(w.y), hi_bf(w.y), lo_bf(w.z), hi_bf(w.z), lo_bf(w.w), hi_bf(w.w)};
        float ss = 0.f;
#pragma unroll
        for (int c = 0; c < 8; ++c) ss += v[c] * v[c];
#pragma unroll
        for (int o = 1; o < LPG; o <<= 1) ss += shx(ss, o, lane_);
        const float inv = rsqrtf(ss * (1.f / W) + EPS);
        const u32x4 gz = *(const u32x4*)(Zg + row * ZW + col);
        const float gzv[8] = {lo_bf(gz.x), hi_bf(gz.x), lo_bf(gz.y), hi_bf(gz.y), lo_bf(gz.z), hi_bf(gz.z), lo_bf(gz.w), hi_bf(gz.w)};
#pragma unroll
        for (int c = 0; c < 8; ++c) v[c] = v[c] * inv * nw[l * 8 + c] * siluf_(gzv[c]);
        u32x4 o; o.x = pk_bf16(v[0], v[1]); o.y = pk_bf16(v[2], v[3]); o.z = pk_bf16(v[4], v[5]); o.w = pk_bf16(v[6], v[7]);
        *(u32x4*)op = o;
    }
}

__device__ void xattn(LAS unsigned char* lds, const bf16_t* XQ, const bf16_t* Kb, const bf16_t* VTg, bf16_t* XO, const int wid_s) {
    const int t = fresh_tid(wid_s), wv = t >> 6, lane = t & 63, fr = lane & 15, fq = lane >> 4;
    LAS bf16_t* Pw = (LAS bf16_t*)(lds + wv * 8448);
    for (int item = fresh_bid(); item < 512; item += fresh_gdim()) {
        const int qt = item & 31, hd = (item >> 5) & 3, b = item >> 7;
        const size_t r0 = (size_t)b * SEQ + qt * 128 + wv * 16;
        bf16x8 qf[4];
#pragma unroll
        for (int ks = 0; ks < 4; ++ks) qf[ks] = *(const bf16x8*)(XQ + (r0 + fr) * 512 + hd * 128 + ks * 32 + fq * 8);
        f32x4 s[16];
#pragma unroll
        for (int nt = 0; nt < 16; ++nt) {
            f32x4 a = {0.f, 0.f, 0.f, 0.f};
#pragma unroll
            for (int ks = 0; ks < 4; ++ks) { const bf16x8 kfr = *(const bf16x8*)(Kb + ((size_t)b * 256 + nt * 16 + fr) * 512 + hd * 128 + ks * 32 + fq * 8); a = mfma16(qf[ks], kfr, a); }
            s[nt] = a * 0.08838834764831845f;
        }
        float mx[4], sm[4];
#pragma unroll
        for (int r = 0; r < 4; ++r) {
            float m = s[0][r];
#pragma unroll
            for (int nt = 1; nt < 16; ++nt) m = fmaxf(m, s[nt][r]);
            m = fmaxf(m, shx(m, 1, lane)); m = fmaxf(m, shx(m, 2, lane)); m = fmaxf(m, shx(m, 4, lane)); m = fmaxf(m, shx(m, 8, lane));
            mx[r] = m;
            float su = 0.f;
#pragma unroll
            for (int nt = 0; nt < 16; ++nt) { const float e = __expf(s[nt][r] - m); s[nt][r] = e; su += e; }
            su += shx(su, 1, lane); su += shx(su, 2, lane); su += shx(su, 4, lane); su += shx(su, 8, lane);
            sm[r] = 1.f / su;
        }
#pragma unroll
        for (int nt = 0; nt < 16; ++nt)
#pragma unroll
            for (int r = 0; r < 4; ++r) Pw[(fq * 4 + r) * 264 + nt * 16 + fr] = f2bf(s[nt][r] * sm[r]);
        __syncthreads();
        bf16x8 pf[8];
#pragma unroll
        for (int ks = 0; ks < 8; ++ks) pf[ks] = *(const LAS bf16x8*)(Pw + fr * 264 + ks * 32 + fq * 8);
#pragma unroll
        for (int dtile = 0; dtile < 8; ++dtile) {
            f32x4 o = {0.f, 0.f, 0.f, 0.f};
#pragma unroll
            for (int ks = 0; ks < 8; ++ks) { const bf16x8 vfr = *(const bf16x8*)(VTg + ((size_t)(b * 4 + hd) * 128 + dtile * 16 + fr) * 256 + ks * 32 + fq * 8); o = mfma16(pf[ks], vfr, o); }
#pragma unroll
            for (int r = 0; r < 4; ++r) XO[(r0 + fq * 4 + r) * 512 + hd * 128 + dtile * 16 + fr] = f2bf(o[r]);
        }
        __syncthreads();
    }
}

__device__ void ffn_act(const bf16_t* G, const bf16_t* U, const float* cw, bf16_t* ACT, const int wid_s) {
    const unsigned nitems = (unsigned)(FF / 8) * (MTOK / 16);
    const unsigned gthreads = (unsigned)fresh_gdim() * 512u, gid = (unsigned)fresh_bid() * 512u + (unsigned)fresh_tid(wid_s);
    for (unsigned idx = gid; idx < nitems; idx += gthreads) {
        const unsigned cg = idx % (FF / 8), tb = idx / (FF / 8);
        const unsigned c0 = cg * 8, t0 = tb * 16;
        float w0[8], w1[8], w2[8];
#pragma unroll
        for (int c = 0; c < 8; ++c) { w0[c] = cw[(c0 + c) * 3]; w1[c] = cw[(c0 + c) * 3 + 1]; w2[c] = cw[(c0 + c) * 3 + 2]; }
        float g2[8], g1[8];
        const bool start = (t0 & (SEQ - 1)) == 0;
        const unsigned base = t0 * FF + c0;
        { u32x4 a = {0u, 0u, 0u, 0u}, bq = {0u, 0u, 0u, 0u};
          if (!start) { a = *(const u32x4*)(G + (base - 2 * FF)); bq = *(const u32x4*)(G + (base - FF)); }
          g2[0] = lo_bf(a.x); g2[1] = hi_bf(a.x); g2[2] = lo_bf(a.y); g2[3] = hi_bf(a.y); g2[4] = lo_bf(a.z); g2[5] = hi_bf(a.z); g2[6] = lo_bf(a.w); g2[7] = hi_bf(a.w);
          g1[0] = lo_bf(bq.x); g1[1] = hi_bf(bq.x); g1[2] = lo_bf(bq.y); g1[3] = hi_bf(bq.y); g1[4] = lo_bf(bq.z); g1[5] = hi_bf(bq.z); g1[6] = lo_bf(bq.w); g1[7] = hi_bf(bq.w); }
#pragma unroll 4
        for (unsigned tt = 0; tt < 16; ++tt) {
            const unsigned off = base + tt * FF;
            const u32x4 a = *(const u32x4*)(G + off);
            const u32x4 uq = *(const u32x4*)(U + off);
            const float g0[8] = {lo_bf(a.x), hi_bf(a.x), lo_bf(a.y), hi_bf(a.y), lo_bf(a.z), hi_bf(a.z), lo_bf(a.w), hi_bf(a.w)};
            const float uu[8] = {lo_bf(uq.x), hi_bf(uq.x), lo_bf(uq.y), hi_bf(uq.y), lo_bf(uq.z), hi_bf(uq.z), lo_bf(uq.w), hi_bf(uq.w)};
            float r[8];
#pragma unroll
            for (int c = 0; c < 8; ++c) { const float y = w0[c] * g2[c] + w1[c] * g1[c] + w2[c] * g0[c]; r[c] = geluf_(y) * uu[c]; g2[c] = g1[c]; g1[c] = g0[c]; }
            u32x4 o; o.x = pk_bf16(r[0], r[1]); o.y = pk_bf16(r[2], r[3]); o.z = pk_bf16(r[4], r[5]); o.w = pk_bf16(r[6], r[7]);
            *(u32x4*)(ACT + off) = o;
        }
    }
}

__device__ void ffn_fix(const bf16_t* GB, const bf16_t* UB, const float* cw, bf16_t* ACT, const int wid_s) {
    const unsigned nitems = 256u * 2u * (FF / 8);
    const unsigned gthreads = (unsigned)fresh_gdim() * 512u, gid = (unsigned)fresh_bid() * 512u + (unsigned)fresh_tid(wid_s);
    for (unsigned idx = gid; idx < nitems; idx += gthreads) {
        const unsigned cg = idx % (FF / 8), rest = idx / (FF / 8), rr = rest & 1u, rb = rest >> 1;
        const unsigned c0 = cg * 8;
        const bool first = (rb & 63u) == 0u;
        const u32x4 zero = {0u, 0u, 0u, 0u};
        const u32x4 a0 = *(const u32x4*)(GB + (size_t)(rb * 4 + 2 + rr) * FF + c0);
        u32x4 a1, a2;
        if (rr == 0) { a1 = first ? zero : *(const u32x4*)(GB + (size_t)((rb - 1) * 4 + 1) * FF + c0); a2 = first ? zero : *(const u32x4*)(GB + (size_t)((rb - 1) * 4 + 0) * FF + c0); }
        else         { a1 = *(const u32x4*)(GB + (size_t)(rb * 4 + 2) * FF + c0);                     a2 = first ? zero : *(const u32x4*)(GB + (size_t)((rb - 1) * 4 + 1) * FF + c0); }
        const u32x4 uq = *(const u32x4*)(UB + (size_t)(rb * 2 + rr) * FF + c0);
        const float g0[8] = {lo_bf(a0.x), hi_bf(a0.x), lo_bf(a0.y), hi_bf(a0.y), lo_bf(a0.z), hi_bf(a0.z), lo_bf(a0.w), hi_bf(a0.w)};
        const float g1[8] = {lo_bf(a1.x), hi_bf(a1.x), lo_bf(a1.y), hi_bf(a1.y), lo_bf(a1.z), hi_bf(a1.z), lo_bf(a1.w), hi_bf(a1.w)};
        const float g2[8] = {lo_bf(a2.x), hi_bf(a2.x), lo_bf(a2.y), hi_bf(a2.y), lo_bf(a2.z), hi_bf(a2.z), lo_bf(a2.w), hi_bf(a2.w)};
        const float uu[8] = {lo_bf(uq.x), hi_bf(uq.x), lo_bf(uq.y), hi_bf(uq.y), lo_bf(uq.z), hi_bf(uq.z), lo_bf(uq.w), hi_bf(uq.w)};
        float r[8];
#pragma unroll
        for (int c = 0; c < 8; ++c) { const float y = cw[(c0 + c) * 3] * g2[c] + cw[(c0 + c) * 3 + 1] * g1[c] + cw[(c0 + c) * 3 + 2] * g0[c]; r[c] = geluf_(y) * uu[c]; }
        u32x4 o; o.x = pk_bf16(r[0], r[1]); o.y = pk_bf16(r[2], r[3]); o.z = pk_bf16(r[4], r[5]); o.w = pk_bf16(r[6], r[7]);
        *(u32x4*)(ACT + (size_t)(rb * 64 + rr) * FF + c0) = o;
    }
}

__device__ void convert_layer_small(LAS float* ldsf, PPtr p, int l, const int wid_s) {
    unsigned char* ws = p->ws;
    convert_w(ldsf, p->in[4] + (size_t)l * 2048 * 14368, (bf16_t*)(ws + WS_WA), 2048, 14368, ZN, 1, wid_s);
    convert_w(ldsf, p->in[9] + (size_t)l * 1024 * 2048, (bf16_t*)(ws + WS_WDN), 1024, 2048, 2048, 0, wid_s);
    convert_w(ldsf, p->in[13] + (size_t)l * 1024 * 2048, (bf16_t*)(ws + WS_WGLA), 1024, 2048, 2048, 0, wid_s);
    convert_w(ldsf, p->in[22] + (size_t)l * 1024 * 4096, (bf16_t*)(ws + WS_WGLU), 1024, 4096, 4096, 2, wid_s);
    convert_w(ldsf, p->in[23] + (size_t)l * 2048 * 2048, (bf16_t*)(ws + WS_WMIX), 2048, 2048, 2048, 0, wid_s);
    convert_w(ldsf, p->in[27] + (size_t)l * 2048 * 512, (bf16_t*)(ws + WS_WXQ), 2048, 512, 512, 0, wid_s);
    convert_w(ldsf, p->in[28] + (size_t)l * 2048 * 1024, (bf16_t*)(ws + WS_WXKV), 2048, 1024, 1024, 0, wid_s);
    convert_w(ldsf, p->in[29] + (size_t)l * 512 * 2048, (bf16_t*)(ws + WS_WXO), 512, 2048, 2048, 0, wid_s);
}
__device__ void convert_layer_ffn(LAS float* ldsf, PPtr p, int l, const int wid_s, int nb, int bi) {
    unsigned char* ws = p->ws;
    convert_w(ldsf, p->in[32] + (size_t)l * 2048 * 11264, (bf16_t*)(ws + WS_WA), 2048, 11264, 11264, 3, wid_s, nb, bi);
    convert_w(ldsf, p->in[34] + (size_t)l * 5632 * 2048, (bf16_t*)(ws + WS_WA + 46137344), 5632, 2048, 2048, 0, wid_s, nb, bi);
}


#ifdef DEBUG_NAN
__device__ __noinline__ void chk_f32(const float* q, size_t n, unsigned bit, unsigned* flag) {
    const size_t gthreads = (size_t)gridDim.x * 512, gid = (size_t)blockIdx.x * 512 + threadIdx.x; bool bad = false;
    for (size_t i = gid; i < n; i += gthreads) { const float v = q[i]; if (!(fabsf(v) < 1e30f)) bad = true; }
    if (bad) atomicOr(flag, 1u << bit);
}
__device__ __noinline__ void chk_bf16(const bf16_t* q, size_t n, unsigned bit, unsigned* flag) {
    const size_t gthreads = (size_t)gridDim.x * 512, gid = (size_t)blockIdx.x * 512 + threadIdx.x; bool bad = false;
    for (size_t i = gid; i < n; i += gthreads) { const float v = bf2f(q[i]); if (!(fabsf(v) < 1e30f)) bad = true; }
    if (bad) atomicOr(flag, 1u << bit);
}
#define CHKF(ptr, n, bit) do { if (l == DEBUG_NAN - 1) { chk_f32(ptr, n, bit, (unsigned*)(PP()->ws + WS_MISC + 32768)); } gsync(grid); } while (0)
#define CHKB(ptr, n, bit) do { if (l == DEBUG_NAN - 1) { chk_bf16(ptr, n, bit, (unsigned*)(PP()->ws + WS_MISC + 32768)); } xbar(wid_s); } while (0)
#else
#define CHKF(ptr, n, bit) do {} while (0)
#define CHKB(ptr, n, bit) do {} while (0)
#endif
#ifdef DEBUG_TS
__device__ __forceinline__ bool ts_in(const int* sel, int n, int k) { for (int q = 0; q < n; ++q) if (sel[q] == k) return true; return false; }
#define TS(k) do { const unsigned long long t_ = __builtin_amdgcn_s_memrealtime(); const int selA_[] = DEBUG_TS_A; const int selB_[] = DEBUG_TS_B; \
    const int kk_ = (k) % 20; \
    if (ts_in(selA_, (int)(sizeof(selA_) / sizeof(int)), kk_)) tsA += t_ - tsL; if (ts_in(selB_, (int)(sizeof(selB_) / sizeof(int)), kk_)) tsB += t_ - tsL; tsL = t_; } while (0)
#else
#define TS(k) do {} while (0)
#endif
#ifndef PMASK
#define PMASK 0xFFFFFFFFu
#endif
#define ON(k) ((PMASK >> (k)) & 1u)
constexpr size_t WS_LIMIT = 941621248;
static_assert(WS_END <= WS_LIMIT, "workspace map exceeds the guaranteed workspace size");
static_assert(WS_DNP + (size_t)MTOK * FF * 2 <= WS_MISC, "ACT does not fit");
static_assert((size_t)MTOK * FF * 2 * 2 <= SZ_Z, "G,U do not fit in Z");

#define m_ws (PP()->ws)
#define m_Z ((bf16_t*)(m_ws + WS_Z))
#define m_Y ((bf16_t*)(m_ws + WS_Z))
#define m_SMp ((float*)(m_ws + WS_SM))
#define m_H ((bf16_t*)(m_ws + WS_H))
#define m_OA m_H
#define m_OB (m_H + (size_t)MTOK * 1024)
#define m_MRG ((float*)(m_ws + WS_DNP))
#define m_XQ ((bf16_t*)(m_ws + WS_DNP))
#define m_XO ((bf16_t*)(m_ws + WS_DNP + (size_t)MTOK * 512 * 2))
#define m_ACT ((bf16_t*)(m_ws + WS_DNP))
#define m_MB ((bf16_t*)(m_ws + WS_GLP))
#define m_MEMN ((bf16_t*)(m_ws + WS_GLP))
#define m_KB ((bf16_t*)(m_ws + WS_GLP + 4194304))
#define m_VTG ((bf16_t*)(m_ws + WS_GLP + 5242880))
#define m_G ((bf16_t*)(m_ws + WS_Z))
#define m_U ((bf16_t*)(m_ws + WS_Z + 16777216))
#define m_xs ((bf16_t*)(m_ws + WS_XS))
#define m_out (PP()->out)
#define p PP()
__global__ void __launch_bounds__(512, 2) fwd_megakernel(Params p_unused) {
    extern __shared__ __attribute__((aligned(16))) unsigned char lds_raw[];
    LAS unsigned char* lds = (LAS unsigned char*)lds_raw;
    LAS float* ldsf = (LAS float*)lds_raw;
    cg::grid_group grid = cg::this_grid();
    if ((threadIdx.x & 63) == 0) ((LAS int*)(lds + 131072))[__builtin_amdgcn_s_getreg(10244) & 63] = (int)(threadIdx.x >> 6);
    { unsigned* bar0 = (unsigned*)(PP()->ws + WS_BAR);
      if (threadIdx.x == 0) { volatile LAS unsigned* st = (volatile LAS unsigned*)(lds + XB_LDS_OFF); st[0] = 0u; st[1] = 0u;
          (void)xb_add(&bar0[XB_XCNT(xb_xcc_id())], 1u); } }
    __syncthreads();
    constexpr int wid_s = 0;
#ifdef DEBUG_TS
    unsigned long long tsA = 0ull, tsB = 0ull, tsL = __builtin_amdgcn_s_memrealtime();
#endif
    if (ON(0)) convert_layer_small(ldsf, p, 0, wid_s);
    if (ON(1)) norm_rows(p->in[0], nullptr, nullptr, nullptr, nullptr, m_xs, p->in[2], m_H, MTOK, wid_s);
    if (PP()->ws == nullptr) grid.sync();
    xbar(wid_s); TS(0);

#pragma unroll 1
    for (int l = 0; l < 2; ++l) {
        if (ON(2)) { EpiZ e; e.Z = m_Z; e.SMp = m_SMp; run_gemm(lds, m_H, DM, (const bf16_t*)(m_ws + WS_WA), MTOK, ZN, DM, e, wid_s); }
#ifdef REPEAT_PH1
        { EpiZ e; e.Z = m_Z; e.SMp = m_SMp; run_gemm(lds, m_H, DM, (const bf16_t*)(m_ws + WS_WA), MTOK, ZN, DM, e, wid_s); }
#endif
        xbar(wid_s); TS(l * 20 + 1);

#ifdef DEBUG_Z
        {
            unsigned long long* cw = (unsigned long long*)(PP()->ws + WS_MISC + 32768);
            const size_t gthreads = (size_t)gridDim.x * 512, gid = (size_t)blockIdx.x * 512 + threadIdx.x;
            const bf16_t* zz = m_Z; const bf16_t* wa = (const bf16_t*)(m_ws + WS_WA);
            unsigned long long c = 0, mi = ~0ull, cwa = 0;
            for (size_t i = gid; i < (size_t)MTOK * ZW; i += gthreads) { const float v = bf2f(zz[i]); if (!(fabsf(v) < 1e30f)) { ++c; if (i < mi) mi = i; } }
            for (size_t i = gid; i < (size_t)ZN * 2048; i += gthreads) { const float v = bf2f(wa[i]); if (!(fabsf(v) < 1e30f)) ++cwa; }
            if (c) { atomicAdd(cw, c); atomicMin(cw + 1, mi); }
            if (cwa) atomicAdd(cw + 2, cwa);
            xbar(wid_s);
            const unsigned long long C = cw[0], MI = cw[1], WB = cw[2];
            const int pnf = (int)((MI % ZW) / 256), pmf = (int)((MI / ZW) / 256);
            const int wb = WB == 0 ? 0 : (WB < 1000 ? 1 : 2), zb = C < 10000 ? 0 : (C < 10000000 ? 1 : 2);
            const float e1 = exp10f(10.f + (float)(pmf / 4));
            const float v1 = (10.f + pnf) * e1, v2 = (10.f + 10.f * (3 * wb + zb)) * e1 * 0.01f;
            float* o = PP()->out;
            for (size_t i = gid; i < (size_t)MTOK * DM; i += gthreads) o[i] = (i == 0) ? v1 : v2;
            return;
        }
#endif

        CHKB(m_H, (size_t)MTOK * DM, 0); CHKB(m_Z, (size_t)MTOK * ZW, 1); CHKF(m_SMp, (size_t)MTOK * 32, 2);
        if (ON(3)) dn_prep(lds, p, l, wid_s);
        if (ON(4)) gla_prep(lds, p, l, wid_s);
        xbar(wid_s); TS(l * 20 + 2);
        CHKB((const bf16_t*)(m_ws + WS_DNP), (size_t)DN_ITEM * 1024, 3); CHKB((const bf16_t*)(m_ws + WS_GLP), (size_t)GL_ITEM * 512, 4);
        for (int role = blockIdx.x; role < 256; role += gridDim.x) {
            if (role < 128) { if (ON(5)) dn_scan(lds, p, role >> 2, role & 3, wid_s); }
            else if (role < 192) { if (ON(6)) gla_scan(lds, p, (role - 128) >> 2, (role - 128) & 3, wid_s); }
            else { const int wv = fresh_tid(wid_s) >> 6; if (ON(7) && wv < 4) { const int pair = (role - 192) * 4 + wv; s5_scan(lds + wv * 12544, p, l, pair >> 6, pair & 63, wid_s); } }
            __syncthreads();
        }
        { const int bid_ = fresh_bid(), gd_ = fresh_gdim(), nbc = gd_ >= 256 ? 192 : gd_; if (ON(0) && bid_ < nbc) convert_layer_ffn(ldsf, p, l, wid_s, nbc, bid_); }
        xbar(wid_s); TS(l * 20 + 3);
#ifdef REPEAT_PH3
        for (int role = blockIdx.x; role < 256; role += gridDim.x) {
            if (role < 128) { if (ON(5)) dn_scan(lds, p, role >> 2, role & 3, wid_s); }
            else if (role < 192) { if (ON(6)) gla_scan(lds, p, (role - 128) >> 2, (role - 128) & 3, wid_s); }
            else { const int wv = fresh_tid(wid_s) >> 6; if (ON(7) && wv < 4) { const int pair = (role - 192) * 4 + wv; s5_scan(lds + wv * 12544, p, l, pair >> 6, pair & 63, wid_s); } }
            __syncthreads();
        }
        xbar(wid_s);
#endif
        CHKB(m_OA, (size_t)MTOK * 1024, 5); CHKB(m_OB, (size_t)MTOK * 1024, 6); CHKB(m_Z, (size_t)MTOK * ZW, 7);
        if (ON(8)) head_norm_gate<128>(m_OA, m_Z + ZZ, p->in[8] + l * 128, wid_s);
        if (ON(8)) head_norm_gate<256>(m_OB, m_Z + GR, p->in[12] + l * 256, wid_s);
        if (ON(9)) { EpiGLU e; e.Z = m_Z; e.MRG = m_MRG; run_gemm(lds, m_Z + ZQ, ZW, (const bf16_t*)(m_ws + WS_WGLU), MTOK, 4096, 1024, e, wid_s); }
        xbar(wid_s); TS(l * 20 + 4);
        CHKB(m_OA, (size_t)MTOK * 2048, 8); CHKF(m_MRG, (size_t)MTOK * DM, 9);
        if (ON(10)) { EpiAcc<false> e; e.Z = m_Z; e.MRG = m_MRG; e.MB = nullptr; e.goff = 0; run_gemm(lds, m_OA, 1024, (const bf16_t*)(m_ws + WS_WDN), MTOK, DM, 1024, e, wid_s); }
        if (ON(10)) { EpiAcc<true> e; e.Z = m_Z; e.MRG = m_MRG; e.MB = m_MB; e.goff = 2048; run_gemm(lds, m_OB, 1024, (const bf16_t*)(m_ws + WS_WGLA), MTOK, DM, 1024, e, wid_s); }
        xbar(wid_s); TS(l * 20 + 5);
        CHKB(m_MB, (size_t)MTOK * DM, 10);
        if (ON(11)) { EpiBf16 e; e.C = m_Y; e.ldc = DM; run_gemm(lds, m_MB, DM, (const bf16_t*)(m_ws + WS_WMIX), MTOK, DM, DM, e, wid_s); }
        xbar(wid_s); TS(l * 20 + 6);
        CHKF(m_Y, (size_t)MTOK * DM, 11);
        if (ON(1)) norm_rows(nullptr, m_xs, m_Y, p->in[3] + l * DM, nullptr, m_xs, p->in[24] + l * DM, m_H, MTOK, wid_s);
        if (ON(1)) norm_rows(p->in[1], nullptr, nullptr, nullptr, nullptr, nullptr, p->in[26] + l * DM, m_MEMN, 1024, wid_s);
        xbar(wid_s); TS(l * 20 + 7);
        CHKB(m_xs, (size_t)MTOK * DM, 12); CHKB(m_H, (size_t)MTOK * DM, 13);
        if (ON(12)) { EpiBf16 e; e.C = m_XQ; e.ldc = 512; run_gemm(lds, m_H, DM, (const bf16_t*)(m_ws + WS_WXQ), MTOK, 512, DM, e, wid_s); }
        if (ON(13)) { EpiKV e; e.Kb = m_KB; e.VT = m_VTG; run_gemm(lds, m_MEMN, DM, (const bf16_t*)(m_ws + WS_WXKV), 1024, 1024, DM, e, wid_s, 128); }
        xbar(wid_s); TS(l * 20 + 8);
        CHKB(m_XQ, (size_t)MTOK * 512, 14); CHKB(m_KB, (size_t)1024 * 1024, 15);
        if (ON(14)) xattn(lds, m_XQ, m_KB, m_VTG, m_XO, wid_s);
        xbar(wid_s); TS(l * 20 + 9);
        CHKB(m_XO, (size_t)MTOK * 512, 16);
        if (ON(11)) { EpiBf16 e; e.C = m_Y; e.ldc = DM; run_gemm(lds, m_XO, 512, (const bf16_t*)(m_ws + WS_WXO), MTOK, DM, 512, e, wid_s); }
        xbar(wid_s); TS(l * 20 + 10);
        CHKF(m_Y, (size_t)MTOK * DM, 17);
        if (ON(1)) norm_rows(nullptr, m_xs, m_Y, p->in[25] + l * DM, nullptr, m_xs, p->in[30] + l * DM, m_H, MTOK, wid_s);
        xbar(wid_s); TS(l * 20 + 11);
        CHKB(m_xs, (size_t)MTOK * DM, 18);
        if (ON(15)) { EpiFFN e; e.ACT = m_ACT; e.GB = m_G; e.UB = m_U; e.cw = p->in[33] + (size_t)l * FF * 3; run_gemm(lds, m_H, DM, (const bf16_t*)(m_ws + WS_WA), MTOK, 2 * FF, DM, e, wid_s); }
        xbar(wid_s); TS(l * 20 + 12);
        CHKB(m_G, (size_t)MTOK * FF * 2, 19);
        if (ON(16)) ffn_fix(m_G, m_U, p->in[33] + (size_t)l * FF * 3, m_ACT, wid_s);
        xbar(wid_s); TS(l * 20 + 13);
        CHKB(m_ACT, (size_t)MTOK * FF, 20);
        if (ON(11)) { EpiBf16 e; e.C = m_Y; e.ldc = DM; run_gemm(lds, m_ACT, FF, (const bf16_t*)(m_ws + WS_WA + 46137344), MTOK, DM, FF, e, wid_s); }
        xbar(wid_s); TS(l * 20 + 14);
        CHKF(m_Y, (size_t)MTOK * DM, 21);
        if (l == 0) {
            if (ON(1)) norm_rows(nullptr, m_xs, m_Y, p->in[31] + l * DM, nullptr, m_xs, p->in[2] + DM, m_H, MTOK, wid_s);
            if (ON(0)) convert_layer_small(ldsf, p, 1, wid_s);
        } else {
            if (ON(1)) norm_rows(nullptr, m_xs, m_Y, p->in[31] + l * DM, m_out, nullptr, nullptr, nullptr, MTOK, wid_s);
        }
        xbar(wid_s); TS(l * 20 + 15);
        }
#ifdef DEBUG_TS
    {   const float A = (float)tsA * 0.01f, B = (float)tsB * 0.01f;
        xbar(wid_s);
        const unsigned gthreads = (unsigned)fresh_gdim() * 512u, gid = (unsigned)fresh_bid() * 512u + (unsigned)fresh_tid(wid_s);
        float* o = PP()->out;
        for (unsigned i = gid; i < (unsigned)MTOK * DM; i += gthreads) o[i] = (i == 0u) ? B * 10000.f : A;
    }
#endif
#ifdef DEBUG_NAN
    { const unsigned f = *(volatile unsigned*)(PP()->ws + WS_MISC + 32768); int idx = -1; for (int k = 0; k < 32; ++k) if ((f >> k) & 1u) { idx = k; break; }
      bool finalbad = false; const size_t gthreads = (size_t)gridDim.x * 512, gid = (size_t)blockIdx.x * 512 + threadIdx.x;
      const float val = idx < 0 ? 16.f : exp2f(5.f + idx);
      float* o = PP()->out;
      for (size_t i = gid; i < (size_t)MTOK * DM; i += gthreads) { if (idx >= 0) o[i] = val; else { const float v = o[i]; if (!(fabsf(v) < 1e30f)) o[i] = 16.f; } } }
#endif
}

#undef m_ws
#undef m_Z
#undef m_Y
#undef m_SMp
#undef m_H
#undef m_OA
#undef m_OB
#undef m_MRG
#undef m_XQ
#undef m_XO
#undef m_ACT
#undef m_MB
#undef m_MEMN
#undef m_KB
#undef m_VTG
#undef m_G
#undef m_U
#undef m_xs
#undef m_out
#undef p
extern "C" void kernel_launch(void* const* d_in, const int* in_sizes, int n_in,
                              void* d_out, int out_size, void* d_ws, size_t ws_size,
                              hipStream_t stream) {
    static int grid_blocks = 0;
    constexpr int kDynLds = 131072 + 512;
    if (!grid_blocks) {
        int dev = 0, cus = 0, per_cu = 0;
        (void)hipGetDevice(&dev);
        (void)hipDeviceGetAttribute(&cus, hipDeviceAttributeMultiprocessorCount, dev);
        if (hipFuncSetAttribute((const void*)fwd_megakernel, hipFuncAttributeMaxDynamicSharedMemorySize, kDynLds) != hipSuccess) fprintf(stderr, "hipFuncSetAttribute failed\n");
        if (hipOccupancyMaxActiveBlocksPerMultiprocessor(&per_cu, (const void*)fwd_megakernel, 512, kDynLds) != hipSuccess || per_cu < 1) { fprintf(stderr, "occupancy query: %d\n", per_cu); per_cu = 1; }
        (void)hipGetLastError();
        grid_blocks = cus;
        if (n_in != 35 || ws_size < WS_END) fprintf(stderr, "kernel_launch: unexpected n_in %d or ws_size %zu (< %zu)\n", n_in, ws_size, (size_t)WS_END);
    }
    Params hp{};
    for (int i = 0; i < 35; ++i) hp.in[i] = (const float*)d_in[i];
    hp.out = (float*)d_out; hp.ws = (unsigned char*)d_ws;
    (void)hipMemsetAsync((unsigned char*)d_ws + WS_BAR, 0, XCD_BAR_WORDS * 4, stream);
    void* args[] = {&hp};
    hipError_t e = hipLaunchCooperativeKernel((const void*)fwd_megakernel, dim3(grid_blocks), dim3(512), args, kDynLds, stream);
    if (e != hipSuccess) fprintf(stderr, "cooperative launch failed: %s (grid %d)\n", hipGetErrorString(e), grid_blocks);
}
```

```cpp
#include <hip/hip_runtime.h>
#include <hip/hip_cooperative_groups.h>
#include <cstdio>
#include <type_traits>
namespace cg = cooperative_groups;

#define LAS __attribute__((address_space(3)))
typedef unsigned short bf16_t;
typedef short bf16x8 __attribute__((ext_vector_type(8)));
typedef float f32x4 __attribute__((ext_vector_type(4)));
typedef unsigned u32x2 __attribute__((ext_vector_type(2)));
typedef unsigned u32x4 __attribute__((ext_vector_type(4)));

constexpr int MTOK = 16384, DM = 2048, SEQ = 4096, NB = 4;
constexpr int ZW = 14336;
constexpr int ZN = 14592;
constexpr int ZQ = 0, ZK = 1024, ZV = 2048, ZZ = 3072, GQ = 4096, GK = 4608, GV = 5120, GR = 6144, SU = 7168, GT = 8192;
constexpr int FF = 5632;
constexpr float EPS = 1e-6f;

constexpr size_t WS_WA   = 0;
constexpr size_t SZ_WA   = 69206016;
constexpr size_t WS_WDN  = WS_WA + SZ_WA;
constexpr size_t WS_WGLA = WS_WDN + 4194304;
constexpr size_t WS_WGLU = WS_WGLA + 4194304;
constexpr size_t WS_WMIX = WS_WGLU + 8388608;
constexpr size_t WS_WXQ  = WS_WMIX + 8388608;
constexpr size_t WS_WXKV = WS_WXQ + 2097152;
constexpr size_t WS_WXO  = WS_WXKV + 4194304;
constexpr size_t WS_Z    = WS_WXO + 2097152;
constexpr size_t SZ_Z    = (size_t)MTOK * ZW * 2;
constexpr size_t WS_SM   = WS_Z + SZ_Z;
constexpr size_t WS_H    = WS_SM + (size_t)MTOK * 32 * 4;
constexpr size_t WS_DNP  = WS_H + (size_t)MTOK * DM * 2;
constexpr size_t DN_ITEM = 73728;
constexpr size_t WS_GLP  = WS_DNP + DN_ITEM * 2048;
constexpr size_t GL_ITEM = 74240;
constexpr size_t WS_MISC = WS_GLP + GL_ITEM * 1024;
constexpr size_t WS_BAR  = WS_MISC + 16384;
constexpr size_t WS_XS   = WS_MISC + 65536;
constexpr size_t WS_END  = WS_XS + (size_t)MTOK * DM * 2;

struct Params { const float* in[35]; float* out; unsigned char* ws; };
typedef const __attribute__((address_space(4))) Params* PPtr;
__device__ __forceinline__ int fresh_tid(int) {
    int hw = __builtin_amdgcn_s_getreg(10244) & 63; asm volatile("" : "+s"(hw));
    const int w = __builtin_amdgcn_readfirstlane(*(const volatile LAS int*)((LAS unsigned char*)nullptr + 131072 + hw * 4));
    const int ln = __builtin_amdgcn_mbcnt_hi(~0u, __builtin_amdgcn_mbcnt_lo(~0u, 0u)); int t = w * 64 + ln; asm volatile("" : "+v"(t)); return t; }
__device__ __forceinline__ int fresh_bid() { int b = blockIdx.x; asm volatile("" : "+s"(b)); return b; }
__device__ __forceinline__ int fresh_gdim() { int b = gridDim.x; asm volatile("" : "+s"(b)); return b; }
__device__ __forceinline__ PPtr PP() { auto kp = __builtin_amdgcn_kernarg_segment_ptr(); asm volatile("" : "+s"(kp)); return (PPtr)kp; }

__device__ __forceinline__ float bf2f(bf16_t v) { return __uint_as_float(((unsigned)v) << 16); }
typedef float f32x2_t __attribute__((ext_vector_type(2)));
typedef __bf16 bf16x2_t __attribute__((ext_vector_type(2)));
__device__ __forceinline__ unsigned pk_bf16(float lo, float hi) { const f32x2_t v = {lo, hi}; const bf16x2_t b = __builtin_convertvector(v, bf16x2_t); return __builtin_bit_cast(unsigned, b); }
__device__ __forceinline__ bf16_t f2bf(float f) { return (bf16_t)(pk_bf16(f, 0.f) & 0xffffu); }
__device__ __forceinline__ float sigmoidf_(float x) { return 1.f / (1.f + __expf(-x)); }
__device__ __forceinline__ float siluf_(float x) { return x * sigmoidf_(x); }
__device__ __forceinline__ float geluf_(float x) { const float u = 1.5957691216057308f * (x + 0.044715f * x * x * x); return x * sigmoidf_(u); }
__device__ __forceinline__ float softplusf_(float x) { return x > 20.f ? x : log1pf(__expf(x)); }
__device__ __forceinline__ float shx(float v, int mask, int lane) { return __int_as_float(__builtin_amdgcn_ds_bpermute((lane ^ mask) << 2, __float_as_int(v))); }
__device__ __forceinline__ float shup(float v, int delta, int lane) { return __int_as_float(__builtin_amdgcn_ds_bpermute((lane - delta) << 2, __float_as_int(v))); }
__device__ __forceinline__ float lo_bf(unsigned w) { return __uint_as_float(w << 16); }
__device__ __forceinline__ float hi_bf(unsigned w) { return __uint_as_float(w & 0xffff0000u); }
__device__ __forceinline__ f32x4 mfma16(bf16x8 a, bf16x8 b, f32x4 c) { return __builtin_amdgcn_mfma_f32_16x16x32_bf16(a, b, c, 0, 0, 0); }

__device__ __forceinline__ void gsync(cg::grid_group& grid) {
    __builtin_amdgcn_fence(__ATOMIC_RELEASE, "agent");
    asm volatile("s_waitcnt vmcnt(0) lgkmcnt(0)" ::: "memory");
    grid.sync();
    __builtin_amdgcn_fence(__ATOMIC_ACQUIRE, "agent");
    asm volatile("s_waitcnt vmcnt(0)" ::: "memory");
#ifdef EXTRA_SYNC
    __builtin_amdgcn_fence(__ATOMIC_RELEASE, "agent");
    asm volatile("s_waitcnt vmcnt(0) lgkmcnt(0)" ::: "memory");
    grid.sync();
    __builtin_amdgcn_fence(__ATOMIC_ACQUIRE, "agent");
    asm volatile("s_waitcnt vmcnt(0)" ::: "memory");
#endif
}


#define XB_TMO      128
#define XB_XCNT(j)  (256  + 64 * (j))
#define XB_XSUB(j)  (1280 + 64 * (j))
#define XB_XGEN(j)  (2304 + 64 * (j))
#define XB_TOP      3328
#define XB_TOPGEN   3392
#define XCD_BAR_WORDS 3456
#define XB_SPIN_CAP (1u << 20)
constexpr int XB_LDS_OFF = 131072 + 256;
__device__ __forceinline__ unsigned xb_ld(unsigned* p)              { return __hip_atomic_load(p, __ATOMIC_RELAXED, __HIP_MEMORY_SCOPE_AGENT); }
__device__ __forceinline__ unsigned xb_add(unsigned* p, unsigned v) { return __hip_atomic_fetch_add(p, v, __ATOMIC_RELAXED, __HIP_MEMORY_SCOPE_AGENT); }
__device__ __forceinline__ unsigned xb_xcc_id() { return (unsigned)__builtin_amdgcn_s_getreg((3 << 11) | 20) & 0xFu; }
#define XB_SPIN(cond, bar) do { unsigned _sp = 0; while (cond) { __builtin_amdgcn_s_sleep(1); \
    if ((++_sp & 255u) == 0u) { if (xb_ld(&(bar)[XB_TMO])) break; if (_sp > XB_SPIN_CAP) { atomicAdd(&(bar)[XB_TMO], 1u); break; } } } } while (0)
__device__ __forceinline__ void xcd_barrier_complete(unsigned* bar, unsigned x, unsigned& nloc, unsigned& nx) {
    const unsigned G = gridDim.x;
    unsigned sum, cnt, mine, sp = 0u;
    for (;;) {
        sum = 0u; cnt = 0u; mine = 0u;
#pragma unroll
        for (unsigned j = 0; j < 16; ++j) { const unsigned c = xb_ld(&bar[XB_XCNT(j)]); sum += c; cnt += (c > 0u) ? 1u : 0u; mine = (j == x) ? c : mine; }
        if (sum == G) break;
        __builtin_amdgcn_s_sleep(1);
        if ((++sp & 255u) == 0u) { if (xb_ld(&bar[XB_TMO])) break; if (sp > XB_SPIN_CAP) { atomicAdd(&bar[XB_TMO], 1u); break; } }
    }
    nloc = mine > 0u ? mine : 1u; nx = cnt > 0u ? cnt : 1u;
}
__device__ __forceinline__ void xbar(const int wid_s) {
    asm volatile("s_waitcnt vmcnt(0)" ::: "memory");
    __syncthreads();
    unsigned* bar = (unsigned*)(PP()->ws + WS_BAR);
    if (fresh_tid(wid_s) == 0) {
        volatile LAS unsigned* st = (volatile LAS unsigned*)((LAS unsigned char*)nullptr + XB_LDS_OFF);
        const unsigned x = xb_xcc_id();
        __builtin_amdgcn_s_waitcnt(0);
        unsigned nloc = st[0], nx = st[1];
        if (nloc == 0u) { xcd_barrier_complete(bar, x, nloc, nx); st[0] = nloc; st[1] = nx; }
        const unsigned old = xb_add(&bar[XB_XSUB(x)], 1u);
        const unsigned gen = old / nloc;
        if (old + 1u == (gen + 1u) * nloc) {
            __builtin_amdgcn_fence(__ATOMIC_RELEASE, "agent");
            asm volatile("s_waitcnt vmcnt(0)" ::: "memory");
            const unsigned og = xb_add(&bar[XB_TOP], 1u);
            const unsigned tg = og / nx;
            if (og + 1u == (tg + 1u) * nx) xb_add(&bar[XB_TOPGEN], 1u);
            else XB_SPIN(xb_ld(&bar[XB_TOPGEN]) == tg, bar);
            __builtin_amdgcn_fence(__ATOMIC_ACQUIRE, "agent");
            xb_add(&bar[XB_XGEN(x)], 1u);
            asm volatile("s_waitcnt vmcnt(0)" ::: "memory");
        } else {
            XB_SPIN(xb_ld(&bar[XB_XGEN(x)]) == gen, bar);
            __builtin_amdgcn_fence(__ATOMIC_ACQUIRE, "agent");
            asm volatile("s_waitcnt vmcnt(0)" ::: "memory");
        }
    }
    __syncthreads();
}

constexpr int BM = 256, BK = 64, HALF = 128, HTB = HALF * BK * 2, STAGE_BYTES = 8 * HTB, NXCD = 8, WGM = 8;
__device__ __forceinline__ int lds_byte(int r, int c) { const int st = (r >> 4) * 2 + (c >> 5), rr = r & 15, cc = c & 31, ob = rr * 64 + cc * 2; return st * 1024 + (ob ^ (((ob >> 9) & 1) << 5)); }
__device__ __forceinline__ void stage_rc(int b, int& R, int& C) { const int st = b / 1024, sb = b % 1024, swz = sb ^ (((sb >> 9) & 1) << 5); R = (st >> 1) * 16 + swz / 64; C = (st & 1) * 32 + (swz % 64) / 2; }
__device__ __forceinline__ int perm32(int rho) { const int n = rho >> 4, i = rho & 15; return 8 * (i >> 2) + 4 * n + (i & 3); }
struct Unit { int pm, pn; };
struct Gemm { const bf16_t* A; const bf16_t* Bt; int M, N, K, lda; };
struct StaticOrder {
    int nM, nN, nwg, G, c;
    __device__ void init(int M, int N, int G_, int c_) { nM = M / BM; nN = N / BM; nwg = nM * nN; G = G_; c = c_; }
    __device__ bool next(int i, Unit& u) const {
        const long L = (long)i * G + c; if (L >= nwg) return false;
        int wgid = (int)L; { const int q = nwg / NXCD, r = nwg % NXCD, xcd = wgid % NXCD, off = wgid / NXCD; wgid = (xcd < r ? xcd * (q + 1) : r * (q + 1) + (xcd - r) * q) + off; }
        const int nig = WGM * nN, gid = wgid / nig, fm = gid * WGM, gsz = (nM - fm) < WGM ? (nM - fm) : WGM;
        u.pm = fm + ((wgid % nig) % gsz); u.pn = (wgid % nig) / gsz; return true;
    }
};

template <class Epi>
__device__ __forceinline__ void gemm_phase(LAS unsigned char* lds, const Gemm g, const StaticOrder& S, const Epi& E, const int wid_s) {
    const int tid = fresh_tid(wid_s), wid = __builtin_amdgcn_readfirstlane(tid >> 6), lane = tid & 63, wr = wid >> 2, wc = wid & 3, fr = lane & 15, fq = lane >> 4;
    const int K = g.K, nt = K / BK, lda = g.lda;
    unsigned voffA[2], voffB[2];
#pragma unroll
    for (int i = 0; i < 2; ++i) { int R, C; stage_rc(tid * 16 + i * 8192, R, C); const int Rb = Epi::PERM ? ((R & ~31) + perm32(R & 31)) : R; voffA[i] = (unsigned)(R * lda + C) * 2u; voffB[i] = (unsigned)(Rb * K + C) * 2u; }
    const size_t kstep = (size_t)(BK * 2);
    const size_t hstepA = (size_t)HALF * lda * 2, hstepB = (size_t)HALF * K * 2;
    const size_t tstepA = 2 * hstepA, tstepB = 2 * hstepB;
    const unsigned ldsw = (unsigned)wid * 1024u;
    const int aoff = lds_byte(wr * 64 + fr, fq * 8), boff = lds_byte(wc * 32 + fr, fq * 8);
#define PG8_SA(b, h) (((b) * 2 + (h)) * HTB)
#define PG8_SB(b, h) ((4 + (b) * 2 + (h)) * HTB)
#define PG8_STAGE(bufoff, gbase, voff) do { _Pragma("unroll") for (int _i = 0; _i < 2; ++_i) \
        __builtin_amdgcn_global_load_lds((const unsigned*)((const char*)(gbase) + (voff)[_i]), (LAS unsigned*)(lds + (bufoff) + ldsw + _i * 8192), 16, 0, 0); } while (0)
#define PG8_LDA(dst, b, h) do { _Pragma("unroll") for (int m = 0; m < 4; ++m) _Pragma("unroll") for (int k = 0; k < 2; ++k) dst[m][k] = *(const LAS bf16x8*)(lds + PG8_SA(b, h) + aoff + m * 2048 + k * 1024); } while (0)
#define PG8_LDB(dst, b, h) do { _Pragma("unroll") for (int n = 0; n < 2; ++n) _Pragma("unroll") for (int k = 0; k < 2; ++k) dst[n][k] = *(const LAS bf16x8*)(lds + PG8_SB(b, h) + boff + n * 2048 + k * 1024); } while (0)
#define PG8_MMA(ai, bj, At, Bt) do { __builtin_amdgcn_s_setprio(1); _Pragma("unroll") for (int m = 0; m < 4; ++m) _Pragma("unroll") for (int n = 0; n < 2; ++n) _Pragma("unroll") for (int k = 0; k < 2; ++k) \
        acc[ai][bj][m][n] = __builtin_amdgcn_mfma_f32_16x16x32_bf16(Bt[n][k], At[m][k], acc[ai][bj][m][n], 0, 0, 0); __builtin_amdgcn_s_setprio(0); } while (0)
#define PG8_WAIT_V(n) asm volatile("s_waitcnt vmcnt(" #n ")" ::: "memory")
#define PG8_WAIT_L(n) asm volatile("s_waitcnt lgkmcnt(" #n ")" ::: "memory")
#define PG8_BAR __builtin_amdgcn_s_barrier()
#define PG8_SCHED __builtin_amdgcn_sched_barrier(0)
    Unit cur, nxt; int ui = 0;
    if (!S.next(0, cur)) return;
    f32x4 acc[2][2][4][2];
#pragma unroll
    for (int a = 0; a < 2; ++a)
#pragma unroll
        for (int b = 0; b < 2; ++b)
#pragma unroll
            for (int m = 0; m < 4; ++m)
#pragma unroll
                for (int n = 0; n < 2; ++n) acc[a][b][m][n] = (f32x4){0.f, 0.f, 0.f, 0.f};
    bf16x8 At[4][2], B0[2][2], B1[2][2];
    const char* cA = (const char*)g.A + (size_t)cur.pm * tstepA; const char* cB = (const char*)g.Bt + (size_t)cur.pn * tstepB;
    PG8_STAGE(PG8_SB(0, 0), cB, voffB); PG8_STAGE(PG8_SA(0, 0), cA, voffA); PG8_STAGE(PG8_SB(0, 1), cB + hstepB, voffB); PG8_STAGE(PG8_SA(0, 1), cA + hstepA, voffA);
    if (wr == 1) PG8_BAR;
    PG8_WAIT_V(4); PG8_BAR;
    PG8_STAGE(PG8_SB(1, 0), cB + kstep, voffB); PG8_STAGE(PG8_SA(1, 0), cA + kstep, voffA); PG8_STAGE(PG8_SB(1, 1), cB + hstepB + kstep, voffB);
    PG8_WAIT_V(6); PG8_BAR;
    for (;;) {
        const bool has_next = S.next(ui + 1, nxt);
        const char* nA = has_next ? (const char*)g.A + (size_t)nxt.pm * tstepA : cA; const char* nB = has_next ? (const char*)g.Bt + (size_t)nxt.pn * tstepB : cB;
        for (int t = 0; t < nt; t += 2) {
            const bool last = (t == nt - 2);
            const char* a1 = cA + (size_t)(t + 1) * kstep;
            const char* a2 = last ? nA : cA + (size_t)(t + 2) * kstep; const char* b2 = last ? nB : cB + (size_t)(t + 2) * kstep;
            const char* a3 = a2 + kstep; const char* b3 = b2 + kstep;
            PG8_LDB(B0, 0, 0); PG8_SCHED; PG8_LDA(At, 0, 0); PG8_STAGE(PG8_SA(1, 1), a1 + hstepA, voffA);
            PG8_WAIT_L(8); PG8_BAR; PG8_WAIT_L(0); PG8_MMA(0, 0, At, B0); PG8_BAR; PG8_SCHED;
            PG8_LDB(B1, 0, 1); PG8_STAGE(PG8_SB(0, 0), b2, voffB);
            PG8_BAR; PG8_WAIT_L(0); PG8_MMA(0, 1, At, B1); PG8_BAR;
            PG8_LDA(At, 0, 1); PG8_STAGE(PG8_SA(0, 0), a2, voffA);
            PG8_BAR; PG8_WAIT_L(0); PG8_MMA(1, 0, At, B0); PG8_BAR; PG8_SCHED;
            PG8_STAGE(PG8_SB(0, 1), b2 + hstepB, voffB);
            PG8_WAIT_V(6); PG8_BAR; PG8_MMA(1, 1, At, B1); PG8_BAR;
            PG8_LDB(B0, 1, 0); PG8_SCHED; PG8_LDA(At, 1, 0); PG8_STAGE(PG8_SA(0, 1), a2 + hstepA, voffA);
            PG8_WAIT_L(8); PG8_BAR; PG8_WAIT_L(0); PG8_MMA(0, 0, At, B0); PG8_BAR; PG8_SCHED;
            PG8_LDB(B1, 1, 1); PG8_STAGE(PG8_SB(1, 0), b3, voffB);
            PG8_BAR; PG8_WAIT_L(0); PG8_MMA(0, 1, At, B1); PG8_BAR;
            PG8_LDA(At, 1, 1); PG8_STAGE(PG8_SA(1, 0), a3, voffA);
            PG8_BAR; PG8_WAIT_L(0); PG8_MMA(1, 0, At, B0); PG8_BAR; PG8_SCHED;
            PG8_STAGE(PG8_SB(1, 1), b3 + hstepB, voffB);
            PG8_WAIT_V(6); PG8_BAR; PG8_MMA(1, 1, At, B1); PG8_BAR;
        }
        E(acc, cur, wr, wc, fr, fq);
        if (!has_next) break;
#pragma unroll
        for (int a = 0; a < 2; ++a)
#pragma unroll
            for (int b = 0; b < 2; ++b)
#pragma unroll
                for (int m = 0; m < 4; ++m)
#pragma unroll
                    for (int n = 0; n < 2; ++n) acc[a][b][m][n] = (f32x4){0.f, 0.f, 0.f, 0.f};
        cur = nxt; cA = nA; cB = nB; ++ui;
    }
    PG8_WAIT_V(0);
    if (wr == 0) PG8_BAR;
    PG8_BAR;
#undef PG8_SA
#undef PG8_SB
#undef PG8_STAGE
#undef PG8_LDA
#undef PG8_LDB
#undef PG8_MMA
#undef PG8_WAIT_V
#undef PG8_WAIT_L
#undef PG8_BAR
#undef PG8_SCHED
}

typedef const f32x4 (&AccRef)[2][2][4][2];
__device__ __forceinline__ u32x2 pk4(f32x4 v) { u32x2 r; r.x = pk_bf16(v[0], v[1]); r.y = pk_bf16(v[2], v[3]); return r; }
__device__ __forceinline__ f32x4 ld_bf4(const bf16_t* p) { const u32x2 w = *(const u32x2*)p; return (f32x4){lo_bf(w.x), hi_bf(w.x), lo_bf(w.y), hi_bf(w.y)}; }
__device__ __forceinline__ f32x4 sig4(f32x4 v) { return (f32x4){sigmoidf_(v[0]), sigmoidf_(v[1]), sigmoidf_(v[2]), sigmoidf_(v[3])}; }

struct EpiZ { static constexpr bool PERM = true; bf16_t* Z; float* SMp;
    __device__ __forceinline__ void operator()(AccRef acc, const Unit& u, int wr, int wc, int fr, int fq) const {
        const int row0 = u.pm * BM + wr * 64 + fr;
        if (u.pn < 56) {
#pragma unroll
            for (int ai = 0; ai < 2; ++ai)
#pragma unroll
                for (int m = 0; m < 4; ++m) { bf16_t* rp = Z + (size_t)(row0 + ai * HALF + m * 16) * ZW + u.pn * BM + wc * 32 + 8 * fq;
#pragma unroll
                    for (int bj = 0; bj < 2; ++bj) { const u32x2 lo = pk4(acc[ai][bj][m][0]), hi = pk4(acc[ai][bj][m][1]); *(u32x4*)(rp + bj * HALF) = (u32x4){lo.x, lo.y, hi.x, hi.y}; } }
        } else if (wc == 0) {
#pragma unroll
            for (int ai = 0; ai < 2; ++ai)
#pragma unroll
                for (int m = 0; m < 4; ++m) { float* rp = SMp + (size_t)(row0 + ai * HALF + m * 16) * 32 + 8 * fq;
#pragma unroll
                    for (int n = 0; n < 2; ++n) *(f32x4*)(rp + n * 4) = acc[ai][0][m][n]; }
        }
    }
};
struct EpiF32 { static constexpr bool PERM = false; float* C; int ldc;
    __device__ __forceinline__ void operator()(AccRef acc, const Unit& u, int wr, int wc, int fr, int fq) const {
        const int row0 = u.pm * BM + wr * 64 + fr, col0 = u.pn * BM + wc * 32 + 4 * fq;
#pragma unroll
        for (int ai = 0; ai < 2; ++ai)
#pragma unroll
            for (int m = 0; m < 4; ++m) { float* rp = C + (size_t)(row0 + ai * HALF + m * 16) * ldc + col0;
#pragma unroll
                for (int bj = 0; bj < 2; ++bj)
#pragma unroll
                    for (int n = 0; n < 2; ++n) *(f32x4*)(rp + bj * HALF + n * 16) = acc[ai][bj][m][n]; }
    }
};
struct EpiBf16 { static constexpr bool PERM = true; bf16_t* C; int ldc;
    __device__ __forceinline__ void operator()(AccRef acc, const Unit& u, int wr, int wc, int fr, int fq) const {
        const int row0 = u.pm * BM + wr * 64 + fr, col0 = u.pn * BM + wc * 32 + 8 * fq;
#pragma unroll
        for (int ai = 0; ai < 2; ++ai)
#pragma unroll
            for (int m = 0; m < 4; ++m) { bf16_t* rp = C + (size_t)(row0 + ai * HALF + m * 16) * ldc + col0;
#pragma unroll
                for (int bj = 0; bj < 2; ++bj) { const u32x2 lo = pk4(acc[ai][bj][m][0]), hi = pk4(acc[ai][bj][m][1]); *(u32x4*)(rp + bj * HALF) = (u32x4){lo.x, lo.y, hi.x, hi.y}; } }
    }
};
__device__ __forceinline__ void ld_bf8(const bf16_t* p, f32x4& lo, f32x4& hi) { const u32x4 w = *(const u32x4*)p; lo = (f32x4){lo_bf(w.x), hi_bf(w.x), lo_bf(w.y), hi_bf(w.y)}; hi = (f32x4){lo_bf(w.z), hi_bf(w.z), lo_bf(w.w), hi_bf(w.w)}; }
__device__ __forceinline__ void st_bf8(bf16_t* p, f32x4 lo, f32x4 hi) { const u32x2 a = pk4(lo), b = pk4(hi); *(u32x4*)p = (u32x4){a.x, a.y, b.x, b.y}; }
struct EpiGLU { static constexpr bool PERM = true; const bf16_t* Z; bf16_t* MRG;
    __device__ __forceinline__ void operator()(AccRef acc, const Unit& u, int wr, int wc, int fr, int fq) const {
        const int row0 = u.pm * BM + wr * 64 + fr, oc = u.pn * HALF + wc * 32 + 8 * fq;
#pragma unroll
        for (int ai = 0; ai < 2; ++ai)
#pragma unroll
            for (int m = 0; m < 4; ++m) { const int row = row0 + ai * HALF + m * 16;
                f32x4 g0, g1; ld_bf8(Z + (size_t)row * ZW + GT + 4096 + oc, g0, g1);
                st_bf8(MRG + (size_t)row * DM + oc, sig4(g0) * acc[ai][0][m][0] * sig4(acc[ai][1][m][0]), sig4(g1) * acc[ai][0][m][1] * sig4(acc[ai][1][m][1])); }
    }
};
template <bool FINAL> struct EpiAcc { static constexpr bool PERM = true; const bf16_t* Z; bf16_t* MRG; bf16_t* MB; int goff;
    __device__ __forceinline__ void operator()(AccRef acc, const Unit& u, int wr, int wc, int fr, int fq) const {
        const int row0 = u.pm * BM + wr * 64 + fr, col0 = u.pn * BM + wc * 32 + 8 * fq;
#pragma unroll
        for (int ai = 0; ai < 2; ++ai)
#pragma unroll
            for (int m = 0; m < 4; ++m) { const int row = row0 + ai * HALF + m * 16;
#pragma unroll
                for (int bj = 0; bj < 2; ++bj) { const int c = col0 + bj * HALF;
                    f32x4 g0, g1, m0, m1; ld_bf8(Z + (size_t)row * ZW + GT + goff + c, g0, g1); ld_bf8(MRG + (size_t)row * DM + c, m0, m1);
                    st_bf8((FINAL ? MB : MRG) + (size_t)row * DM + c, m0 + sig4(g0) * acc[ai][bj][m][0], m1 + sig4(g1) * acc[ai][bj][m][1]); } }
    }
};
struct EpiKV { static constexpr bool PERM = false; bf16_t* Kb; bf16_t* VT;
    __device__ __forceinline__ void operator()(AccRef acc, const Unit& u, int wr, int wc, int fr, int fq) const {
        const int row0 = u.pm * BM + wr * 64 + fr, col0 = u.pn * BM + wc * 32 + 4 * fq;
#pragma unroll
        for (int ai = 0; ai < 2; ++ai)
#pragma unroll
            for (int m = 0; m < 4; ++m) { const int row = row0 + ai * HALF + m * 16;
#pragma unroll
                for (int bj = 0; bj < 2; ++bj)
#pragma unroll
                    for (int n = 0; n < 2; ++n) { const int c = col0 + bj * HALF + n * 16; const f32x4 v = acc[ai][bj][m][n];
                        if (c < 512) *(u32x2*)(Kb + (size_t)row * 512 + c) = pk4(v);
                        else { const int cc = c - 512, b = row >> 8, key = row & 255;
#pragma unroll
                            for (int i = 0; i < 4; ++i) VT[((size_t)(b * 4 + ((cc + i) >> 7)) * 128 + ((cc + i) & 127)) * 256 + key] = f2bf(v[i]); } } }
    }
};
__device__ __forceinline__ float dpp_ror1(float v) { return __int_as_float(__builtin_amdgcn_update_dpp(0, __float_as_int(v), 0x121, 0xF, 0xF, false)); }
__device__ __forceinline__ float dpp_ror2(float v) { return __int_as_float(__builtin_amdgcn_update_dpp(0, __float_as_int(v), 0x122, 0xF, 0xF, false)); }
struct EpiFFN { static constexpr bool PERM = true; bf16_t* ACT; bf16_t* GB; bf16_t* UB; const float* cw;
    __device__ __forceinline__ void operator()(AccRef acc, const Unit& u, int wr, int wc, int fr, int fq) const {
        const int oc = u.pn * HALF + wc * 32 + 8 * fq;
#pragma unroll
        for (int ai = 0; ai < 2; ++ai) {
            const int rowb = u.pm * BM + ai * HALF + wr * 64;
            u32x2 pk0[4];
#pragma unroll
            for (int n = 0; n < 2; ++n) {
                const f32x4 wa = *(const f32x4*)(cw + (oc + 4 * n) * 3), wb = *(const f32x4*)(cw + (oc + 4 * n) * 3 + 4), wcc = *(const f32x4*)(cw + (oc + 4 * n) * 3 + 8);
                const float w0[4] = {wa[0], wa[3], wb[2], wcc[1]}, w1[4] = {wa[1], wb[0], wb[3], wcc[2]}, w2[4] = {wa[2], wb[1], wcc[0], wcc[3]};
                f32x4 v1 = {0.f, 0.f, 0.f, 0.f}, v2 = {0.f, 0.f, 0.f, 0.f};
#pragma unroll
                for (int m = 0; m < 4; ++m) {
                    f32x4 c1, c2, r;
#pragma unroll
                    for (int c = 0; c < 4; ++c) { c1[c] = dpp_ror1(acc[ai][0][m][n][c]); c2[c] = dpp_ror2(acc[ai][0][m][n][c]); }
#pragma unroll
                    for (int c = 0; c < 4; ++c) {
                        const float g = acc[ai][0][m][n][c], up = acc[ai][1][m][n][c];
                        const float q1 = (m == 0 || fr >= 1) ? c1[c] : v1[c];
                        const float q2 = (m == 0 || fr >= 2) ? c2[c] : v2[c];
                        r[c] = geluf_(w0[c] * q2 + w1[c] * q1 + w2[c] * g) * up;
                    }
                    v1 = c1; v2 = c2;
                    const u32x2 pr = pk4(r);
                    if (n == 0) pk0[m] = pr;
                    else { const int row = rowb + m * 16 + fr; if (m > 0 || fr >= 2) *(u32x4*)(ACT + (size_t)row * FF + oc) = (u32x4){pk0[m].x, pk0[m].y, pr.x, pr.y}; }
                    __builtin_amdgcn_sched_barrier(0);
                }
            }
            if (fr < 2) { st_bf8(GB + (size_t)((rowb >> 6) * 4 + 2 + fr) * FF + oc, acc[ai][0][0][0], acc[ai][0][0][1]); st_bf8(UB + (size_t)((rowb >> 6) * 2 + fr) * FF + oc, acc[ai][1][0][0], acc[ai][1][0][1]); }
            if (fr >= 14) st_bf8(GB + (size_t)((rowb >> 6) * 4 + (fr - 14)) * FF + oc, acc[ai][0][3][0], acc[ai][0][3][1]);
            __builtin_amdgcn_sched_barrier(0);
        }
    }
};

template <class Epi> __device__ __forceinline__ void run_gemm(LAS unsigned char* lds, const bf16_t* A, int lda, const bf16_t* Bt, int M, int N, int K, const Epi& E, const int wid_s, int shift = 0) {
    Gemm g; g.A = A; g.Bt = Bt; g.M = M; g.N = N; g.K = K; g.lda = lda;
    StaticOrder S; S.init(M, N, (int)fresh_gdim(), (int)((fresh_bid() + fresh_gdim() - shift) % fresh_gdim()));
    gemm_phase<Epi>(lds, g, S, E, wid_s);
}

__device__ __forceinline__ int src_col(int kind, int n) {
    if (kind == 0) return n;
    if (kind == 1) {
        if (n < 4096) return n;
        if (n < 6144) return n + 16;
        if (n < 14336) return n + 32;
        if (n < 14352) return n - 14336 + 4096;
        if (n < 14368) return n - 14352 + 6160;
        return -1;
    }
    if (kind == 2) { const int un = n >> 8, r = n & 255; return r < 128 ? un * 128 + r : 2048 + un * 128 + (r - 128); }
    { const int un = n >> 8, r = n & 255; return r < 128 ? un * 128 + r : FF + un * 128 + (r - 128); }
}
__device__ void convert_w(LAS float* ldsf, const float* __restrict__ W, bf16_t* __restrict__ Wt, int K, int Nsrc, int Ndst, int kind, const int wid_s, int nb = 0, int bi = 0) {
    const int t = fresh_tid(wid_s), ntn = Ndst >> 6, ntiles = ntn * (K >> 6);
    const int nn = t & 63, kq = t >> 6, row = t >> 3, seg = (t & 7) * 8;
    const int g = nb > 0 ? nb : fresh_gdim();
    int tile = nb > 0 ? bi : fresh_bid();
    float v[8];
    auto ld = [&](int tl) __attribute__((always_inline)) {
        const int n0 = (tl % ntn) << 6, k0 = (tl / ntn) << 6;
        const int sc = src_col(kind, n0 + nn);
#pragma unroll
        for (int i = 0; i < 8; ++i) v[i] = sc >= 0 ? W[(size_t)(k0 + kq + 8 * i) * Nsrc + sc] : 0.f;
    };
    if (tile < ntiles) ld(tile);
    for (; tile < ntiles; tile += g) {
        const int n0 = (tile % ntn) << 6, k0 = (tile / ntn) << 6;
#pragma unroll
        for (int i = 0; i < 8; ++i) ldsf[nn * 65 + kq + 8 * i] = v[i];
        __syncthreads();
        if (tile + g < ntiles) ld(tile + g);
        float o8[8];
#pragma unroll
        for (int j = 0; j < 8; ++j) o8[j] = ldsf[row * 65 + seg + j];
        u32x4 o; o.x = pk_bf16(o8[0], o8[1]); o.y = pk_bf16(o8[2], o8[3]); o.z = pk_bf16(o8[4], o8[5]); o.w = pk_bf16(o8[6], o8[7]);
        *(u32x4*)(Wt + (size_t)(n0 + row) * K + k0 + seg) = o;
        __syncthreads();
    }
}

__device__ __forceinline__ float wave_sum(float v, int lane) {
#pragma unroll
    for (int o = 32; o >= 1; o >>= 1) v += shx(v, o, lane);
    return v;
}
__device__ void norm_rows(const float* xin_f, const bf16_t* xin_b, const bf16_t* y, const float* gpost, float* xout_f, bf16_t* xout_b, const float* gpre, bf16_t* hout, int nrows, const int wid_s) {
    const int t_ = fresh_tid(wid_s); const int lane = t_ & 63, gw = fresh_bid() * 8 + (t_ >> 6), nw = fresh_gdim() * 8;
    for (int row = gw; row < nrows; row += nw) {
        f32x4 v[8];
        if (xin_f) {
            const float* xr = xin_f + (size_t)row * DM;
#pragma unroll
            for (int i = 0; i < 8; ++i) v[i] = *(const f32x4*)(xr + (i * 64 + lane) * 4);
        } else {
            const bf16_t* xr = xin_b + (size_t)row * DM;
#pragma unroll
            for (int i = 0; i < 8; ++i) v[i] = ld_bf4(xr + (i * 64 + lane) * 4);
        }
        if (y) {
            f32x4 yv[8]; float ss = 0.f;
            const bf16_t* yr = y + (size_t)row * DM;
#pragma unroll
            for (int i = 0; i < 8; ++i) { yv[i] = ld_bf4(yr + (i * 64 + lane) * 4); ss += yv[i][0] * yv[i][0] + yv[i][1] * yv[i][1] + yv[i][2] * yv[i][2] + yv[i][3] * yv[i][3]; }
            ss = wave_sum(ss, lane);
            const float inv = rsqrtf(ss * (1.f / DM) + EPS);
#pragma unroll
            for (int i = 0; i < 8; ++i) { const f32x4 gp = *(const f32x4*)(gpost + (i * 64 + lane) * 4); v[i] += yv[i] * inv * gp; }
        }
        if (xout_f) {
            float* xo = xout_f + (size_t)row * DM;
#pragma unroll
            for (int i = 0; i < 8; ++i) *(f32x4*)(xo + (i * 64 + lane) * 4) = v[i];
        }
        if (xout_b) {
            bf16_t* xo = xout_b + (size_t)row * DM;
#pragma unroll
            for (int i = 0; i < 8; ++i) *(u32x2*)(xo + (i * 64 + lane) * 4) = pk4(v[i]);
        }
        if (hout) {
            float ss = 0.f;
#pragma unroll
            for (int i = 0; i < 8; ++i) ss += v[i][0] * v[i][0] + v[i][1] * v[i][1] + v[i][2] * v[i][2] + v[i][3] * v[i][3];
            ss = wave_sum(ss, lane);
            const float inv = rsqrtf(ss * (1.f / DM) + EPS);
            bf16_t* ho = hout + (size_t)row * DM;
#pragma unroll
            for (int i = 0; i < 8; ++i) { const f32x4 gp = *(const f32x4*)(gpre + (i * 64 + lane) * 4); *(u32x2*)(ho + (i * 64 + lane) * 4) = pk4(v[i] * inv * gp); }
        }
    }
}

__device__ void dn_prep(LAS unsigned char* lds, PPtr p, int layer, const int wid_s) {
    const int t = fresh_tid(wid_s), wv = t >> 6, lane = t & 63, fr = lane & 15, fq = lane >> 4;
    LAS bf16_t* QS = (LAS bf16_t*)lds;
    LAS bf16_t* KS = (LAS bf16_t*)(lds + 17408);
    LAS float* KF = (LAS float*)(lds + 34816);
    LAS float* VF = (LAS float*)(lds + 67584);
    LAS float* LS = (LAS float*)(lds + 100352);
    LAS float* GC = (LAS float*)(lds + 117760);
    LAS float* BE = GC + 64;
    LAS float* EG = GC + 128;
    const bf16_t* Z = (const bf16_t*)(p->ws + WS_Z);
    const float* SMp = (const float*)(p->ws + WS_SM);
    bf16_t* DNP = (bf16_t*)(p->ws + WS_DNP);
    float* GLAST = (float*)(p->ws + WS_MISC);
    const float* convw = p->in[5] + (size_t)layer * 3072 * 4;
    for (int item = fresh_bid(); item < 2048; item += fresh_gdim()) {
        const int n = item & 63, h = (item >> 6) & 7, b = item >> 9;
        const size_t row0 = (size_t)b * SEQ + n * 64;
        bf16_t* it = DNP + (size_t)item * 36864;
#pragma unroll 1
        for (int pass = 0; pass < 2; ++pass) {
            const int tok = pass * 32 + (t >> 4), c8 = (t & 15) * 8;
#pragma unroll
            for (int mat = 0; mat < 3; ++mat) {
                const int ch = mat * 1024 + h * 128 + c8;
                float y[8];
#pragma unroll
                for (int c = 0; c < 8; ++c) y[c] = 0.f;
                f32x4 wc[8];
#pragma unroll
                for (int c = 0; c < 8; ++c) wc[c] = *(const f32x4*)(convw + (size_t)(ch + c) * 4);
#pragma unroll
                for (int j = 0; j < 4; ++j) {
                    const int tt = n * 64 + tok - 3 + j;
                    if (tt >= 0) {
                        const u32x4 xv = *(const u32x4*)(Z + ((size_t)b * SEQ + tt) * ZW + ch);
                        y[0] += wc[0][j] * lo_bf(xv.x); y[1] += wc[1][j] * hi_bf(xv.x);
                        y[2] += wc[2][j] * lo_bf(xv.y); y[3] += wc[3][j] * hi_bf(xv.y);
                        y[4] += wc[4][j] * lo_bf(xv.z); y[5] += wc[5][j] * hi_bf(xv.z);
                        y[6] += wc[6][j] * lo_bf(xv.w); y[7] += wc[7][j] * hi_bf(xv.w);
                    }
                }
                float ss = 0.f;
#pragma unroll
                for (int c = 0; c < 8; ++c) { y[c] = siluf_(y[c]); ss += y[c] * y[c]; }
                if (mat < 2) {
                    ss += shx(ss, 1, lane); ss += shx(ss, 2, lane); ss += shx(ss, 4, lane); ss += shx(ss, 8, lane);
                    const float inv = rsqrtf(ss + EPS) * (mat == 0 ? 0.08838834764831845f : 1.f);
#pragma unroll
                    for (int c = 0; c < 8; ++c) y[c] *= inv;
                    u32x4 o; o.x = pk_bf16(y[0], y[1]); o.y = pk_bf16(y[2], y[3]); o.z = pk_bf16(y[4], y[5]); o.w = pk_bf16(y[6], y[7]);
                    if (mat == 0) *(LAS u32x4*)(QS + tok * 136 + c8) = o;
                    else { *(LAS u32x4*)(KS + tok * 136 + c8) = o;
#pragma unroll
                        for (int c = 0; c < 8; ++c) KF[tok * 128 + c8 + c] = y[c]; }
                } else {
#pragma unroll
                    for (int c = 0; c < 8; ++c) VF[tok * 128 + c8 + c] = y[c];
                }
            }
        }
        if (t < 64) {
            const float db = SMp[(row0 + t) * 32 + h], da = SMp[(row0 + t) * 32 + 8 + h];
            const float be = sigmoidf_(db);
            float g = -expf(p->in[6][layer * 8 + h]) * softplusf_(da + p->in[7][layer * 8 + h]);
#pragma unroll
            for (int o = 1; o < 64; o <<= 1) { const float v = shup(g, o, lane); if (lane >= o) g += v; }
            GC[t] = g; BE[t] = be; EG[t] = expf(g); GC[192 + t] = be * expf(g);
        }
        __syncthreads();
#pragma unroll
        for (int tt = 0; tt < 2; ++tt) {
            const int tile = wv * 2 + tt, mi = tile >> 2, ni = tile & 3;
            f32x4 aK = {0.f, 0.f, 0.f, 0.f}, aQ = {0.f, 0.f, 0.f, 0.f};
#pragma unroll
            for (int ks = 0; ks < 4; ++ks) {
                const bf16x8 bfr = *(const LAS bf16x8*)(KS + (ni * 16 + fr) * 136 + ks * 32 + fq * 8);
                const bf16x8 ak = *(const LAS bf16x8*)(KS + (mi * 16 + fr) * 136 + ks * 32 + fq * 8);
                const bf16x8 aq = *(const LAS bf16x8*)(QS + (mi * 16 + fr) * 136 + ks * 32 + fq * 8);
                aK = mfma16(ak, bfr, aK); aQ = mfma16(aq, bfr, aQ);
            }
            const int j = ni * 16 + fr; const float gj = GC[j];
#pragma unroll
            for (int r = 0; r < 4; ++r) {
                const int i = mi * 16 + fq * 4 + r;
                const float dec = (i >= j) ? expf(GC[i] - gj) : 0.f;
                LS[i * 68 + j] = (i > j) ? BE[i] * aK[r] * dec : 0.f;
                it[32768 + i * 64 + j] = f2bf(aQ[r] * dec);
            }
        }
        __syncthreads();
        if (t < 256) {
            const bool isw = t >= 128; const int cc = t & 127;
            bf16_t* op = it + (isw ? 8192 : 0) + cc;
            LAS const float* src = isw ? KF : VF;
            float x[64];
            int z0; asm volatile("v_mov_b32 %0, 0" : "=v"(z0));
            LAS const float* LSv = LS + z0;
            LAS const float* facp = (isw ? (GC + 192) : BE) + z0;
#pragma unroll
            for (int i = 0; i < 64; ++i) {
                float s = facp[i] * src[i * 128 + cc];
#pragma unroll
                for (int j = 0; j < i; ++j) s -= LSv[i * 68 + j] * x[j];
                x[i] = s;
                op[i * 128] = f2bf(s);
                asm volatile("" ::: "memory");
            }
        } else {
            const int t2 = t - 256;
            { const int i = t2 >> 2, cs = (t2 & 3) * 32; const float e = EG[i];
#pragma unroll
              for (int q = 0; q < 4; ++q) { const u32x4 w = *(const LAS u32x4*)(QS + i * 136 + cs + q * 8);
                  u32x4 o; o.x = pk_bf16(lo_bf(w.x) * e, hi_bf(w.x) * e); o.y = pk_bf16(lo_bf(w.y) * e, hi_bf(w.y) * e); o.z = pk_bf16(lo_bf(w.z) * e, hi_bf(w.z) * e); o.w = pk_bf16(lo_bf(w.w) * e, hi_bf(w.w) * e);
                  *(u32x4*)(it + 16384 + i * 128 + cs + q * 8) = o; } }
            { const int d = t2 >> 1, hf = t2 & 1; const float gl = GC[63];
#pragma unroll
              for (int q = 0; q < 4; ++q) { float v[8];
#pragma unroll
                  for (int e = 0; e < 8; ++e) { const int i = hf * 32 + q * 8 + e; v[e] = KF[i * 128 + d] * expf(gl - GC[i]); }
                  u32x4 o; o.x = pk_bf16(v[0], v[1]); o.y = pk_bf16(v[2], v[3]); o.z = pk_bf16(v[4], v[5]); o.w = pk_bf16(v[6], v[7]);
                  *(u32x4*)(it + 24576 + d * 64 + hf * 32 + q * 8) = o; } }
            if (t2 == 0) GLAST[item] = expf(GC[63]);
        }
        __syncthreads();
    }
}

__device__ void gla_prep(LAS unsigned char* lds, PPtr p, int layer, const int wid_s) {
    const int t = fresh_tid(wid_s), wv = t >> 6, lane = t & 63, fr = lane & 15, fq = lane >> 4;
    LAS bf16_t* QA = (LAS bf16_t*)(lds + 32768);
    LAS bf16_t* KD = (LAS bf16_t*)(lds + 50176);
    LAS float* TOT = (LAS float*)(lds + 67584);
    const bf16_t* Z = (const bf16_t*)(p->ws + WS_Z);
    const float* SMp = (const float*)(p->ws + WS_SM);
    unsigned char* GLP = p->ws + WS_GLP;
    for (int item = fresh_bid(); item < 1024; item += fresh_gdim()) {
        const int n = item & 63, h = (item >> 6) & 3, b = item >> 8;
        const size_t row0 = (size_t)b * SEQ + n * 64;
        bf16_t* it = (bf16_t*)(GLP + (size_t)item * GL_ITEM);
        const int d = t & 127, iq = __builtin_amdgcn_readfirstlane(t >> 7);
        float wup[16];
#pragma unroll
        for (int r = 0; r < 16; ++r) wup[r] = p->in[10][(size_t)layer * 16 * 512 + r * 512 + h * 128 + d];
        const float bup = p->in[11][layer * 512 + h * 128 + d];
        float la[16]; float run = 0.f;
#pragma unroll
        for (int ii = 0; ii < 16; ++ii) {
            const float* gl = SMp + (row0 + iq * 16 + ii) * 32 + 16;
            float dot = bup;
#pragma unroll
            for (int r = 0; r < 16; ++r) dot += gl[r] * wup[r];
            const float ls = fminf(dot, 0.f) - log1pf(__expf(-fabsf(dot)));
            run += ls * (1.f / 16.f); la[ii] = run;
        }
        TOT[iq * 128 + d] = run;
        __syncthreads();
        float off = 0.f, blast = 0.f;
#pragma unroll
        for (int q = 0; q < 4; ++q) { const float v = TOT[q * 128 + d]; blast += v; if (q < iq) off += v; }
        float kdv[16];
#pragma unroll
        for (int ii = 0; ii < 16; ++ii) {
            const int i = iq * 16 + ii; const float bc = la[ii] + off;
            const float q = bf2f(Z[(row0 + i) * ZW + GQ + h * 128 + d]) * 0.08838834764831845f;
            const float k = bf2f(Z[(row0 + i) * ZW + GK + h * 128 + d]);
            it[i * 128 + d] = f2bf(q * __expf(bc));
            QA[i * 136 + d] = f2bf(q * __expf(bc - blast));
            const float kd = k * __expf(blast - bc);
            KD[i * 136 + d] = f2bf(kd); kdv[ii] = kd;
        }
        { u32x4 o0, o1;
          o0.x = pk_bf16(kdv[0], kdv[1]); o0.y = pk_bf16(kdv[2], kdv[3]); o0.z = pk_bf16(kdv[4], kdv[5]); o0.w = pk_bf16(kdv[6], kdv[7]);
          o1.x = pk_bf16(kdv[8], kdv[9]); o1.y = pk_bf16(kdv[10], kdv[11]); o1.z = pk_bf16(kdv[12], kdv[13]); o1.w = pk_bf16(kdv[14], kdv[15]);
          *(u32x4*)(it + 8192 + d * 64 + iq * 16) = o0; *(u32x4*)(it + 8192 + d * 64 + iq * 16 + 8) = o1; }
        if (iq == 0) ((float*)((unsigned char*)it + 73728))[d] = __expf(blast);
        __syncthreads();
#pragma unroll
        for (int tt = 0; tt < 2; ++tt) {
            const int tile = wv * 2 + tt, mi = tile >> 2, ni = tile & 3;
            f32x4 a = {0.f, 0.f, 0.f, 0.f};
#pragma unroll
            for (int ks = 0; ks < 4; ++ks) {
                const bf16x8 bfr = *(const LAS bf16x8*)(KD + (ni * 16 + fr) * 136 + ks * 32 + fq * 8);
                const bf16x8 aq = *(const LAS bf16x8*)(QA + (mi * 16 + fr) * 136 + ks * 32 + fq * 8);
                a = mfma16(aq, bfr, a);
            }
            const int j = ni * 16 + fr;
#pragma unroll
            for (int r = 0; r < 4; ++r) { const int i = mi * 16 + fq * 4 + r; it[16384 + i * 64 + j] = f2bf(i >= j ? a[r] : 0.f); }
        }
        { const int e = t & 255, hf = t >> 8;
#pragma unroll
          for (int q = 0; q < 4; ++q) { bf16_t v[8];
#pragma unroll
              for (int e2 = 0; e2 < 8; ++e2) v[e2] = Z[(row0 + hf * 32 + q * 8 + e2) * ZW + GV + h * 256 + e];
              u32x4 o; o.x = v[0] | ((unsigned)v[1] << 16); o.y = v[2] | ((unsigned)v[3] << 16); o.z = v[4] | ((unsigned)v[5] << 16); o.w = v[6] | ((unsigned)v[7] << 16);
              *(u32x4*)(it + 20480 + e * 64 + hf * 32 + q * 8) = o; } }
        __syncthreads();
    }
}

__device__ void dn_scan(LAS unsigned char* lds, PPtr p, int bh, int es, const int wid_s) {
    const int t = fresh_tid(wid_s), wv = t >> 6, lane = t & 63, fr = lane & 15, fq = lane >> 4;
    const int mt = wv & 3, et = wv >> 2;
    LAS bf16_t* ST = (LAS bf16_t*)lds;
    LAS bf16_t* VT = (LAS bf16_t*)(lds + 8704);
    const bf16_t* DNP = (const bf16_t*)(p->ws + WS_DNP);
    const float* GLAST = (const float*)(p->ws + WS_MISC);
    bf16_t* OA = (bf16_t*)(p->ws + WS_H);
    for (int i = t; i < 32 * 136 / 2; i += 512) ((LAS unsigned*)ST)[i] = 0u;
    f32x4 S0 = {0.f, 0.f, 0.f, 0.f}, S1 = {0.f, 0.f, 0.f, 0.f};
    __syncthreads();
    const int b = bh >> 3, h = bh & 7;
    struct DF { bf16x8 wf[4], qf[4], af[2], kf[2]; float uv[4]; float gl; };
    auto dload = [&](int n) __attribute__((always_inline)) {
        DF f; const bf16_t* it = DNP + (size_t)(bh * 64 + n) * 36864;
#pragma unroll
        for (int ks = 0; ks < 4; ++ks) { f.wf[ks] = *(const bf16x8*)(it + 8192 + (mt * 16 + fr) * 128 + ks * 32 + fq * 8); f.qf[ks] = *(const bf16x8*)(it + 16384 + (mt * 16 + fr) * 128 + ks * 32 + fq * 8); }
#pragma unroll
        for (int ks = 0; ks < 2; ++ks) { f.af[ks] = *(const bf16x8*)(it + 32768 + (mt * 16 + fr) * 64 + ks * 32 + fq * 8); f.kf[ks] = *(const bf16x8*)(it + 24576 + (wv * 16 + fr) * 64 + ks * 32 + fq * 8); }
#pragma unroll
        for (int r = 0; r < 4; ++r) f.uv[r] = bf2f(it[(mt * 16 + fq * 4 + r) * 128 + es * 32 + et * 16 + fr]);
        f.gl = GLAST[bh * 64 + n];
        return f; };
    DF cf = dload(0);
#pragma unroll 1
    for (int n = 0; n < 64; ++n) {
        const DF nf = dload(n < 63 ? n + 1 : 63);
        const bf16x8 (&wf)[4] = cf.wf; const bf16x8 (&qf)[4] = cf.qf; const bf16x8 (&af)[2] = cf.af; const bf16x8 (&kf)[2] = cf.kf; const float (&uv)[4] = cf.uv; const float gl = cf.gl;
        f32x4 P = {0.f, 0.f, 0.f, 0.f}, Q = {0.f, 0.f, 0.f, 0.f};
#pragma unroll
        for (int ks = 0; ks < 4; ++ks) { const bf16x8 bfr = *(const LAS bf16x8*)(ST + (et * 16 + fr) * 136 + ks * 32 + fq * 8); P = mfma16(wf[ks], bfr, P); Q = mfma16(qf[ks], bfr, Q); }
        const f32x4 vn = {uv[0] - P[0], uv[1] - P[1], uv[2] - P[2], uv[3] - P[3]};
        *(LAS u32x2*)(VT + (et * 16 + fr) * 72 + mt * 16 + fq * 4) = pk4(vn);
        __syncthreads();
#pragma unroll
        for (int ks = 0; ks < 2; ++ks) { const bf16x8 bfr = *(const LAS bf16x8*)(VT + (et * 16 + fr) * 72 + ks * 32 + fq * 8); Q = mfma16(af[ks], bfr, Q); }
#pragma unroll
        for (int r = 0; r < 4; ++r) OA[((size_t)b * SEQ + n * 64 + mt * 16 + fq * 4 + r) * 1024 + h * 128 + es * 32 + et * 16 + fr] = f2bf(Q[r]);
        S0 *= gl; S1 *= gl;
#pragma unroll
        for (int ks = 0; ks < 2; ++ks) {
            const bf16x8 b0 = *(const LAS bf16x8*)(VT + fr * 72 + ks * 32 + fq * 8);
            const bf16x8 b1 = *(const LAS bf16x8*)(VT + (16 + fr) * 72 + ks * 32 + fq * 8);
            S0 = mfma16(kf[ks], b0, S0); S1 = mfma16(kf[ks], b1, S1);
        }
        *(LAS u32x2*)(ST + fr * 136 + wv * 16 + fq * 4) = pk4(S0);
        *(LAS u32x2*)(ST + (16 + fr) * 136 + wv * 16 + fq * 4) = pk4(S1);
        __syncthreads();
        cf = nf;
    }
}

__device__ void gla_scan(LAS unsigned char* lds, PPtr p, int bh, int es, const int wid_s) {
    const int t = fresh_tid(wid_s), wv = t >> 6, lane = t & 63, fr = lane & 15, fq = lane >> 4;
    const int mt = wv & 3, eh = wv >> 2;
    LAS bf16_t* STb = (LAS bf16_t*)lds;
    const unsigned char* GLP = p->ws + WS_GLP;
    bf16_t* OB = (bf16_t*)(p->ws + WS_H) + (size_t)MTOK * 1024;
    for (int i = t; i < 64 * 136 / 2; i += 512) ((LAS unsigned*)STb)[i] = 0u;
    f32x4 S[4];
#pragma unroll
    for (int e = 0; e < 4; ++e) S[e] = (f32x4){0.f, 0.f, 0.f, 0.f};
    __syncthreads();
    const int b = bh >> 2, h = bh & 3;
    struct GF { bf16x8 qf[4], af[2], kf[2], vB[4][2]; f32x4 al; };
    auto gload = [&](int n) __attribute__((always_inline)) {
        GF f; const unsigned char* itb = GLP + (size_t)(bh * 64 + n) * GL_ITEM; const bf16_t* it = (const bf16_t*)itb;
#pragma unroll
        for (int ks = 0; ks < 4; ++ks) f.qf[ks] = *(const bf16x8*)(it + (mt * 16 + fr) * 128 + ks * 32 + fq * 8);
#pragma unroll
        for (int ks = 0; ks < 2; ++ks) { f.af[ks] = *(const bf16x8*)(it + 16384 + (mt * 16 + fr) * 64 + ks * 32 + fq * 8); f.kf[ks] = *(const bf16x8*)(it + 8192 + (wv * 16 + fr) * 64 + ks * 32 + fq * 8); }
#pragma unroll
        for (int e = 0; e < 4; ++e)
#pragma unroll
            for (int ks = 0; ks < 2; ++ks) f.vB[e][ks] = *(const bf16x8*)(it + 20480 + (es * 64 + e * 16 + fr) * 64 + ks * 32 + fq * 8);
        f.al = *(const f32x4*)((const float*)(itb + 73728) + wv * 16 + fq * 4);
        return f; };
    GF cf = gload(0);
#pragma unroll 1
    for (int n = 0; n < 64; ++n) {
        const GF nf = gload(n < 63 ? n + 1 : 63);
        LAS bf16_t* cur = STb + (n & 1) * (64 * 136);
        LAS bf16_t* nxt = STb + ((n + 1) & 1) * (64 * 136);
        const bf16x8 (&qf)[4] = cf.qf; const bf16x8 (&af)[2] = cf.af; const bf16x8 (&kf)[2] = cf.kf; const bf16x8 (&vB)[4][2] = cf.vB; const f32x4 al = cf.al;
        bf16x8 vO[2][2];
#pragma unroll
        for (int e2 = 0; e2 < 2; ++e2)
#pragma unroll
            for (int ks = 0; ks < 2; ++ks) vO[e2][ks] = eh ? vB[2 + e2][ks] : vB[e2][ks];
#pragma unroll
        for (int e2 = 0; e2 < 2; ++e2) {
            const int etile = eh * 2 + e2;
            f32x4 O = {0.f, 0.f, 0.f, 0.f};
#pragma unroll
            for (int ks = 0; ks < 4; ++ks) { const bf16x8 bfr = *(const LAS bf16x8*)(cur + (etile * 16 + fr) * 136 + ks * 32 + fq * 8); O = mfma16(qf[ks], bfr, O); }
#pragma unroll
            for (int ks = 0; ks < 2; ++ks) O = mfma16(af[ks], vO[e2][ks], O);
#pragma unroll
            for (int r = 0; r < 4; ++r) OB[((size_t)b * SEQ + n * 64 + mt * 16 + fq * 4 + r) * 1024 + h * 256 + es * 64 + etile * 16 + fr] = f2bf(O[r]);
        }
#pragma unroll
        for (int e = 0; e < 4; ++e) {
            S[e] *= al;
#pragma unroll
            for (int ks = 0; ks < 2; ++ks) S[e] = mfma16(kf[ks], vB[e][ks], S[e]);
            *(LAS u32x2*)(nxt + (e * 16 + fr) * 136 + wv * 16 + fq * 4) = pk4(S[e]);
        }
        __syncthreads();
        cf = nf;
    }
}

__device__ __forceinline__ void s5_scan(LAS unsigned char* ldsw, PPtr p, int layer, int b, int g, const int wid_s) {
    const int lane = fresh_tid(wid_s) & 63, fr = lane & 15, fq = lane >> 4;
    bf16_t* Z = (bf16_t*)(p->ws + WS_Z);
    const float* lam_re = p->in[14] + (size_t)(layer * 64 + g) * 64;
    const float* lam_im = p->in[15] + (size_t)(layer * 64 + g) * 64;
    const float dt = expf(p->in[16][layer * 64 + g]);
    const float* b_re = p->in[17] + (size_t)(layer * 64 + g) * 64 * 16;
    const float* b_im = p->in[18] + (size_t)(layer * 64 + g) * 64 * 16;
    const float* c_re = p->in[19] + (size_t)(layer * 64 + g) * 16 * 64;
    const float* c_im = p->in[20] + (size_t)(layer * 64 + g) * 16 * 64;
    const float dsk = p->in[21][layer * 1024 + g * 16 + fr];
    float ar, ai;
    { const float lr = fminf(lam_re[lane], -1e-4f), li = lam_im[lane]; const float mag = expf(lr * dt); ar = mag * cosf(li * dt); ai = mag * sinf(li * dt); }
    bf16x8 bB[8];
#pragma unroll
    for (int nt = 0; nt < 8; ++nt) {
        const int pp = (nt * 16 + fr) & 63;
        const float lr = fminf(lam_re[pp], -1e-4f), li = lam_im[pp]; const float mag = expf(lr * dt);
        const float a_r = mag * cosf(li * dt), a_i = mag * sinf(li * dt), nr = a_r - 1.f, den = lr * lr + li * li;
        const float zr = (nr * lr + a_i * li) / den, zi = (a_i * lr - nr * li) / den;
        float v[8];
#pragma unroll
        for (int j = 0; j < 8; ++j) {
            float val = 0.f;
            if (fq < 2) { const float br = b_re[pp * 16 + fq * 8 + j], bi = b_im[pp * 16 + fq * 8 + j]; val = (nt >= 4) ? (zr * bi + zi * br) : (zr * br - zi * bi); }
            v[j] = val;
        }
        u32x4 o; o.x = pk_bf16(v[0], v[1]); o.y = pk_bf16(v[2], v[3]); o.z = pk_bf16(v[4], v[5]); o.w = pk_bf16(v[6], v[7]);
        bB[nt] = __builtin_bit_cast(bf16x8, o);
    }
    bf16x8 cB[4];
#pragma unroll
    for (int ks = 0; ks < 4; ++ks) {
        const int kb = ks * 32 + fq * 8;
        float v[8];
#pragma unroll
        for (int j = 0; j < 8; ++j) v[j] = (ks < 2) ? c_re[fr * 64 + kb + j] : -c_im[fr * 64 + kb - 64 + j];
        u32x4 o; o.x = pk_bf16(v[0], v[1]); o.y = pk_bf16(v[2], v[3]); o.z = pk_bf16(v[4], v[5]); o.w = pk_bf16(v[6], v[7]);
        cB[ks] = __builtin_bit_cast(bf16x8, o);
    }
    LAS float* BU = (LAS float*)ldsw;
    LAS bf16_t* X = (LAS bf16_t*)(ldsw + 8192);
    float xr = 0.f, xi = 0.f;
    struct UF { u32x4 ur; bf16_t ue[4]; };
    auto uload = [&](int tile) __attribute__((always_inline)) {
        UF f; const size_t row0 = (size_t)b * SEQ + tile * 16;
        f.ur = (u32x4){0u, 0u, 0u, 0u};
        if (fq < 2) f.ur = *(const u32x4*)(Z + (row0 + fr) * ZW + SU + g * 16 + fq * 8);
#pragma unroll
        for (int r = 0; r < 4; ++r) f.ue[r] = Z[(row0 + fq * 4 + r) * ZW + SU + g * 16 + fr];
        return f; };
    UF u0 = uload(0), u1 = uload(1);
#pragma unroll 1
    for (int tile = 0; tile < 256; ++tile) {
        const size_t row0 = (size_t)b * SEQ + tile * 16;
        const UF u2 = uload(tile < 254 ? tile + 2 : 255);
        const bf16x8 ua = __builtin_bit_cast(bf16x8, u0.ur);
#pragma unroll
        for (int nt = 0; nt < 8; ++nt) {
            f32x4 acc = {0.f, 0.f, 0.f, 0.f};
            acc = mfma16(ua, bB[nt], acc);
#pragma unroll
            for (int r = 0; r < 4; ++r) BU[(fq * 4 + r) * 128 + nt * 16 + fr] = acc[r];
        }
        asm volatile("s_waitcnt lgkmcnt(0)" ::: "memory");
#pragma unroll
        for (int tt = 0; tt < 16; ++tt) {
            const float bur = BU[tt * 128 + lane], bui = BU[tt * 128 + 64 + lane];
            const float nxr = ar * xr - ai * xi + bur, nxi = ar * xi + ai * xr + bui;
            xr = nxr; xi = nxi;
            X[tt * 136 + lane] = f2bf(xr); X[tt * 136 + 64 + lane] = f2bf(xi);
        }
        asm volatile("s_waitcnt lgkmcnt(0)" ::: "memory");
        f32x4 acc = {0.f, 0.f, 0.f, 0.f};
#pragma unroll
        for (int ks = 0; ks < 4; ++ks) { const bf16x8 xa = *(const LAS bf16x8*)(X + fr * 136 + ks * 32 + fq * 8); acc = mfma16(xa, cB[ks], acc); }
#pragma unroll
        for (int r = 0; r < 4; ++r) {
            bf16_t* zp = Z + (row0 + fq * 4 + r) * ZW + ZQ + g * 16 + fr;
            const float u = bf2f(u0.ue[r]);
            *zp = f2bf(geluf_(acc[r] + dsk * u));
        }
        asm volatile("s_waitcnt lgkmcnt(0)" ::: "memory");
        u0 = u1; u1 = u2;
    }
}

template <int W> __device__ void head_norm_gate(bf16_t* O, const bf16_t* Zg  , const float* nw, const int wid_s) {
    constexpr int LPG = W / 8;
    const size_t ngroups = (size_t)MTOK * (1024 / W);
    const int t_ = fresh_tid(wid_s), lane_ = t_ & 63;
    const size_t gthreads = (size_t)fresh_gdim() * 512, gid = (size_t)fresh_bid() * 512 + t_;
    for (size_t idx = gid; idx < ngroups * LPG; idx += gthreads) {
        const size_t grp = idx / LPG; const int l = (int)(idx % LPG);
        const size_t row = grp / (1024 / W); const int hh = (int)(grp % (1024 / W));
        const int col = hh * W + l * 8;
        bf16_t* op = O + row * 1024 + col;
        const u32x4 w = *(const u32x4*)op;
        float v[8] = {lo_bf(w.x), hi_bf(w.x), lo_bf(w.y), hi_bf(w.y), lo_bf(w.z), hi_bf(w.z), lo_bf(w.w), hi_bf(w.w)};
        float ss = 0.f;
#pragma unroll
        for (int c = 0; c < 8; ++c) ss += v[c] * v[c];
#pragma unroll
        for (int o = 1; o < LPG; o <<= 1) ss += shx(ss, o, lane_);
        const float inv = rsqrtf(ss * (1.f / W) + EPS);
        const u32x4 gz = *(const u32x4*)(Zg + row * ZW + col);
        const float gzv[8] = {lo_bf(gz.x), hi_bf(gz.x), lo_bf(gz.y), hi_bf(gz.y), lo_bf(gz.z), hi_bf(gz.z), lo_bf(gz.w), hi_bf(gz.w)};
#pragma unroll
        for (int c = 0; c < 8; ++c) v[c] = v[c] * inv * nw[l * 8 + c] * siluf_(gzv[c]);
        u32x4 o; o.x = pk_bf16(v[0], v[1]); o.y = pk_bf16(v[2], v[3]); o.z = pk_bf16(v[4], v[5]); o.w = pk_bf16(v[6], v[7]);
        *(u32x4*)op = o;
    }
}

__device__ void xattn(LAS unsigned char* lds, const bf16_t* XQ, const bf16_t* Kb, const bf16_t* VTg, bf16_t* XO, const int wid_s) {
    const int t = fresh_tid(wid_s), wv = t >> 6, lane = t & 63, fr = lane & 15, fq = lane >> 4;
    LAS bf16_t* Pw = (LAS bf16_t*)(lds + wv * 8448);
    for (int item = fresh_bid(); item < 512; item += fresh_gdim()) {
        const int qt = item & 31, hd = (item >> 5) & 3, b = item >> 7;
        const size_t r0 = (size_t)b * SEQ + qt * 128 + wv * 16;
        bf16x8 qf[4];
#pragma unroll
        for (int ks = 0; ks < 4; ++ks) qf[ks] = *(const bf16x8*)(XQ + (r0 + fr) * 512 + hd * 128 + ks * 32 + fq * 8);
        f32x4 s[16];
#pragma unroll
        for (int nt = 0; nt < 16; ++nt) {
            f32x4 a = {0.f, 0.f, 0.f, 0.f};
#pragma unroll
            for (int ks = 0; ks < 4; ++ks) { const bf16x8 kfr = *(const bf16x8*)(Kb + ((size_t)b * 256 + nt * 16 + fr) * 512 + hd * 128 + ks * 32 + fq * 8); a = mfma16(qf[ks], kfr, a); }
            s[nt] = a * 0.08838834764831845f;
        }
        float mx[4], sm[4];
#pragma unroll
        for (int r = 0; r < 4; ++r) {
            float m = s[0][r];
#pragma unroll
            for (int nt = 1; nt < 16; ++nt) m = fmaxf(m, s[nt][r]);
            m = fmaxf(m, shx(m, 1, lane)); m = fmaxf(m, shx(m, 2, lane)); m = fmaxf(m, shx(m, 4, lane)); m = fmaxf(m, shx(m, 8, lane));
            mx[r] = m;
            float su = 0.f;
#pragma unroll
            for (int nt = 0; nt < 16; ++nt) { const float e = __expf(s[nt][r] - m); s[nt][r] = e; su += e; }
            su += shx(su, 1, lane); su += shx(su, 2, lane); su += shx(su, 4, lane); su += shx(su, 8, lane);
            sm[r] = 1.f / su;
        }
#pragma unroll
        for (int nt = 0; nt < 16; ++nt)
#pragma unroll
            for (int r = 0; r < 4; ++r) Pw[(fq * 4 + r) * 264 + nt * 16 + fr] = f2bf(s[nt][r] * sm[r]);
        __syncthreads();
        bf16x8 pf[8];
#pragma unroll
        for (int ks = 0; ks < 8; ++ks) pf[ks] = *(const LAS bf16x8*)(Pw + fr * 264 + ks * 32 + fq * 8);
#pragma unroll
        for (int dtile = 0; dtile < 8; ++dtile) {
            f32x4 o = {0.f, 0.f, 0.f, 0.f};
#pragma unroll
            for (int ks = 0; ks < 8; ++ks) { const bf16x8 vfr = *(const bf16x8*)(VTg + ((size_t)(b * 4 + hd) * 128 + dtile * 16 + fr) * 256 + ks * 32 + fq * 8); o = mfma16(pf[ks], vfr, o); }
#pragma unroll
            for (int r = 0; r < 4; ++r) XO[(r0 + fq * 4 + r) * 512 + hd * 128 + dtile * 16 + fr] = f2bf(o[r]);
        }
        __syncthreads();
    }
}

__device__ void ffn_act(const bf16_t* G, const bf16_t* U, const float* cw, bf16_t* ACT, const int wid_s) {
    const unsigned nitems = (unsigned)(FF / 8) * (MTOK / 16);
    const unsigned gthreads = (unsigned)fresh_gdim() * 512u, gid = (unsigned)fresh_bid() * 512u + (unsigned)fresh_tid(wid_s);
    for (unsigned idx = gid; idx < nitems; idx += gthreads) {
        const unsigned cg = idx % (FF / 8), tb = idx / (FF / 8);
        const unsigned c0 = cg * 8, t0 = tb * 16;
        float w0[8], w1[8], w2[8];
#pragma unroll
        for (int c = 0; c < 8; ++c) { w0[c] = cw[(c0 + c) * 3]; w1[c] = cw[(c0 + c) * 3 + 1]; w2[c] = cw[(c0 + c) * 3 + 2]; }
        float g2[8], g1[8];
        const bool start = (t0 & (SEQ - 1)) == 0;
        const unsigned base = t0 * FF + c0;
        { u32x4 a = {0u, 0u, 0u, 0u}, bq = {0u, 0u, 0u, 0u};
          if (!start) { a = *(const u32x4*)(G + (base - 2 * FF)); bq = *(const u32x4*)(G + (base - FF)); }
          g2[0] = lo_bf(a.x); g2[1] = hi_bf(a.x); g2[2] = lo_bf(a.y); g2[3] = hi_bf(a.y); g2[4] = lo_bf(a.z); g2[5] = hi_bf(a.z); g2[6] = lo_bf(a.w); g2[7] = hi_bf(a.w);
          g1[0] = lo_bf(bq.x); g1[1] = hi_bf(bq.x); g1[2] = lo_bf(bq.y); g1[3] = hi_bf(bq.y); g1[4] = lo_bf(bq.z); g1[5] = hi_bf(bq.z); g1[6] = lo_bf(bq.w); g1[7] = hi_bf(bq.w); }
#pragma unroll 4
        for (unsigned tt = 0; tt < 16; ++tt) {
            const unsigned off = base + tt * FF;
            const u32x4 a = *(const u32x4*)(G + off);
            const u32x4 uq = *(const u32x4*)(U + off);
            const float g0[8] = {lo_bf(a.x), hi_bf(a.x), lo_bf(a.y), hi_bf(a.y), lo_bf(a.z), hi_bf(a.z), lo_bf(a.w), hi_bf(a.w)};
            const float uu[8] = {lo_bf(uq.x), hi_bf(uq.x), lo_bf(uq.y), hi_bf(uq.y), lo_bf(uq.z), hi_bf(uq.z), lo_bf(uq.w), hi_bf(uq.w)};
            float r[8];
#pragma unroll
            for (int c = 0; c < 8; ++c) { const float y = w0[c] * g2[c] + w1[c] * g1[c] + w2[c] * g0[c]; r[c] = geluf_(y) * uu[c]; g2[c] = g1[c]; g1[c] = g0[c]; }
            u32x4 o; o.x = pk_bf16(r[0], r[1]); o.y = pk_bf16(r[2], r[3]); o.z = pk_bf16(r[4], r[5]); o.w = pk_bf16(r[6], r[7]);
            *(u32x4*)(ACT + off) = o;
        }
    }
}

__device__ void ffn_fix(const bf16_t* GB, const bf16_t* UB, const float* cw, bf16_t* ACT, const int wid_s) {
    const unsigned nitems = 256u * 2u * (FF / 8);
    const unsigned gthreads = (unsigned)fresh_gdim() * 512u, gid = (unsigned)fresh_bid() * 512u + (unsigned)fresh_tid(wid_s);
    for (unsigned idx = gid; idx < nitems; idx += gthreads) {
        const unsigned cg = idx % (FF / 8), rest = idx / (FF / 8), rr = rest & 1u, rb = rest >> 1;
        const unsigned c0 = cg * 8;
        const bool first = (rb & 63u) == 0u;
        const u32x4 zero = {0u, 0u, 0u, 0u};
        const u32x4 a0 = *(const u32x4*)(GB + (size_t)(rb * 4 + 2 + rr) * FF + c0);
        u32x4 a1, a2;
        if (rr == 0) { a1 = first ? zero : *(const u32x4*)(GB + (size_t)((rb - 1) * 4 + 1) * FF + c0); a2 = first ? zero : *(const u32x4*)(GB + (size_t)((rb - 1) * 4 + 0) * FF + c0); }
        else         { a1 = *(const u32x4*)(GB + (size_t)(rb * 4 + 2) * FF + c0);                     a2 = first ? zero : *(const u32x4*)(GB + (size_t)((rb - 1) * 4 + 1) * FF + c0); }
        const u32x4 uq = *(const u32x4*)(UB + (size_t)(rb * 2 + rr) * FF + c0);
        const float g0[8] = {lo_bf(a0.x), hi_bf(a0.x), lo_bf(a0.y), hi_bf(a0.y), lo_bf(a0.z), hi_bf(a0.z), lo_bf(a0.w), hi_bf(a0.w)};
        const float g1[8] = {lo_bf(a1.x), hi_bf(a1.x), lo_bf(a1.y), hi_bf(a1.y), lo_bf(a1.z), hi_bf(a1.z), lo_bf(a1.w), hi_bf(a1.w)};
        const float g2[8] = {lo_bf(a2.x), hi_bf(a2.x), lo_bf(a2.y), hi_bf(a2.y), lo_bf(a2.z), hi_bf(a2.z), lo_bf(a2.w), hi_bf(a2.w)};
        const float uu[8] = {lo_bf(uq.x), hi_bf(uq.x), lo_bf(uq.y), hi_bf(uq.y), lo_bf(uq.z), hi_bf(uq.z), lo_bf(uq.w), hi_bf(uq.w)};
        float r[8];
#pragma unroll
        for (int c = 0; c < 8; ++c) { const float y = cw[(c0 + c) * 3] * g2[c] + cw[(c0 + c) * 3 + 1] * g1[c] + cw[(c0 + c) * 3 + 2] * g0[c]; r[c] = geluf_(y) * uu[c]; }
        u32x4 o; o.x = pk_bf16(r[0], r[1]); o.y = pk_bf16(r[2], r[3]); o.z = pk_bf16(r[4], r[5]); o.w = pk_bf16(r[6], r[7]);
        *(u32x4*)(ACT + (size_t)(rb * 64 + rr) * FF + c0) = o;
    }
}

__device__ void convert_layer_small(LAS float* ldsf, PPtr p, int l, const int wid_s) {
    unsigned char* ws = p->ws;
    convert_w(ldsf, p->in[4] + (size_t)l * 2048 * 14368, (bf16_t*)(ws + WS_WA), 2048, 14368, ZN, 1, wid_s);
    convert_w(ldsf, p->in[9] + (size_t)l * 1024 * 2048, (bf16_t*)(ws + WS_WDN), 1024, 2048, 2048, 0, wid_s);
    convert_w(ldsf, p->in[13] + (size_t)l * 1024 * 2048, (bf16_t*)(ws + WS_WGLA), 1024, 2048, 2048, 0, wid_s);
    convert_w(ldsf, p->in[22] + (size_t)l * 1024 * 4096, (bf16_t*)(ws + WS_WGLU), 1024, 4096, 4096, 2, wid_s);
    convert_w(ldsf, p->in[23] + (size_t)l * 2048 * 2048, (bf16_t*)(ws + WS_WMIX), 2048, 2048, 2048, 0, wid_s);
    convert_w(ldsf, p->in[27] + (size_t)l * 2048 * 512, (bf16_t*)(ws + WS_WXQ), 2048, 512, 512, 0, wid_s);
    convert_w(ldsf, p->in[28] + (size_t)l * 2048 * 1024, (bf16_t*)(ws + WS_WXKV), 2048, 1024, 1024, 0, wid_s);
    convert_w(ldsf, p->in[29] + (size_t)l * 512 * 2048, (bf16_t*)(ws + WS_WXO), 512, 2048, 2048, 0, wid_s);
}
__device__ void convert_layer_ffn(LAS float* ldsf, PPtr p, int l, const int wid_s, int nb, int bi) {
    unsigned char* ws = p->ws;
    convert_w(ldsf, p->in[32] + (size_t)l * 2048 * 11264, (bf16_t*)(ws + WS_WA), 2048, 11264, 11264, 3, wid_s, nb, bi);
    convert_w(ldsf, p->in[34] + (size_t)l * 5632 * 2048, (bf16_t*)(ws + WS_WA + 46137344), 5632, 2048, 2048, 0, wid_s, nb, bi);
}


#ifdef DEBUG_NAN
__device__ __noinline__ void chk_f32(const float* q, size_t n, unsigned bit, unsigned* flag) {
    const size_t gthreads = (size_t)gridDim.x * 512, gid = (size_t)blockIdx.x * 512 + threadIdx.x; bool bad = false;
    for (size_t i = gid; i < n; i += gthreads) { const float v = q[i]; if (!(fabsf(v) < 1e30f)) bad = true; }
    if (bad) atomicOr(flag, 1u << bit);
}
__device__ __noinline__ void chk_bf16(const bf16_t* q, size_t n, unsigned bit, unsigned* flag) {
    const size_t gthreads = (size_t)gridDim.x * 512, gid = (size_t)blockIdx.x * 512 + threadIdx.x; bool bad = false;
    for (size_t i = gid; i < n; i += gthreads) { const float v = bf2f(q[i]); if (!(fabsf(v) < 1e30f)) bad = true; }
    if (bad) atomicOr(flag, 1u << bit);
}
#define CHKF(ptr, n, bit) do { if (l == DEBUG_NAN - 1) { chk_f32(ptr, n, bit, (unsigned*)(PP()->ws + WS_MISC + 32768)); } gsync(grid); } while (0)
#define CHKB(ptr, n, bit) do { if (l == DEBUG_NAN - 1) { chk_bf16(ptr, n, bit, (unsigned*)(PP()->ws + WS_MISC + 32768)); } xbar(wid_s); } while (0)
#else
#define CHKF(ptr, n, bit) do {} while (0)
#define CHKB(ptr, n, bit) do {} while (0)
#endif
#ifdef DEBUG_TS
__device__ __forceinline__ bool ts_in(const int* sel, int n, int k) { for (int q = 0; q < n; ++q) if (sel[q] == k) return true; return false; }
#define TS(k) do { const unsigned long long t_ = __builtin_amdgcn_s_memrealtime(); const int selA_[] = DEBUG_TS_A; const int selB_[] = DEBUG_TS_B; \
    const int kk_ = (k) % 20; \
    if (ts_in(selA_, (int)(sizeof(selA_) / sizeof(int)), kk_)) tsA += t_ - tsL; if (ts_in(selB_, (int)(sizeof(selB_) / sizeof(int)), kk_)) tsB += t_ - tsL; tsL = t_; } while (0)
#else
#define TS(k) do {} while (0)
#endif
#ifndef PMASK
#define PMASK 0xFFFFFFFFu
#endif
#define ON(k) ((PMASK >> (k)) & 1u)
constexpr size_t WS_LIMIT = 941621248;
static_assert(WS_END <= WS_LIMIT, "workspace map exceeds the guaranteed workspace size");
static_assert(WS_DNP + (size_t)MTOK * FF * 2 <= WS_MISC, "ACT does not fit");
static_assert((size_t)MTOK * FF * 2 * 2 <= SZ_Z, "G,U do not fit in Z");

#define m_ws (PP()->ws)
#define m_Z ((bf16_t*)(m_ws + WS_Z))
#define m_Y ((bf16_t*)(m_ws + WS_Z))
#define m_SMp ((float*)(m_ws + WS_SM))
#define m_H ((bf16_t*)(m_ws + WS_H))
#define m_OA m_H
#define m_OB (m_H + (size_t)MTOK * 1024)
#define m_MRG ((bf16_t*)(m_ws + WS_DNP))
#define m_XQ ((bf16_t*)(m_ws + WS_DNP))
#define m_XO ((bf16_t*)(m_ws + WS_DNP + (size_t)MTOK * 512 * 2))
#define m_ACT ((bf16_t*)(m_ws + WS_DNP))
#define m_MB ((bf16_t*)(m_ws + WS_GLP))
#define m_MEMN ((bf16_t*)(m_ws + WS_GLP))
#define m_KB ((bf16_t*)(m_ws + WS_GLP + 4194304))
#define m_VTG ((bf16_t*)(m_ws + WS_GLP + 5242880))
#define m_G ((bf16_t*)(m_ws + WS_Z))
#define m_U ((bf16_t*)(m_ws + WS_Z + 16777216))
#define m_xs ((bf16_t*)(m_ws + WS_XS))
#define m_out (PP()->out)
#define p PP()
__global__ void __launch_bounds__(512, 2) fwd_megakernel(Params p_unused) {
    extern __shared__ __attribute__((aligned(16))) unsigned char lds_raw[];
    LAS unsigned char* lds = (LAS unsigned char*)lds_raw;
    LAS float* ldsf = (LAS float*)lds_raw;
    cg::grid_group grid = cg::this_grid();
    if ((threadIdx.x & 63) == 0) ((LAS int*)(lds + 131072))[__builtin_amdgcn_s_getreg(10244) & 63] = (int)(threadIdx.x >> 6);
    { unsigned* bar0 = (unsigned*)(PP()->ws + WS_BAR);
      if (threadIdx.x == 0) { volatile LAS unsigned* st = (volatile LAS unsigned*)(lds + XB_LDS_OFF); st[0] = 0u; st[1] = 0u;
          (void)xb_add(&bar0[XB_XCNT(xb_xcc_id())], 1u); } }
    __syncthreads();
    constexpr int wid_s = 0;
#ifdef DEBUG_TS
    unsigned long long tsA = 0ull, tsB = 0ull, tsL = __builtin_amdgcn_s_memrealtime();
#endif
    if (ON(0)) convert_layer_small(ldsf, p, 0, wid_s);
    if (ON(1)) norm_rows(p->in[0], nullptr, nullptr, nullptr, nullptr, m_xs, p->in[2], m_H, MTOK, wid_s);
    if (PP()->ws == nullptr) grid.sync();
    xbar(wid_s); TS(0);

#pragma unroll 1
    for (int l = 0; l < 2; ++l) {
        if (ON(2)) { EpiZ e; e.Z = m_Z; e.SMp = m_SMp; run_gemm(lds, m_H, DM, (const bf16_t*)(m_ws + WS_WA), MTOK, ZN, DM, e, wid_s); }
#ifdef REPEAT_PH1
        { EpiZ e; e.Z = m_Z; e.SMp = m_SMp; run_gemm(lds, m_H, DM, (const bf16_t*)(m_ws + WS_WA), MTOK, ZN, DM, e, wid_s); }
#endif
        xbar(wid_s); TS(l * 20 + 1);

#ifdef DEBUG_Z
        {
            unsigned long long* cw = (unsigned long long*)(PP()->ws + WS_MISC + 32768);
            const size_t gthreads = (size_t)gridDim.x * 512, gid = (size_t)blockIdx.x * 512 + threadIdx.x;
            const bf16_t* zz = m_Z; const bf16_t* wa = (const bf16_t*)(m_ws + WS_WA);
            unsigned long long c = 0, mi = ~0ull, cwa = 0;
            for (size_t i = gid; i < (size_t)MTOK * ZW; i += gthreads) { const float v = bf2f(zz[i]); if (!(fabsf(v) < 1e30f)) { ++c; if (i < mi) mi = i; } }
            for (size_t i = gid; i < (size_t)ZN * 2048; i += gthreads) { const float v = bf2f(wa[i]); if (!(fabsf(v) < 1e30f)) ++cwa; }
            if (c) { atomicAdd(cw, c); atomicMin(cw + 1, mi); }
            if (cwa) atomicAdd(cw + 2, cwa);
            xbar(wid_s);
            const unsigned long long C = cw[0], MI = cw[1], WB = cw[2];
            const int pnf = (int)((MI % ZW) / 256), pmf = (int)((MI / ZW) / 256);
            const int wb = WB == 0 ? 0 : (WB < 1000 ? 1 : 2), zb = C < 10000 ? 0 : (C < 10000000 ? 1 : 2);
            const float e1 = exp10f(10.f + (float)(pmf / 4));
            const float v1 = (10.f + pnf) * e1, v2 = (10.f + 10.f * (3 * wb + zb)) * e1 * 0.01f;
            float* o = PP()->out;
            for (size_t i = gid; i < (size_t)MTOK * DM; i += gthreads) o[i] = (i == 0) ? v1 : v2;
            return;
        }
#endif

        CHKB(m_H, (size_t)MTOK * DM, 0); CHKB(m_Z, (size_t)MTOK * ZW, 1); CHKF(m_SMp, (size_t)MTOK * 32, 2);
        if (ON(3)) dn_prep(lds, p, l, wid_s);
        if (ON(4)) gla_prep(lds, p, l, wid_s);
        xbar(wid_s); TS(l * 20 + 2);
        CHKB((const bf16_t*)(m_ws + WS_DNP), (size_t)DN_ITEM * 1024, 3); CHKB((const bf16_t*)(m_ws + WS_GLP), (size_t)GL_ITEM * 512, 4);
        for (int role = blockIdx.x; role < 256; role += gridDim.x) {
            if (role < 128) { if (ON(5)) dn_scan(lds, p, role >> 2, role & 3, wid_s); }
            else if (role < 192) { if (ON(6)) gla_scan(lds, p, (role - 128) >> 2, (role - 128) & 3, wid_s); }
            else { const int wv = fresh_tid(wid_s) >> 6; if (ON(7) && wv < 4) { const int pair = (role - 192) * 4 + wv; s5_scan(lds + wv * 12544, p, l, pair >> 6, pair & 63, wid_s); } }
            __syncthreads();
        }
        { const int bid_ = fresh_bid(), gd_ = fresh_gdim(), nbc = gd_ >= 256 ? 192 : gd_; if (ON(0) && bid_ < nbc) convert_layer_ffn(ldsf, p, l, wid_s, nbc, bid_); }
        xbar(wid_s); TS(l * 20 + 3);
#ifdef REPEAT_PH3
        for (int role = blockIdx.x; role < 256; role += gridDim.x) {
            if (role < 128) { if (ON(5)) dn_scan(lds, p, role >> 2, role & 3, wid_s); }
            else if (role < 192) { if (ON(6)) gla_scan(lds, p, (role - 128) >> 2, (role - 128) & 3, wid_s); }
            else { const int wv = fresh_tid(wid_s) >> 6; if (ON(7) && wv < 4) { const int pair = (role - 192) * 4 + wv; s5_scan(lds + wv * 12544, p, l, pair >> 6, pair & 63, wid_s); } }
            __syncthreads();
        }
        xbar(wid_s);
#endif
        CHKB(m_OA, (size_t)MTOK * 1024, 5); CHKB(m_OB, (size_t)MTOK * 1024, 6); CHKB(m_Z, (size_t)MTOK * ZW, 7);
        if (ON(8)) head_norm_gate<128>(m_OA, m_Z + ZZ, p->in[8] + l * 128, wid_s);
        if (ON(8)) head_norm_gate<256>(m_OB, m_Z + GR, p->in[12] + l * 256, wid_s);
        if (ON(9)) { EpiGLU e; e.Z = m_Z; e.MRG = m_MRG; run_gemm(lds, m_Z + ZQ, ZW, (const bf16_t*)(m_ws + WS_WGLU), MTOK, 4096, 1024, e, wid_s); }
        xbar(wid_s); TS(l * 20 + 4);
        CHKB(m_OA, (size_t)MTOK * 2048, 8); CHKB(m_MRG, (size_t)MTOK * DM, 9);
        if (ON(10)) { EpiAcc<false> e; e.Z = m_Z; e.MRG = m_MRG; e.MB = nullptr; e.goff = 0; run_gemm(lds, m_OA, 1024, (const bf16_t*)(m_ws + WS_WDN), MTOK, DM, 1024, e, wid_s); }
        if (ON(10)) { EpiAcc<true> e; e.Z = m_Z; e.MRG = m_MRG; e.MB = m_MB; e.goff = 2048; run_gemm(lds, m_OB, 1024, (const bf16_t*)(m_ws + WS_WGLA), MTOK, DM, 1024, e, wid_s); }
        xbar(wid_s); TS(l * 20 + 5);
        CHKB(m_MB, (size_t)MTOK * DM, 10);
        if (ON(11)) { EpiBf16 e; e.C = m_Y; e.ldc = DM; run_gemm(lds, m_MB, DM, (const bf16_t*)(m_ws + WS_WMIX), MTOK, DM, DM, e, wid_s); }
        xbar(wid_s); TS(l * 20 + 6);
        CHKF(m_Y, (size_t)MTOK * DM, 11);
        if (ON(1)) norm_rows(nullptr, m_xs, m_Y, p->in[3] + l * DM, nullptr, m_xs, p->in[24] + l * DM, m_H, MTOK, wid_s);
        if (ON(1)) norm_rows(p->in[1], nullptr, nullptr, nullptr, nullptr, nullptr, p->in[26] + l * DM, m_MEMN, 1024, wid_s);
        xbar(wid_s); TS(l * 20 + 7);
        CHKB(m_xs, (size_t)MTOK * DM, 12); CHKB(m_H, (size_t)MTOK * DM, 13);
        if (ON(12)) { EpiBf16 e; e.C = m_XQ; e.ldc = 512; run_gemm(lds, m_H, DM, (const bf16_t*)(m_ws + WS_WXQ), MTOK, 512, DM, e, wid_s); }
        if (ON(13)) { EpiKV e; e.Kb = m_KB; e.VT = m_VTG; run_gemm(lds, m_MEMN, DM, (const bf16_t*)(m_ws + WS_WXKV), 1024, 1024, DM, e, wid_s, 128); }
        xbar(wid_s); TS(l * 20 + 8);
        CHKB(m_XQ, (size_t)MTOK * 512, 14); CHKB(m_KB, (size_t)1024 * 1024, 15);
        if (ON(14)) xattn(lds, m_XQ, m_KB, m_VTG, m_XO, wid_s);
        xbar(wid_s); TS(l * 20 + 9);
        CHKB(m_XO, (size_t)MTOK * 512, 16);
        if (ON(11)) { EpiBf16 e; e.C = m_Y; e.ldc = DM; run_gemm(lds, m_XO, 512, (const bf16_t*)(m_ws + WS_WXO), MTOK, DM, 512, e, wid_s); }
        xbar(wid_s); TS(l * 20 + 10);
        CHKF(m_Y, (size_t)MTOK * DM, 17);
        if (ON(1)) norm_rows(nullptr, m_xs, m_Y, p->in[25] + l * DM, nullptr, m_xs, p->in[30] + l * DM, m_H, MTOK, wid_s);
        xbar(wid_s); TS(l * 20 + 11);
        CHKB(m_xs, (size_t)MTOK * DM, 18);
        if (ON(15)) { EpiFFN e; e.ACT = m_ACT; e.GB = m_G; e.UB = m_U; e.cw = p->in[33] + (size_t)l * FF * 3; run_gemm(lds, m_H, DM, (const bf16_t*)(m_ws + WS_WA), MTOK, 2 * FF, DM, e, wid_s); }
        xbar(wid_s); TS(l * 20 + 12);
        CHKB(m_G, (size_t)MTOK * FF * 2, 19);
        if (ON(16)) ffn_fix(m_G, m_U, p->in[33] + (size_t)l * FF * 3, m_ACT, wid_s);
        xbar(wid_s); TS(l * 20 + 13);
        CHKB(m_ACT, (size_t)MTOK * FF, 20);
        if (ON(11)) { EpiBf16 e; e.C = m_Y; e.ldc = DM; run_gemm(lds, m_ACT, FF, (const bf16_t*)(m_ws + WS_WA + 46137344), MTOK, DM, FF, e, wid_s); }
        xbar(wid_s); TS(l * 20 + 14);
        CHKF(m_Y, (size_t)MTOK * DM, 21);
        if (l == 0) {
            if (ON(1)) norm_rows(nullptr, m_xs, m_Y, p->in[31] + l * DM, nullptr, m_xs, p->in[2] + DM, m_H, MTOK, wid_s);
            if (ON(0)) convert_layer_small(ldsf, p, 1, wid_s);
        } else {
            if (ON(1)) norm_rows(nullptr, m_xs, m_Y, p->in[31] + l * DM, m_out, nullptr, nullptr, nullptr, MTOK, wid_s);
        }
        xbar(wid_s); TS(l * 20 + 15);
        }
#ifdef DEBUG_TS
    {   const float A = (float)tsA * 0.01f, B = (float)tsB * 0.01f;
        xbar(wid_s);
        const unsigned gthreads = (unsigned)fresh_gdim() * 512u, gid = (unsigned)fresh_bid() * 512u + (unsigned)fresh_tid(wid_s);
        float* o = PP()->out;
        for (unsigned i = gid; i < (unsigned)MTOK * DM; i += gthreads) o[i] = (i == 0u) ? B * 10000.f : A;
    }
#endif
#ifdef DEBUG_NAN
    { const unsigned f = *(volatile unsigned*)(PP()->ws + WS_MISC + 32768); int idx = -1; for (int k = 0; k < 32; ++k) if ((f >> k) & 1u) { idx = k; break; }
      bool finalbad = false; const size_t gthreads = (size_t)gridDim.x * 512, gid = (size_t)blockIdx.x * 512 + threadIdx.x;
      const float val = idx < 0 ? 16.f : exp2f(5.f + idx);
      float* o = PP()->out;
      for (size_t i = gid; i < (size_t)MTOK * DM; i += gthreads) { if (idx >= 0) o[i] = val; else { const float v = o[i]; if (!(fabsf(v) < 1e30f)) o[i] = 16.f; } } }
#endif
}

#undef m_ws
#undef m_Z
#undef m_Y
#undef m_SMp
#undef m_H
#undef m_OA
#undef m_OB
#undef m_MRG
#undef m_XQ
#undef m_XO
#undef m_ACT
#undef m_MB
#undef m_MEMN
#undef m_KB
#undef m_VTG
#undef m_G
#undef m_U
#undef m_xs
#undef m_out
#undef p
extern "C" void kernel_launch(void* const* d_in, const int* in_sizes, int n_in,
                              void* d_out, int out_size, void* d_ws, size_t ws_size,
                              hipStream_t stream) {
    static int grid_blocks = 0;
    constexpr int kDynLds = 131072 + 512;
    if (!grid_blocks) {
        int dev = 0, cus = 0, per_cu = 0;
        (void)hipGetDevice(&dev);
        (void)hipDeviceGetAttribute(&cus, hipDeviceAttributeMultiprocessorCount, dev);
        if (hipFuncSetAttribute((const void*)fwd_megakernel, hipFuncAttributeMaxDynamicSharedMemorySize, kDynLds) != hipSuccess) fprintf(stderr, "hipFuncSetAttribute failed\n");
        if (hipOccupancyMaxActiveBlocksPerMultiprocessor(&per_cu, (const void*)fwd_megakernel, 512, kDynLds) != hipSuccess || per_cu < 1) { fprintf(stderr, "occupancy query: %d\n", per_cu); per_cu = 1; }
        (void)hipGetLastError();
        grid_blocks = cus;
        if (n_in != 35 || ws_size < WS_END) fprintf(stderr, "kernel_launch: unexpected n_in %d or ws_size %zu (< %zu)\n", n_in, ws_size, (size_t)WS_END);
    }
    Params hp{};
    for (int i = 0; i < 35; ++i) hp.in[i] = (const float*)d_in[i];
    hp.out = (float*)d_out; hp.ws = (unsigned char*)d_ws;
    (void)hipMemsetAsync((unsigned char*)d_ws + WS_BAR, 0, XCD_BAR_WORDS * 4, stream);
    void* args[] = {&hp};
    hipError_t e = hipLaunchCooperativeKernel((const void*)fwd_megakernel, dim3(grid_blocks), dim3(512), args, kDynLds, stream);
    if (e != hipSuccess) fprintf(stderr, "cooperative launch failed: %s (grid %d)\n", hipGetErrorString(e), grid_blocks);
}
```

```cpp
#include <hip/hip_runtime.h>
#include <hip/hip_cooperative_groups.h>
#include <cstdio>
#include <type_traits>
namespace cg = cooperative_groups;

#define LAS __attribute__((address_space(3)))
typedef unsigned short bf16_t;
typedef short bf16x8 __attribute__((ext_vector_type(8)));
typedef float f32x4 __attribute__((ext_vector_type(4)));
typedef unsigned u32x2 __attribute__((ext_vector_type(2)));
typedef unsigned u32x4 __attribute__((ext_vector_type(4)));

constexpr int MTOK = 16384, DM = 2048, SEQ = 4096, NB = 4;
constexpr int ZW = 14336;
constexpr int ZN = 14592;
constexpr int ZQ = 0, ZK = 1024, ZV = 2048, ZZ = 3072, GQ = 4096, GK = 4608, GV = 5120, GR = 6144, SU = 7168, GT = 8192;
constexpr int FF = 5632;
constexpr float EPS = 1e-6f;

constexpr size_t WS_WA   = 0;
constexpr size_t SZ_WA   = 69206016;
constexpr size_t WS_WDN  = WS_WA + SZ_WA;
constexpr size_t WS_WGLA = WS_WDN + 4194304;
constexpr size_t WS_WGLU = WS_WGLA + 4194304;
constexpr size_t WS_WMIX = WS_WGLU + 8388608;
constexpr size_t WS_WXQ  = WS_WMIX + 8388608;
constexpr size_t WS_WXKV = WS_WXQ + 2097152;
constexpr size_t WS_WXO  = WS_WXKV + 4194304;
constexpr size_t WS_Z    = WS_WXO + 2097152;
constexpr size_t SZ_Z    = (size_t)MTOK * ZW * 2;
constexpr size_t WS_SM   = WS_Z + SZ_Z;
constexpr size_t WS_H    = WS_SM + (size_t)MTOK * 32 * 4;
constexpr size_t WS_DNP  = WS_H + (size_t)MTOK * DM * 2;
constexpr size_t DN_ITEM = 73728;
constexpr size_t WS_GLP  = WS_DNP + DN_ITEM * 2048;
constexpr size_t GL_ITEM = 74240;
constexpr size_t WS_MISC = WS_GLP + GL_ITEM * 1024;
constexpr size_t WS_BAR  = WS_MISC + 16384;
constexpr size_t WS_XS   = WS_MISC + 65536;
constexpr size_t WS_END  = WS_XS + (size_t)MTOK * DM * 2;

struct Params { const float* in[35]; float* out; unsigned char* ws; };
typedef const __attribute__((address_space(4))) Params* PPtr;
__device__ __forceinline__ int fresh_tid(int) {
    int hw = __builtin_amdgcn_s_getreg(10244) & 63; asm volatile("" : "+s"(hw));
    const int w = __builtin_amdgcn_readfirstlane(*(const volatile LAS int*)((LAS unsigned char*)nullptr + 131072 + hw * 4));
    const int ln = __builtin_amdgcn_mbcnt_hi(~0u, __builtin_amdgcn_mbcnt_lo(~0u, 0u)); int t = w * 64 + ln; asm volatile("" : "+v"(t)); return t; }
__device__ __forceinline__ int fresh_bid() { int b = blockIdx.x; asm volatile("" : "+s"(b)); return b; }
__device__ __forceinline__ int fresh_gdim() { int b = gridDim.x; asm volatile("" : "+s"(b)); return b; }
__device__ __forceinline__ PPtr PP() { auto kp = __builtin_amdgcn_kernarg_segment_ptr(); asm volatile("" : "+s"(kp)); return (PPtr)kp; }

__device__ __forceinline__ float bf2f(bf16_t v) { return __uint_as_float(((unsigned)v) << 16); }
typedef float f32x2_t __attribute__((ext_vector_type(2)));
typedef __bf16 bf16x2_t __attribute__((ext_vector_type(2)));
__device__ __forceinline__ unsigned pk_bf16(float lo, float hi) { const f32x2_t v = {lo, hi}; const bf16x2_t b = __builtin_convertvector(v, bf16x2_t); return __builtin_bit_cast(unsigned, b); }
__device__ __forceinline__ bf16_t f2bf(float f) { return (bf16_t)(pk_bf16(f, 0.f) & 0xffffu); }
__device__ __forceinline__ float sigmoidf_(float x) { return 1.f / (1.f + __expf(-x)); }
__device__ __forceinline__ float siluf_(float x) { return x * sigmoidf_(x); }
__device__ __forceinline__ float geluf_(float x) { const float u = 1.5957691216057308f * (x + 0.044715f * x * x * x); return x * sigmoidf_(u); }
__device__ __forceinline__ float softplusf_(float x) { return x > 20.f ? x : log1pf(__expf(x)); }
__device__ __forceinline__ float shx(float v, int mask, int lane) { return __int_as_float(__builtin_amdgcn_ds_bpermute((lane ^ mask) << 2, __float_as_int(v))); }
__device__ __forceinline__ float shup(float v, int delta, int lane) { return __int_as_float(__builtin_amdgcn_ds_bpermute((lane - delta) << 2, __float_as_int(v))); }
__device__ __forceinline__ float lo_bf(unsigned w) { return __uint_as_float(w << 16); }
__device__ __forceinline__ float hi_bf(unsigned w) { return __uint_as_float(w & 0xffff0000u); }
__device__ __forceinline__ f32x4 mfma16(bf16x8 a, bf16x8 b, f32x4 c) { return __builtin_amdgcn_mfma_f32_16x16x32_bf16(a, b, c, 0, 0, 0); }

__device__ __forceinline__ void gsync(cg::grid_group& grid) {
    __builtin_amdgcn_fence(__ATOMIC_RELEASE, "agent");
    asm volatile("s_waitcnt vmcnt(0) lgkmcnt(0)" ::: "memory");
    grid.sync();
    __builtin_amdgcn_fence(__ATOMIC_ACQUIRE, "agent");
    asm volatile("s_waitcnt vmcnt(0)" ::: "memory");
#ifdef EXTRA_SYNC
    __builtin_amdgcn_fence(__ATOMIC_RELEASE, "agent");
    asm volatile("s_waitcnt vmcnt(0) lgkmcnt(0)" ::: "memory");
    grid.sync();
    __builtin_amdgcn_fence(__ATOMIC_ACQUIRE, "agent");
    asm volatile("s_waitcnt vmcnt(0)" ::: "memory");
#endif
}


#define XB_TMO      128
#define XB_XCNT(j)  (256  + 64 * (j))
#define XB_XSUB(j)  (1280 + 64 * (j))
#define XB_XGEN(j)  (2304 + 64 * (j))
#define XB_TOP      3328
#define XB_TOPGEN   3392
#define XCD_BAR_WORDS 3456
#define XB_SPIN_CAP (1u << 20)
constexpr int XB_LDS_OFF = 131072 + 256;
__device__ __forceinline__ unsigned xb_ld(unsigned* p)              { return __hip_atomic_load(p, __ATOMIC_RELAXED, __HIP_MEMORY_SCOPE_AGENT); }
__device__ __forceinline__ unsigned xb_add(unsigned* p, unsigned v) { return __hip_atomic_fetch_add(p, v, __ATOMIC_RELAXED, __HIP_MEMORY_SCOPE_AGENT); }
__device__ __forceinline__ unsigned xb_xcc_id() { return (unsigned)__builtin_amdgcn_s_getreg((3 << 11) | 20) & 0xFu; }
#define XB_SPIN(cond, bar) do { unsigned _sp = 0; while (cond) { __builtin_amdgcn_s_sleep(1); \
    if ((++_sp & 255u) == 0u) { if (xb_ld(&(bar)[XB_TMO])) break; if (_sp > XB_SPIN_CAP) { atomicAdd(&(bar)[XB_TMO], 1u); break; } } } } while (0)
__device__ __forceinline__ void xcd_barrier_complete(unsigned* bar, unsigned x, unsigned& nloc, unsigned& nx) {
    const unsigned G = gridDim.x;
    unsigned sum, cnt, mine, sp = 0u;
    for (;;) {
        sum = 0u; cnt = 0u; mine = 0u;
#pragma unroll
        for (unsigned j = 0; j < 16; ++j) { const unsigned c = xb_ld(&bar[XB_XCNT(j)]); sum += c; cnt += (c > 0u) ? 1u : 0u; mine = (j == x) ? c : mine; }
        if (sum == G) break;
        __builtin_amdgcn_s_sleep(1);
        if ((++sp & 255u) == 0u) { if (xb_ld(&bar[XB_TMO])) break; if (sp > XB_SPIN_CAP) { atomicAdd(&bar[XB_TMO], 1u); break; } }
    }
    nloc = mine > 0u ? mine : 1u; nx = cnt > 0u ? cnt : 1u;
}
__device__ __forceinline__ void xbar(const int wid_s) {
    asm volatile("s_waitcnt vmcnt(0)" ::: "memory");
    __syncthreads();
    unsigned* bar = (unsigned*)(PP()->ws + WS_BAR);
    if (fresh_tid(wid_s) == 0) {
        volatile LAS unsigned* st = (volatile LAS unsigned*)((LAS unsigned char*)nullptr + XB_LDS_OFF);
        const unsigned x = xb_xcc_id();
        __builtin_amdgcn_s_waitcnt(0);
        unsigned nloc = st[0], nx = st[1];
        if (nloc == 0u) { xcd_barrier_complete(bar, x, nloc, nx); st[0] = nloc; st[1] = nx; }
        const unsigned old = xb_add(&bar[XB_XSUB(x)], 1u);
        const unsigned gen = old / nloc;
        if (old + 1u == (gen + 1u) * nloc) {
            __builtin_amdgcn_fence(__ATOMIC_RELEASE, "agent");
            asm volatile("s_waitcnt vmcnt(0)" ::: "memory");
            const unsigned og = xb_add(&bar[XB_TOP], 1u);
            const unsigned tg = og / nx;
            if (og + 1u == (tg + 1u) * nx) xb_add(&bar[XB_TOPGEN], 1u);
            else XB_SPIN(xb_ld(&bar[XB_TOPGEN]) == tg, bar);
            __builtin_amdgcn_fence(__ATOMIC_ACQUIRE, "agent");
            xb_add(&bar[XB_XGEN(x)], 1u);
            asm volatile("s_waitcnt vmcnt(0)" ::: "memory");
        } else {
            XB_SPIN(xb_ld(&bar[XB_XGEN(x)]) == gen, bar);
            __builtin_amdgcn_fence(__ATOMIC_ACQUIRE, "agent");
            asm volatile("s_waitcnt vmcnt(0)" ::: "memory");
        }
    }
    __syncthreads();
}

constexpr int BM = 256, BK = 64, HALF = 128, HTB = HALF * BK * 2, STAGE_BYTES = 8 * HTB, NXCD = 8, WGM = 8;
__device__ __forceinline__ int lds_byte(int r, int c) { const int st = (r >> 4) * 2 + (c >> 5), rr = r & 15, cc = c & 31, ob = rr * 64 + cc * 2; return st * 1024 + (ob ^ (((ob >> 9) & 1) << 5)); }
__device__ __forceinline__ void stage_rc(int b, int& R, int& C) { const int st = b / 1024, sb = b % 1024, swz = sb ^ (((sb >> 9) & 1) << 5); R = (st >> 1) * 16 + swz / 64; C = (st & 1) * 32 + (swz % 64) / 2; }
__device__ __forceinline__ int perm32(int rho) { const int n = rho >> 4, i = rho & 15; return 8 * (i >> 2) + 4 * n + (i & 3); }
struct Unit { int pm, pn; };
struct Gemm { const bf16_t* A; const bf16_t* Bt; int M, N, K, lda; };
struct StaticOrder {
    int nM, nN, nwg, G, c;
    __device__ void init(int M, int N, int G_, int c_) { nM = M / BM; nN = N / BM; nwg = nM * nN; G = G_; c = c_; }
    __device__ bool next(int i, Unit& u) const {
        const long L = (long)i * G + c; if (L >= nwg) return false;
        int wgid = (int)L; { const int q = nwg / NXCD, r = nwg % NXCD, xcd = wgid % NXCD, off = wgid / NXCD; wgid = (xcd < r ? xcd * (q + 1) : r * (q + 1) + (xcd - r) * q) + off; }
        const int nig = WGM * nN, gid = wgid / nig, fm = gid * WGM, gsz = (nM - fm) < WGM ? (nM - fm) : WGM;
        u.pm = fm + ((wgid % nig) % gsz); u.pn = (wgid % nig) / gsz; return true;
    }
};

template <class Epi>
__device__ __forceinline__ void gemm_phase(LAS unsigned char* lds, const Gemm g, const StaticOrder& S, const Epi& E, const int wid_s) {
    const int tid = fresh_tid(wid_s), wid = __builtin_amdgcn_readfirstlane(tid >> 6), lane = tid & 63, wr = wid >> 2, wc = wid & 3, fr = lane & 15, fq = lane >> 4;
    const int K = g.K, nt = K / BK, lda = g.lda;
    unsigned voffA[2], voffB[2];
#pragma unroll
    for (int i = 0; i < 2; ++i) { int R, C; stage_rc(tid * 16 + i * 8192, R, C); const int Rb = Epi::PERM ? ((R & ~31) + perm32(R & 31)) : R; voffA[i] = (unsigned)(R * lda + C) * 2u; voffB[i] = (unsigned)(Rb * K + C) * 2u; }
    const size_t kstep = (size_t)(BK * 2);
    const size_t hstepA = (size_t)HALF * lda * 2, hstepB = (size_t)HALF * K * 2;
    const size_t tstepA = 2 * hstepA, tstepB = 2 * hstepB;
    const unsigned ldsw = (unsigned)wid * 1024u;
    const int aoff = lds_byte(wr * 64 + fr, fq * 8), boff = lds_byte(wc * 32 + fr, fq * 8);
#define PG8_SA(b, h) (((b) * 2 + (h)) * HTB)
#define PG8_SB(b, h) ((4 + (b) * 2 + (h)) * HTB)
#define PG8_STAGE(bufoff, gbase, voff) do { _Pragma("unroll") for (int _i = 0; _i < 2; ++_i) \
        __builtin_amdgcn_global_load_lds((const unsigned*)((const char*)(gbase) + (voff)[_i]), (LAS unsigned*)(lds + (bufoff) + ldsw + _i * 8192), 16, 0, 0); } while (0)
#define PG8_LDA(dst, b, h) do { _Pragma("unroll") for (int m = 0; m < 4; ++m) _Pragma("unroll") for (int k = 0; k < 2; ++k) dst[m][k] = *(const LAS bf16x8*)(lds + PG8_SA(b, h) + aoff + m * 2048 + k * 1024); } while (0)
#define PG8_LDB(dst, b, h) do { _Pragma("unroll") for (int n = 0; n < 2; ++n) _Pragma("unroll") for (int k = 0; k < 2; ++k) dst[n][k] = *(const LAS bf16x8*)(lds + PG8_SB(b, h) + boff + n * 2048 + k * 1024); } while (0)
#define PG8_MMA(ai, bj, At, Bt) do { __builtin_amdgcn_s_setprio(1); _Pragma("unroll") for (int m = 0; m < 4; ++m) _Pragma("unroll") for (int n = 0; n < 2; ++n) _Pragma("unroll") for (int k = 0; k < 2; ++k) \
        acc[ai][bj][m][n] = __builtin_amdgcn_mfma_f32_16x16x32_bf16(Bt[n][k], At[m][k], acc[ai][bj][m][n], 0, 0, 0); __builtin_amdgcn_s_setprio(0); } while (0)
#define PG8_WAIT_V(n) asm volatile("s_waitcnt vmcnt(" #n ")" ::: "memory")
#define PG8_WAIT_L(n) asm volatile("s_waitcnt lgkmcnt(" #n ")" ::: "memory")
#define PG8_BAR __builtin_amdgcn_s_barrier()
#define PG8_SCHED __builtin_amdgcn_sched_barrier(0)
    Unit cur, nxt; int ui = 0;
    if (!S.next(0, cur)) return;
    f32x4 acc[2][2][4][2];
#pragma unroll
    for (int a = 0; a < 2; ++a)
#pragma unroll
        for (int b = 0; b < 2; ++b)
#pragma unroll
            for (int m = 0; m < 4; ++m)
#pragma unroll
                for (int n = 0; n < 2; ++n) acc[a][b][m][n] = (f32x4){0.f, 0.f, 0.f, 0.f};
    bf16x8 At[4][2], B0[2][2], B1[2][2];
    const char* cA = (const char*)g.A + (size_t)cur.pm * tstepA; const char* cB = (const char*)g.Bt + (size_t)cur.pn * tstepB;
    PG8_STAGE(PG8_SB(0, 0), cB, voffB); PG8_STAGE(PG8_SA(0, 0), cA, voffA); PG8_STAGE(PG8_SB(0, 1), cB + hstepB, voffB); PG8_STAGE(PG8_SA(0, 1), cA + hstepA, voffA);
    if (wr == 1) PG8_BAR;
    PG8_WAIT_V(4); PG8_BAR;
    PG8_STAGE(PG8_SB(1, 0), cB + kstep, voffB); PG8_STAGE(PG8_SA(1, 0), cA + kstep, voffA); PG8_STAGE(PG8_SB(1, 1), cB + hstepB + kstep, voffB);
    PG8_WAIT_V(6); PG8_BAR;
    for (;;) {
        const bool has_next = S.next(ui + 1, nxt);
        const char* nA = has_next ? (const char*)g.A + (size_t)nxt.pm * tstepA : cA; const char* nB = has_next ? (const char*)g.Bt + (size_t)nxt.pn * tstepB : cB;
        for (int t = 0; t < nt; t += 2) {
            const bool last = (t == nt - 2);
            const char* a1 = cA + (size_t)(t + 1) * kstep;
            const char* a2 = last ? nA : cA + (size_t)(t + 2) * kstep; const char* b2 = last ? nB : cB + (size_t)(t + 2) * kstep;
            const char* a3 = a2 + kstep; const char* b3 = b2 + kstep;
            PG8_LDB(B0, 0, 0); PG8_SCHED; PG8_LDA(At, 0, 0); PG8_STAGE(PG8_SA(1, 1), a1 + hstepA, voffA);
            PG8_WAIT_L(8); PG8_BAR; PG8_WAIT_L(0); PG8_MMA(0, 0, At, B0); PG8_BAR; PG8_SCHED;
            PG8_LDB(B1, 0, 1); PG8_STAGE(PG8_SB(0, 0), b2, voffB);
            PG8_BAR; PG8_WAIT_L(0); PG8_MMA(0, 1, At, B1); PG8_BAR;
            PG8_LDA(At, 0, 1); PG8_STAGE(PG8_SA(0, 0), a2, voffA);
            PG8_BAR; PG8_WAIT_L(0); PG8_MMA(1, 0, At, B0); PG8_BAR; PG8_SCHED;
            PG8_STAGE(PG8_SB(0, 1), b2 + hstepB, voffB);
            PG8_WAIT_V(6); PG8_BAR; PG8_MMA(1, 1, At, B1); PG8_BAR;
            PG8_LDB(B0, 1, 0); PG8_SCHED; PG8_LDA(At, 1, 0); PG8_STAGE(PG8_SA(0, 1), a2 + hstepA, voffA);
            PG8_WAIT_L(8); PG8_BAR; PG8_WAIT_L(0); PG8_MMA(0, 0, At, B0); PG8_BAR; PG8_SCHED;
            PG8_LDB(B1, 1, 1); PG8_STAGE(PG8_SB(1, 0), b3, voffB);
            PG8_BAR; PG8_WAIT_L(0); PG8_MMA(0, 1, At, B1); PG8_BAR;
            PG8_LDA(At, 1, 1); PG8_STAGE(PG8_SA(1, 0), a3, voffA);
            PG8_BAR; PG8_WAIT_L(0); PG8_MMA(1, 0, At, B0); PG8_BAR; PG8_SCHED;
            PG8_STAGE(PG8_SB(1, 1), b3 + hstepB, voffB);
            PG8_WAIT_V(6); PG8_BAR; PG8_MMA(1, 1, At, B1); PG8_BAR;
        }
        E(acc, cur, wr, wc, fr, fq);
        if (!has_next) break;
#pragma unroll
        for (int a = 0; a < 2; ++a)
#pragma unroll
            for (int b = 0; b < 2; ++b)
#pragma unroll
                for (int m = 0; m < 4; ++m)
#pragma unroll
                    for (int n = 0; n < 2; ++n) acc[a][b][m][n] = (f32x4){0.f, 0.f, 0.f, 0.f};
        cur = nxt; cA = nA; cB = nB; ++ui;
    }
    PG8_WAIT_V(0);
    if (wr == 0) PG8_BAR;
    PG8_BAR;
#undef PG8_SA
#undef PG8_SB
#undef PG8_STAGE
#undef PG8_LDA
#undef PG8_LDB
#undef PG8_MMA
#undef PG8_WAIT_V
#undef PG8_WAIT_L
#undef PG8_BAR
#undef PG8_SCHED
}

typedef const f32x4 (&AccRef)[2][2][4][2];
__device__ __forceinline__ u32x2 pk4(f32x4 v) { u32x2 r; r.x = pk_bf16(v[0], v[1]); r.y = pk_bf16(v[2], v[3]); return r; }
__device__ __forceinline__ f32x4 ld_bf4(const bf16_t* p) { const u32x2 w = *(const u32x2*)p; return (f32x4){lo_bf(w.x), hi_bf(w.x), lo_bf(w.y), hi_bf(w.y)}; }
__device__ __forceinline__ f32x4 sig4(f32x4 v) { return (f32x4){sigmoidf_(v[0]), sigmoidf_(v[1]), sigmoidf_(v[2]), sigmoidf_(v[3])}; }

struct EpiZ { static constexpr bool PERM = true; bf16_t* Z; float* SMp;
    __device__ __forceinline__ void operator()(AccRef acc, const Unit& u, int wr, int wc, int fr, int fq) const {
        const int row0 = u.pm * BM + wr * 64 + fr;
        if (u.pn < 56) {
#pragma unroll
            for (int ai = 0; ai < 2; ++ai)
#pragma unroll
                for (int m = 0; m < 4; ++m) { bf16_t* rp = Z + (size_t)(row0 + ai * HALF + m * 16) * ZW + u.pn * BM + wc * 32 + 8 * fq;
#pragma unroll
                    for (int bj = 0; bj < 2; ++bj) { const u32x2 lo = pk4(acc[ai][bj][m][0]), hi = pk4(acc[ai][bj][m][1]); *(u32x4*)(rp + bj * HALF) = (u32x4){lo.x, lo.y, hi.x, hi.y}; } }
        } else if (wc == 0) {
#pragma unroll
            for (int ai = 0; ai < 2; ++ai)
#pragma unroll
                for (int m = 0; m < 4; ++m) { float* rp = SMp + (size_t)(row0 + ai * HALF + m * 16) * 32 + 8 * fq;
#pragma unroll
                    for (int n = 0; n < 2; ++n) *(f32x4*)(rp + n * 4) = acc[ai][0][m][n]; }
        }
    }
};
struct EpiF32 { static constexpr bool PERM = false; float* C; int ldc;
    __device__ __forceinline__ void operator()(AccRef acc, const Unit& u, int wr, int wc, int fr, int fq) const {
        const int row0 = u.pm * BM + wr * 64 + fr, col0 = u.pn * BM + wc * 32 + 4 * fq;
#pragma unroll
        for (int ai = 0; ai < 2; ++ai)
#pragma unroll
            for (int m = 0; m < 4; ++m) { float* rp = C + (size_t)(row0 + ai * HALF + m * 16) * ldc + col0;
#pragma unroll
                for (int bj = 0; bj < 2; ++bj)
#pragma unroll
                    for (int n = 0; n < 2; ++n) *(f32x4*)(rp + bj * HALF + n * 16) = acc[ai][bj][m][n]; }
    }
};
struct EpiBf16 { static constexpr bool PERM = true; bf16_t* C; int ldc;
    __device__ __forceinline__ void operator()(AccRef acc, const Unit& u, int wr, int wc, int fr, int fq) const {
        const int row0 = u.pm * BM + wr * 64 + fr, col0 = u.pn * BM + wc * 32 + 8 * fq;
#pragma unroll
        for (int ai = 0; ai < 2; ++ai)
#pragma unroll
            for (int m = 0; m < 4; ++m) { bf16_t* rp = C + (size_t)(row0 + ai * HALF + m * 16) * ldc + col0;
#pragma unroll
                for (int bj = 0; bj < 2; ++bj) { const u32x2 lo = pk4(acc[ai][bj][m][0]), hi = pk4(acc[ai][bj][m][1]); *(u32x4*)(rp + bj * HALF) = (u32x4){lo.x, lo.y, hi.x, hi.y}; } }
    }
};
__device__ __forceinline__ void ld_bf8(const bf16_t* p, f32x4& lo, f32x4& hi) { const u32x4 w = *(const u32x4*)p; lo = (f32x4){lo_bf(w.x), hi_bf(w.x), lo_bf(w.y), hi_bf(w.y)}; hi = (f32x4){lo_bf(w.z), hi_bf(w.z), lo_bf(w.w), hi_bf(w.w)}; }
__device__ __forceinline__ void st_bf8(bf16_t* p, f32x4 lo, f32x4 hi) { const u32x2 a = pk4(lo), b = pk4(hi); *(u32x4*)p = (u32x4){a.x, a.y, b.x, b.y}; }
struct EpiGLU { static constexpr bool PERM = true; const bf16_t* Z; bf16_t* MRG;
    __device__ __forceinline__ void operator()(AccRef acc, const Unit& u, int wr, int wc, int fr, int fq) const {
        const int row0 = u.pm * BM + wr * 64 + fr, oc = u.pn * HALF + wc * 32 + 8 * fq;
#pragma unroll
        for (int ai = 0; ai < 2; ++ai)
#pragma unroll
            for (int m = 0; m < 4; ++m) { const int row = row0 + ai * HALF + m * 16;
                f32x4 g0, g1; ld_bf8(Z + (size_t)row * ZW + GT + 4096 + oc, g0, g1);
                st_bf8(MRG + (size_t)row * DM + oc, sig4(g0) * acc[ai][0][m][0] * sig4(acc[ai][1][m][0]), sig4(g1) * acc[ai][0][m][1] * sig4(acc[ai][1][m][1])); }
    }
};
template <bool FINAL> struct EpiAcc { static constexpr bool PERM = true; const bf16_t* Z; bf16_t* MRG; bf16_t* MB; int goff;
    __device__ __forceinline__ void operator()(AccRef acc, const Unit& u, int wr, int wc, int fr, int fq) const {
        const int row0 = u.pm * BM + wr * 64 + fr, col0 = u.pn * BM + wc * 32 + 8 * fq;
#pragma unroll
        for (int ai = 0; ai < 2; ++ai)
#pragma unroll
            for (int m = 0; m < 4; ++m) { const int row = row0 + ai * HALF + m * 16;
#pragma unroll
                for (int bj = 0; bj < 2; ++bj) { const int c = col0 + bj * HALF;
                    f32x4 g0, g1, m0, m1; ld_bf8(Z + (size_t)row * ZW + GT + goff + c, g0, g1); ld_bf8(MRG + (size_t)row * DM + c, m0, m1);
                    st_bf8((FINAL ? MB : MRG) + (size_t)row * DM + c, m0 + sig4(g0) * acc[ai][bj][m][0], m1 + sig4(g1) * acc[ai][bj][m][1]); } }
    }
};
struct EpiKV { static constexpr bool PERM = false; bf16_t* Kb; bf16_t* VT;
    __device__ __forceinline__ void operator()(AccRef acc, const Unit& u, int wr, int wc, int fr, int fq) const {
        const int row0 = u.pm * BM + wr * 64 + fr, col0 = u.pn * BM + wc * 32 + 4 * fq;
#pragma unroll
        for (int ai = 0; ai < 2; ++ai)
#pragma unroll
            for (int m = 0; m < 4; ++m) { const int row = row0 + ai * HALF + m * 16;
#pragma unroll
                for (int bj = 0; bj < 2; ++bj)
#pragma unroll
                    for (int n = 0; n < 2; ++n) { const int c = col0 + bj * HALF + n * 16; const f32x4 v = acc[ai][bj][m][n];
                        if (c < 512) *(u32x2*)(Kb + (size_t)row * 512 + c) = pk4(v);
                        else { const int cc = c - 512, b = row >> 8, key = row & 255;
#pragma unroll
                            for (int i = 0; i < 4; ++i) VT[((size_t)(b * 4 + ((cc + i) >> 7)) * 128 + ((cc + i) & 127)) * 256 + key] = f2bf(v[i]); } } }
    }
};
__device__ __forceinline__ float dpp_ror1(float v) { return __int_as_float(__builtin_amdgcn_update_dpp(0, __float_as_int(v), 0x121, 0xF, 0xF, false)); }
__device__ __forceinline__ float dpp_ror2(float v) { return __int_as_float(__builtin_amdgcn_update_dpp(0, __float_as_int(v), 0x122, 0xF, 0xF, false)); }
struct EpiFFN { static constexpr bool PERM = true; bf16_t* ACT; bf16_t* GB; bf16_t* UB; const float* cw;
    __device__ __forceinline__ void operator()(AccRef acc, const Unit& u, int wr, int wc, int fr, int fq) const {
        const int oc = u.pn * HALF + wc * 32 + 8 * fq;
#pragma unroll
        for (int ai = 0; ai < 2; ++ai) {
            const int rowb = u.pm * BM + ai * HALF + wr * 64;
            u32x2 pk0[4];
#pragma unroll
            for (int n = 0; n < 2; ++n) {
                const f32x4 wa = *(const f32x4*)(cw + (oc + 4 * n) * 3), wb = *(const f32x4*)(cw + (oc + 4 * n) * 3 + 4), wcc = *(const f32x4*)(cw + (oc + 4 * n) * 3 + 8);
                const float w0[4] = {wa[0], wa[3], wb[2], wcc[1]}, w1[4] = {wa[1], wb[0], wb[3], wcc[2]}, w2[4] = {wa[2], wb[1], wcc[0], wcc[3]};
                f32x4 v1 = {0.f, 0.f, 0.f, 0.f}, v2 = {0.f, 0.f, 0.f, 0.f};
#pragma unroll
                for (int m = 0; m < 4; ++m) {
                    f32x4 c1, c2, r;
#pragma unroll
                    for (int c = 0; c < 4; ++c) { c1[c] = dpp_ror1(acc[ai][0][m][n][c]); c2[c] = dpp_ror2(acc[ai][0][m][n][c]); }
#pragma unroll
                    for (int c = 0; c < 4; ++c) {
                        const float g = acc[ai][0][m][n][c], up = acc[ai][1][m][n][c];
                        const float q1 = (m == 0 || fr >= 1) ? c1[c] : v1[c];
                        const float q2 = (m == 0 || fr >= 2) ? c2[c] : v2[c];
                        r[c] = geluf_(w0[c] * q2 + w1[c] * q1 + w2[c] * g) * up;
                    }
                    v1 = c1; v2 = c2;
                    const u32x2 pr = pk4(r);
                    if (n == 0) pk0[m] = pr;
                    else { const int row = rowb + m * 16 + fr; if (m > 0 || fr >= 2) *(u32x4*)(ACT + (size_t)row * FF + oc) = (u32x4){pk0[m].x, pk0[m].y, pr.x, pr.y}; }
                    __builtin_amdgcn_sched_barrier(0);
                }
            }
            if (fr < 2) { st_bf8(GB + (size_t)((rowb >> 6) * 4 + 2 + fr) * FF + oc, acc[ai][0][0][0], acc[ai][0][0][1]); st_bf8(UB + (size_t)((rowb >> 6) * 2 + fr) * FF + oc, acc[ai][1][0][0], acc[ai][1][0][1]); }
            if (fr >= 14) st_bf8(GB + (size_t)((rowb >> 6) * 4 + (fr - 14)) * FF + oc, acc[ai][0][3][0], acc[ai][0][3][1]);
            __builtin_amdgcn_sched_barrier(0);
        }
    }
};

template <class Epi> __device__ __forceinline__ void run_gemm(LAS unsigned char* lds, const bf16_t* A, int lda, const bf16_t* Bt, int M, int N, int K, const Epi& E, const int wid_s, int shift = 0) {
    Gemm g; g.A = A; g.Bt = Bt; g.M = M; g.N = N; g.K = K; g.lda = lda;
    StaticOrder S; S.init(M, N, (int)fresh_gdim(), (int)((fresh_bid() + fresh_gdim() - shift) % fresh_gdim()));
    gemm_phase<Epi>(lds, g, S, E, wid_s);
}

__device__ __forceinline__ int src_col(int kind, int n) {
    if (kind == 0) return n;
    if (kind == 1) {
        if (n < 4096) return n;
        if (n < 6144) return n + 16;
        if (n < 14336) return n + 32;
        if (n < 14352) return n - 14336 + 4096;
        if (n < 14368) return n - 14352 + 6160;
        return -1;
    }
    if (kind == 2) { const int un = n >> 8, r = n & 255; return r < 128 ? un * 128 + r : 2048 + un * 128 + (r - 128); }
    { const int un = n >> 8, r = n & 255; return r < 128 ? un * 128 + r : FF + un * 128 + (r - 128); }
}
__device__ void convert_w(LAS float* ldsf, const float* __restrict__ W, bf16_t* __restrict__ Wt, int K, int Nsrc, int Ndst, int kind, const int wid_s, int nb = 0, int bi = 0) {
    const int t = fresh_tid(wid_s), ntn = Ndst >> 6, ntiles = ntn * (K >> 6);
    const int nn = t & 63, kq = t >> 6, row = t >> 3, seg = (t & 7) * 8;
    const int g = nb > 0 ? nb : fresh_gdim();
    int tile = nb > 0 ? bi : fresh_bid();
    float v[8];
    auto ld = [&](int tl) __attribute__((always_inline)) {
        const int n0 = (tl % ntn) << 6, k0 = (tl / ntn) << 6;
        const int sc = src_col(kind, n0 + nn);
#pragma unroll
        for (int i = 0; i < 8; ++i) v[i] = sc >= 0 ? W[(size_t)(k0 + kq + 8 * i) * Nsrc + sc] : 0.f;
    };
    if (tile < ntiles) ld(tile);
    for (; tile < ntiles; tile += g) {
        const int n0 = (tile % ntn) << 6, k0 = (tile / ntn) << 6;
#pragma unroll
        for (int i = 0; i < 8; ++i) ldsf[nn * 65 + kq + 8 * i] = v[i];
        __syncthreads();
        if (tile + g < ntiles) ld(tile + g);
        float o8[8];
#pragma unroll
        for (int j = 0; j < 8; ++j) o8[j] = ldsf[row * 65 + seg + j];
        u32x4 o; o.x = pk_bf16(o8[0], o8[1]); o.y = pk_bf16(o8[2], o8[3]); o.z = pk_bf16(o8[4], o8[5]); o.w = pk_bf16(o8[6], o8[7]);
        *(u32x4*)(Wt + (size_t)(n0 + row) * K + k0 + seg) = o;
        __syncthreads();
    }
}

__device__ __forceinline__ float wave_sum(float v, int lane) {
#pragma unroll
    for (int o = 32; o >= 1; o >>= 1) v += shx(v, o, lane);
    return v;
}
__device__ void norm_rows_f(const float* xin_f, bf16_t* xout_b, const float* gpre, bf16_t* hout, int nrows, const int wid_s) {
    const int t_ = fresh_tid(wid_s); const int lane = t_ & 63, gw = fresh_bid() * 8 + (t_ >> 6), nw = fresh_gdim() * 8;
    for (int row = gw; row < nrows; row += nw) {
        f32x4 v[8];
        const float* xr = xin_f + (size_t)row * DM;
#pragma unroll
        for (int i = 0; i < 8; ++i) v[i] = *(const f32x4*)(xr + (i * 64 + lane) * 4);
        if (xout_b) {
            bf16_t* xo = xout_b + (size_t)row * DM;
#pragma unroll
            for (int i = 0; i < 8; ++i) *(u32x2*)(xo + (i * 64 + lane) * 4) = pk4(v[i]);
        }
        float ss = 0.f;
#pragma unroll
        for (int i = 0; i < 8; ++i) ss += v[i][0] * v[i][0] + v[i][1] * v[i][1] + v[i][2] * v[i][2] + v[i][3] * v[i][3];
        ss = wave_sum(ss, lane);
        const float inv = rsqrtf(ss * (1.f / DM) + EPS);
        bf16_t* ho = hout + (size_t)row * DM;
#pragma unroll
        for (int i = 0; i < 8; ++i) { const f32x4 gp = *(const f32x4*)(gpre + (i * 64 + lane) * 4); *(u32x2*)(ho + (i * 64 + lane) * 4) = pk4(v[i] * inv * gp); }
    }
}
__device__ __forceinline__ void norm_rows(const bf16_t* xin_b, const bf16_t* y, const float* gpost, float* xout_f, bf16_t* xout_b, const float* gpre, bf16_t* hout, int nrows, const int wid_s) {
    const int t_ = fresh_tid(wid_s); const int lane = t_ & 63, gw = fresh_bid() * 8 + (t_ >> 6), nw = fresh_gdim() * 8;
    u32x4 rx[4], ry[4];
    auto ldrow = [&](int row) __attribute__((always_inline)) {
#pragma unroll
        for (int i = 0; i < 4; ++i) { rx[i] = *(const u32x4*)(xin_b + (size_t)row * DM + (i * 64 + lane) * 8); ry[i] = *(const u32x4*)(y + (size_t)row * DM + (i * 64 + lane) * 8); }
    };
    if (gw < nrows) ldrow(gw);
    for (int row = gw; row < nrows; row += nw) {
        f32x4 v[8], yv[8];
#pragma unroll
        for (int i = 0; i < 4; ++i) {
            v[2 * i] = (f32x4){lo_bf(rx[i].x), hi_bf(rx[i].x), lo_bf(rx[i].y), hi_bf(rx[i].y)}; v[2 * i + 1] = (f32x4){lo_bf(rx[i].z), hi_bf(rx[i].z), lo_bf(rx[i].w), hi_bf(rx[i].w)};
            yv[2 * i] = (f32x4){lo_bf(ry[i].x), hi_bf(ry[i].x), lo_bf(ry[i].y), hi_bf(ry[i].y)}; yv[2 * i + 1] = (f32x4){lo_bf(ry[i].z), hi_bf(ry[i].z), lo_bf(ry[i].w), hi_bf(ry[i].w)};
        }
        if (row + nw < nrows) ldrow(row + nw);
        float ss = 0.f;
#pragma unroll
        for (int i = 0; i < 8; ++i) ss += yv[i][0] * yv[i][0] + yv[i][1] * yv[i][1] + yv[i][2] * yv[i][2] + yv[i][3] * yv[i][3];
        ss = wave_sum(ss, lane);
        const float inv = rsqrtf(ss * (1.f / DM) + EPS);
#pragma unroll
        for (int i = 0; i < 4; ++i) {
            const f32x4 g0 = *(const f32x4*)(gpost + (i * 64 + lane) * 8), g1 = *(const f32x4*)(gpost + (i * 64 + lane) * 8 + 4);
            v[2 * i] += yv[2 * i] * inv * g0; v[2 * i + 1] += yv[2 * i + 1] * inv * g1;
        }
        if (xout_f) {
            float* xo = xout_f + (size_t)row * DM;
#pragma unroll
            for (int i = 0; i < 4; ++i) { *(f32x4*)(xo + (i * 64 + lane) * 8) = v[2 * i]; *(f32x4*)(xo + (i * 64 + lane) * 8 + 4) = v[2 * i + 1]; }
        }
        if (xout_b) {
            bf16_t* xo = xout_b + (size_t)row * DM;
#pragma unroll
            for (int i = 0; i < 4; ++i) st_bf8(xo + (i * 64 + lane) * 8, v[2 * i], v[2 * i + 1]);
        }
        if (hout) {
            float s2 = 0.f;
#pragma unroll
            for (int i = 0; i < 8; ++i) s2 += v[i][0] * v[i][0] + v[i][1] * v[i][1] + v[i][2] * v[i][2] + v[i][3] * v[i][3];
            s2 = wave_sum(s2, lane);
            const float inv2 = rsqrtf(s2 * (1.f / DM) + EPS);
            bf16_t* ho = hout + (size_t)row * DM;
#pragma unroll
            for (int i = 0; i < 4; ++i) {
                const f32x4 g0 = *(const f32x4*)(gpre + (i * 64 + lane) * 8), g1 = *(const f32x4*)(gpre + (i * 64 + lane) * 8 + 4);
                st_bf8(ho + (i * 64 + lane) * 8, v[2 * i] * inv2 * g0, v[2 * i + 1] * inv2 * g1);
            }
        }
    }
}

__device__ void dn_prep(LAS unsigned char* lds, PPtr p, int layer, const int wid_s) {
    const int t = fresh_tid(wid_s), wv = t >> 6, lane = t & 63, fr = lane & 15, fq = lane >> 4;
    LAS bf16_t* QS = (LAS bf16_t*)lds;
    LAS bf16_t* KS = (LAS bf16_t*)(lds + 17408);
    LAS float* KF = (LAS float*)(lds + 34816);
    LAS float* VF = (LAS float*)(lds + 67584);
    LAS float* LS = (LAS float*)(lds + 100352);
    LAS float* GC = (LAS float*)(lds + 117760);
    LAS float* BE = GC + 64;
    LAS float* EG = GC + 128;
    const bf16_t* Z = (const bf16_t*)(p->ws + WS_Z);
    const float* SMp = (const float*)(p->ws + WS_SM);
    bf16_t* DNP = (bf16_t*)(p->ws + WS_DNP);
    float* GLAST = (float*)(p->ws + WS_MISC);
    const float* convw = p->in[5] + (size_t)layer * 3072 * 4;
    for (int item = fresh_bid(); item < 2048; item += fresh_gdim()) {
        const int n = item & 63, h = (item >> 6) & 7, b = item >> 9;
        const size_t row0 = (size_t)b * SEQ + n * 64;
        bf16_t* it = DNP + (size_t)item * 36864;
        {
            const int c8 = (t & 15) * 8;
#pragma unroll 1
            for (int pass = 0; pass < 2; ++pass) {
                const int tok = pass * 32 + (t >> 4);
                u32x4 xz[3][4];
#pragma unroll
                for (int mat = 0; mat < 3; ++mat)
#pragma unroll
                    for (int j = 0; j < 4; ++j) {
                        const int tt = n * 64 + tok - 3 + j;
                        xz[mat][j] = (u32x4){0u, 0u, 0u, 0u};
                        if (tt >= 0) xz[mat][j] = *(const u32x4*)(Z + ((size_t)b * SEQ + tt) * ZW + mat * 1024 + h * 128 + c8);
                    }
#pragma unroll
                for (int mat = 0; mat < 3; ++mat) {
                    const int ch = mat * 1024 + h * 128 + c8;
                    float y[8];
#pragma unroll
                    for (int c = 0; c < 8; ++c) y[c] = 0.f;
                    f32x4 wc[8];
#pragma unroll
                    for (int c = 0; c < 8; ++c) wc[c] = *(const f32x4*)(convw + (size_t)(ch + c) * 4);
#pragma unroll
                    for (int j = 0; j < 4; ++j) {
                        const u32x4 xv = xz[mat][j];
                        y[0] += wc[0][j] * lo_bf(xv.x); y[1] += wc[1][j] * hi_bf(xv.x);
                        y[2] += wc[2][j] * lo_bf(xv.y); y[3] += wc[3][j] * hi_bf(xv.y);
                        y[4] += wc[4][j] * lo_bf(xv.z); y[5] += wc[5][j] * hi_bf(xv.z);
                        y[6] += wc[6][j] * lo_bf(xv.w); y[7] += wc[7][j] * hi_bf(xv.w);
                    }
                    float ss = 0.f;
#pragma unroll
                    for (int c = 0; c < 8; ++c) { y[c] = siluf_(y[c]); ss += y[c] * y[c]; }
                    if (mat < 2) {
                        ss += shx(ss, 1, lane); ss += shx(ss, 2, lane); ss += shx(ss, 4, lane); ss += shx(ss, 8, lane);
                        const float inv = rsqrtf(ss + EPS) * (mat == 0 ? 0.08838834764831845f : 1.f);
#pragma unroll
                        for (int c = 0; c < 8; ++c) y[c] *= inv;
                        u32x4 o; o.x = pk_bf16(y[0], y[1]); o.y = pk_bf16(y[2], y[3]); o.z = pk_bf16(y[4], y[5]); o.w = pk_bf16(y[6], y[7]);
                        if (mat == 0) *(LAS u32x4*)(QS + tok * 136 + c8) = o;
                        else { *(LAS u32x4*)(KS + tok * 136 + c8) = o;
#pragma unroll
                            for (int c = 0; c < 8; ++c) KF[tok * 128 + c8 + c] = y[c]; }
                    } else {
#pragma unroll
                        for (int c = 0; c < 8; ++c) VF[tok * 128 + c8 + c] = y[c];
                    }
                    __builtin_amdgcn_sched_barrier(0);
                }
            }
        }
        if (t < 64) {
            const float db = SMp[(row0 + t) * 32 + h], da = SMp[(row0 + t) * 32 + 8 + h];
            const float be = sigmoidf_(db);
            float g = -expf(p->in[6][layer * 8 + h]) * softplusf_(da + p->in[7][layer * 8 + h]);
#pragma unroll
            for (int o = 1; o < 64; o <<= 1) { const float v = shup(g, o, lane); if (lane >= o) g += v; }
            GC[t] = g; BE[t] = be; EG[t] = expf(g); GC[192 + t] = be * expf(g);
        }
        __syncthreads();
#pragma unroll
        for (int tt = 0; tt < 2; ++tt) {
            const int tile = wv * 2 + tt, mi = tile >> 2, ni = tile & 3;
            f32x4 aK = {0.f, 0.f, 0.f, 0.f}, aQ = {0.f, 0.f, 0.f, 0.f};
#pragma unroll
            for (int ks = 0; ks < 4; ++ks) {
                const bf16x8 bfr = *(const LAS bf16x8*)(KS + (ni * 16 + fr) * 136 + ks * 32 + fq * 8);
                const bf16x8 ak = *(const LAS bf16x8*)(KS + (mi * 16 + fr) * 136 + ks * 32 + fq * 8);
                const bf16x8 aq = *(const LAS bf16x8*)(QS + (mi * 16 + fr) * 136 + ks * 32 + fq * 8);
                aK = mfma16(ak, bfr, aK); aQ = mfma16(aq, bfr, aQ);
            }
            const int j = ni * 16 + fr; const float gj = GC[j];
#pragma unroll
            for (int r = 0; r < 4; ++r) {
                const int i = mi * 16 + fq * 4 + r;
                const float dec = (i >= j) ? expf(GC[i] - gj) : 0.f;
                LS[i * 68 + j] = (i > j) ? BE[i] * aK[r] * dec : 0.f;
                it[32768 + i * 64 + j] = f2bf(aQ[r] * dec);
            }
        }
        __syncthreads();
        if (t < 256) {
            const bool isw = t >= 128; const int cc = t & 127;
            bf16_t* op = it + (isw ? 8192 : 0) + cc;
            LAS const float* src = isw ? KF : VF;
            float x[64];
            int z0; asm volatile("v_mov_b32 %0, 0" : "=v"(z0));
            LAS const float* LSv = LS + z0;
            LAS const float* facp = (isw ? (GC + 192) : BE) + z0;
#pragma unroll
            for (int i = 0; i < 64; ++i) {
                float s = facp[i] * src[i * 128 + cc];
#pragma unroll
                for (int j = 0; j < i; ++j) s -= LSv[i * 68 + j] * x[j];
                x[i] = s;
                op[i * 128] = f2bf(s);
                asm volatile("" ::: "memory");
            }
        } else {
            const int t2 = t - 256;
            { const int i = t2 >> 2, cs = (t2 & 3) * 32; const float e = EG[i];
#pragma unroll
              for (int q = 0; q < 4; ++q) { const u32x4 w = *(const LAS u32x4*)(QS + i * 136 + cs + q * 8);
                  u32x4 o; o.x = pk_bf16(lo_bf(w.x) * e, hi_bf(w.x) * e); o.y = pk_bf16(lo_bf(w.y) * e, hi_bf(w.y) * e); o.z = pk_bf16(lo_bf(w.z) * e, hi_bf(w.z) * e); o.w = pk_bf16(lo_bf(w.w) * e, hi_bf(w.w) * e);
                  *(u32x4*)(it + 16384 + i * 128 + cs + q * 8) = o; } }
            { const int d = t2 >> 1, hf = t2 & 1; const float gl = GC[63];
#pragma unroll
              for (int q = 0; q < 4; ++q) { float v[8];
#pragma unroll
                  for (int e = 0; e < 8; ++e) { const int i = hf * 32 + q * 8 + e; v[e] = KF[i * 128 + d] * expf(gl - GC[i]); }
                  u32x4 o; o.x = pk_bf16(v[0], v[1]); o.y = pk_bf16(v[2], v[3]); o.z = pk_bf16(v[4], v[5]); o.w = pk_bf16(v[6], v[7]);
                  *(u32x4*)(it + 24576 + d * 64 + hf * 32 + q * 8) = o; } }
            if (t2 == 0) GLAST[item] = expf(GC[63]);
        }
        __syncthreads();
    }
}

__device__ void gla_prep(LAS unsigned char* lds, PPtr p, int layer, const int wid_s) {
    const int t = fresh_tid(wid_s), wv = t >> 6, lane = t & 63, fr = lane & 15, fq = lane >> 4;
    LAS bf16_t* QA = (LAS bf16_t*)(lds + 32768);
    LAS bf16_t* KD = (LAS bf16_t*)(lds + 50176);
    LAS float* TOT = (LAS float*)(lds + 67584);
    const bf16_t* Z = (const bf16_t*)(p->ws + WS_Z);
    const float* SMp = (const float*)(p->ws + WS_SM);
    unsigned char* GLP = p->ws + WS_GLP;
    for (int item = fresh_bid(); item < 1024; item += fresh_gdim()) {
        const int n = item & 63, h = (item >> 6) & 3, b = item >> 8;
        const size_t row0 = (size_t)b * SEQ + n * 64;
        bf16_t* it = (bf16_t*)(GLP + (size_t)item * GL_ITEM);
        const int d = t & 127, iq = __builtin_amdgcn_readfirstlane(t >> 7);
        float wup[16];
#pragma unroll
        for (int r = 0; r < 16; ++r) wup[r] = p->in[10][(size_t)layer * 16 * 512 + r * 512 + h * 128 + d];
        const float bup = p->in[11][layer * 512 + h * 128 + d];
        float la[16]; float run = 0.f;
#pragma unroll
        for (int ii = 0; ii < 16; ++ii) {
            const float* gl = SMp + (row0 + iq * 16 + ii) * 32 + 16;
            float dot = bup;
#pragma unroll
            for (int r = 0; r < 16; ++r) dot += gl[r] * wup[r];
            const float ls = fminf(dot, 0.f) - log1pf(__expf(-fabsf(dot)));
            run += ls * (1.f / 16.f); la[ii] = run;
        }
        TOT[iq * 128 + d] = run;
        __syncthreads();
        float off = 0.f, blast = 0.f;
#pragma unroll
        for (int q = 0; q < 4; ++q) { const float v = TOT[q * 128 + d]; blast += v; if (q < iq) off += v; }
        float kdv[16];
#pragma unroll
        for (int ii = 0; ii < 16; ++ii) {
            const int i = iq * 16 + ii; const float bc = la[ii] + off;
            const float q = bf2f(Z[(row0 + i) * ZW + GQ + h * 128 + d]) * 0.08838834764831845f;
            const float k = bf2f(Z[(row0 + i) * ZW + GK + h * 128 + d]);
            it[i * 128 + d] = f2bf(q * __expf(bc));
            QA[i * 136 + d] = f2bf(q * __expf(bc - blast));
            const float kd = k * __expf(blast - bc);
            KD[i * 136 + d] = f2bf(kd); kdv[ii] = kd;
        }
        { u32x4 o0, o1;
          o0.x = pk_bf16(kdv[0], kdv[1]); o0.y = pk_bf16(kdv[2], kdv[3]); o0.z = pk_bf16(kdv[4], kdv[5]); o0.w = pk_bf16(kdv[6], kdv[7]);
          o1.x = pk_bf16(kdv[8], kdv[9]); o1.y = pk_bf16(kdv[10], kdv[11]); o1.z = pk_bf16(kdv[12], kdv[13]); o1.w = pk_bf16(kdv[14], kdv[15]);
          *(u32x4*)(it + 8192 + d * 64 + iq * 16) = o0; *(u32x4*)(it + 8192 + d * 64 + iq * 16 + 8) = o1; }
        if (iq == 0) ((float*)((unsigned char*)it + 73728))[d] = __expf(blast);
        __syncthreads();
#pragma unroll
        for (int tt = 0; tt < 2; ++tt) {
            const int tile = wv * 2 + tt, mi = tile >> 2, ni = tile & 3;
            f32x4 a = {0.f, 0.f, 0.f, 0.f};
#pragma unroll
            for (int ks = 0; ks < 4; ++ks) {
                const bf16x8 bfr = *(const LAS bf16x8*)(KD + (ni * 16 + fr) * 136 + ks * 32 + fq * 8);
                const bf16x8 aq = *(const LAS bf16x8*)(QA + (mi * 16 + fr) * 136 + ks * 32 + fq * 8);
                a = mfma16(aq, bfr, a);
            }
            const int j = ni * 16 + fr;
#pragma unroll
            for (int r = 0; r < 4; ++r) { const int i = mi * 16 + fq * 4 + r; it[16384 + i * 64 + j] = f2bf(i >= j ? a[r] : 0.f); }
        }
        { const int e = t & 255, hf = t >> 8;
#pragma unroll
          for (int q = 0; q < 4; ++q) { bf16_t v[8];
#pragma unroll
              for (int e2 = 0; e2 < 8; ++e2) v[e2] = Z[(row0 + hf * 32 + q * 8 + e2) * ZW + GV + h * 256 + e];
              u32x4 o; o.x = v[0] | ((unsigned)v[1] << 16); o.y = v[2] | ((unsigned)v[3] << 16); o.z = v[4] | ((unsigned)v[5] << 16); o.w = v[6] | ((unsigned)v[7] << 16);
              *(u32x4*)(it + 20480 + e * 64 + hf * 32 + q * 8) = o; } }
        __syncthreads();
    }
}

__device__ void dn_scan(LAS unsigned char* lds, PPtr p, int bh, int es, const int wid_s) {
    const int t = fresh_tid(wid_s), wv = t >> 6, lane = t & 63, fr = lane & 15, fq = lane >> 4;
    const int mt = wv & 3, et = wv >> 2;
    LAS bf16_t* ST = (LAS bf16_t*)lds;
    LAS bf16_t* VT = (LAS bf16_t*)(lds + 8704);
    const bf16_t* DNP = (const bf16_t*)(p->ws + WS_DNP);
    const float* GLAST = (const float*)(p->ws + WS_MISC);
    bf16_t* OA = (bf16_t*)(p->ws + WS_H);
    for (int i = t; i < 32 * 136 / 2; i += 512) ((LAS unsigned*)ST)[i] = 0u;
    f32x4 S0 = {0.f, 0.f, 0.f, 0.f}, S1 = {0.f, 0.f, 0.f, 0.f};
    __syncthreads();
    const int b = bh >> 3, h = bh & 7;
    struct DF { bf16x8 wf[4], qf[4], af[2], kf[2]; float uv[4]; float gl; };
    auto dload = [&](int n) __attribute__((always_inline)) {
        DF f; const bf16_t* it = DNP + (size_t)(bh * 64 + n) * 36864;
#pragma unroll
        for (int ks = 0; ks < 4; ++ks) { f.wf[ks] = *(const bf16x8*)(it + 8192 + (mt * 16 + fr) * 128 + ks * 32 + fq * 8); f.qf[ks] = *(const bf16x8*)(it + 16384 + (mt * 16 + fr) * 128 + ks * 32 + fq * 8); }
#pragma unroll
        for (int ks = 0; ks < 2; ++ks) { f.af[ks] = *(const bf16x8*)(it + 32768 + (mt * 16 + fr) * 64 + ks * 32 + fq * 8); f.kf[ks] = *(const bf16x8*)(it + 24576 + (wv * 16 + fr) * 64 + ks * 32 + fq * 8); }
#pragma unroll
        for (int r = 0; r < 4; ++r) f.uv[r] = bf2f(it[(mt * 16 + fq * 4 + r) * 128 + es * 32 + et * 16 + fr]);
        f.gl = GLAST[bh * 64 + n];
        return f; };
    DF cf = dload(0);
#pragma unroll 1
    for (int n = 0; n < 64; ++n) {
        const DF nf = dload(n < 63 ? n + 1 : 63);
        const bf16x8 (&wf)[4] = cf.wf; const bf16x8 (&qf)[4] = cf.qf; const bf16x8 (&af)[2] = cf.af; const bf16x8 (&kf)[2] = cf.kf; const float (&uv)[4] = cf.uv; const float gl = cf.gl;
        f32x4 P = {0.f, 0.f, 0.f, 0.f}, Q = {0.f, 0.f, 0.f, 0.f};
#pragma unroll
        for (int ks = 0; ks < 4; ++ks) { const bf16x8 bfr = *(const LAS bf16x8*)(ST + (et * 16 + fr) * 136 + ks * 32 + fq * 8); P = mfma16(wf[ks], bfr, P); Q = mfma16(qf[ks], bfr, Q); }
        const f32x4 vn = {uv[0] - P[0], uv[1] - P[1], uv[2] - P[2], uv[3] - P[3]};
        *(LAS u32x2*)(VT + (et * 16 + fr) * 72 + mt * 16 + fq * 4) = pk4(vn);
        __syncthreads();
#pragma unroll
        for (int ks = 0; ks < 2; ++ks) { const bf16x8 bfr = *(const LAS bf16x8*)(VT + (et * 16 + fr) * 72 + ks * 32 + fq * 8); Q = mfma16(af[ks], bfr, Q); }
#pragma unroll
        for (int r = 0; r < 4; ++r) OA[((size_t)b * SEQ + n * 64 + mt * 16 + fq * 4 + r) * 1024 + h * 128 + es * 32 + et * 16 + fr] = f2bf(Q[r]);
        S0 *= gl; S1 *= gl;
#pragma unroll
        for (int ks = 0; ks < 2; ++ks) {
            const bf16x8 b0 = *(const LAS bf16x8*)(VT + fr * 72 + ks * 32 + fq * 8);
            const bf16x8 b1 = *(const LAS bf16x8*)(VT + (16 + fr) * 72 + ks * 32 + fq * 8);
            S0 = mfma16(kf[ks], b0, S0); S1 = mfma16(kf[ks], b1, S1);
        }
        *(LAS u32x2*)(ST + fr * 136 + wv * 16 + fq * 4) = pk4(S0);
        *(LAS u32x2*)(ST + (16 + fr) * 136 + wv * 16 + fq * 4) = pk4(S1);
        __syncthreads();
        cf = nf;
    }
}

__device__ void gla_scan(LAS unsigned char* lds, PPtr p, int bh, int es, const int wid_s) {
    const int t = fresh_tid(wid_s), wv = t >> 6, lane = t & 63, fr = lane & 15, fq = lane >> 4;
    const int mt = wv & 3, eh = wv >> 2;
    LAS bf16_t* STb = (LAS bf16_t*)lds;
    const unsigned char* GLP = p->ws + WS_GLP;
    bf16_t* OB = (bf16_t*)(p->ws + WS_H) + (size_t)MTOK * 1024;
    for (int i = t; i < 64 * 136 / 2; i += 512) ((LAS unsigned*)STb)[i] = 0u;
    f32x4 S[4];
#pragma unroll
    for (int e = 0; e < 4; ++e) S[e] = (f32x4){0.f, 0.f, 0.f, 0.f};
    __syncthreads();
    const int b = bh >> 2, h = bh & 3;
    struct GF { bf16x8 qf[4], af[2], kf[2], vB[4][2]; f32x4 al; };
    auto gload = [&](int n) __attribute__((always_inline)) {
        GF f; const unsigned char* itb = GLP + (size_t)(bh * 64 + n) * GL_ITEM; const bf16_t* it = (const bf16_t*)itb;
#pragma unroll
        for (int ks = 0; ks < 4; ++ks) f.qf[ks] = *(const bf16x8*)(it + (mt * 16 + fr) * 128 + ks * 32 + fq * 8);
#pragma unroll
        for (int ks = 0; ks < 2; ++ks) { f.af[ks] = *(const bf16x8*)(it + 16384 + (mt * 16 + fr) * 64 + ks * 32 + fq * 8); f.kf[ks] = *(const bf16x8*)(it + 8192 + (wv * 16 + fr) * 64 + ks * 32 + fq * 8); }
#pragma unroll
        for (int e = 0; e < 4; ++e)
#pragma unroll
            for (int ks = 0; ks < 2; ++ks) f.vB[e][ks] = *(const bf16x8*)(it + 20480 + (es * 64 + e * 16 + fr) * 64 + ks * 32 + fq * 8);
        f.al = *(const f32x4*)((const float*)(itb + 73728) + wv * 16 + fq * 4);
        return f; };
    GF cf = gload(0);
#pragma unroll 1
    for (int n = 0; n < 64; ++n) {
        const GF nf = gload(n < 63 ? n + 1 : 63);
        LAS bf16_t* cur = STb + (n & 1) * (64 * 136);
        LAS bf16_t* nxt = STb + ((n + 1) & 1) * (64 * 136);
        const bf16x8 (&qf)[4] = cf.qf; const bf16x8 (&af)[2] = cf.af; const bf16x8 (&kf)[2] = cf.kf; const bf16x8 (&vB)[4][2] = cf.vB; const f32x4 al = cf.al;
        bf16x8 vO[2][2];
#pragma unroll
        for (int e2 = 0; e2 < 2; ++e2)
#pragma unroll
            for (int ks = 0; ks < 2; ++ks) vO[e2][ks] = eh ? vB[2 + e2][ks] : vB[e2][ks];
#pragma unroll
        for (int e2 = 0; e2 < 2; ++e2) {
            const int etile = eh * 2 + e2;
            f32x4 O = {0.f, 0.f, 0.f, 0.f};
#pragma unroll
            for (int ks = 0; ks < 4; ++ks) { const bf16x8 bfr = *(const LAS bf16x8*)(cur + (etile * 16 + fr) * 136 + ks * 32 + fq * 8); O = mfma16(qf[ks], bfr, O); }
#pragma unroll
            for (int ks = 0; ks < 2; ++ks) O = mfma16(af[ks], vO[e2][ks], O);
#pragma unroll
            for (int r = 0; r < 4; ++r) OB[((size_t)b * SEQ + n * 64 + mt * 16 + fq * 4 + r) * 1024 + h * 256 + es * 64 + etile * 16 + fr] = f2bf(O[r]);
        }
#pragma unroll
        for (int e = 0; e < 4; ++e) {
            S[e] *= al;
#pragma unroll
            for (int ks = 0; ks < 2; ++ks) S[e] = mfma16(kf[ks], vB[e][ks], S[e]);
            *(LAS u32x2*)(nxt + (e * 16 + fr) * 136 + wv * 16 + fq * 4) = pk4(S[e]);
        }
        __syncthreads();
        cf = nf;
    }
}

__device__ __forceinline__ void s5_scan(LAS unsigned char* ldsw, PPtr p, int layer, int b, int g, const int wid_s) {
    const int lane = fresh_tid(wid_s) & 63, fr = lane & 15, fq = lane >> 4;
    bf16_t* Z = (bf16_t*)(p->ws + WS_Z);
    const float* lam_re = p->in[14] + (size_t)(layer * 64 + g) * 64;
    const float* lam_im = p->in[15] + (size_t)(layer * 64 + g) * 64;
    const float dt = expf(p->in[16][layer * 64 + g]);
    const float* b_re = p->in[17] + (size_t)(layer * 64 + g) * 64 * 16;
    const float* b_im = p->in[18] + (size_t)(layer * 64 + g) * 64 * 16;
    const float* c_re = p->in[19] + (size_t)(layer * 64 + g) * 16 * 64;
    const float* c_im = p->in[20] + (size_t)(layer * 64 + g) * 16 * 64;
    const float dsk = p->in[21][layer * 1024 + g * 16 + fr];
    float ar, ai;
    { const float lr = fminf(lam_re[lane], -1e-4f), li = lam_im[lane]; const float mag = expf(lr * dt); ar = mag * cosf(li * dt); ai = mag * sinf(li * dt); }
    bf16x8 bB[8];
#pragma unroll
    for (int nt = 0; nt < 8; ++nt) {
        const int pp = (nt * 16 + fr) & 63;
        const float lr = fminf(lam_re[pp], -1e-4f), li = lam_im[pp]; const float mag = expf(lr * dt);
        const float a_r = mag * cosf(li * dt), a_i = mag * sinf(li * dt), nr = a_r - 1.f, den = lr * lr + li * li;
        const float zr = (nr * lr + a_i * li) / den, zi = (a_i * lr - nr * li) / den;
        float v[8];
#pragma unroll
        for (int j = 0; j < 8; ++j) {
            float val = 0.f;
            if (fq < 2) { const float br = b_re[pp * 16 + fq * 8 + j], bi = b_im[pp * 16 + fq * 8 + j]; val = (nt >= 4) ? (zr * bi + zi * br) : (zr * br - zi * bi); }
            v[j] = val;
        }
        u32x4 o; o.x = pk_bf16(v[0], v[1]); o.y = pk_bf16(v[2], v[3]); o.z = pk_bf16(v[4], v[5]); o.w = pk_bf16(v[6], v[7]);
        bB[nt] = __builtin_bit_cast(bf16x8, o);
    }
    bf16x8 cB[4];
#pragma unroll
    for (int ks = 0; ks < 4; ++ks) {
        const int kb = ks * 32 + fq * 8;
        float v[8];
#pragma unroll
        for (int j = 0; j < 8; ++j) v[j] = (ks < 2) ? c_re[fr * 64 + kb + j] : -c_im[fr * 64 + kb - 64 + j];
        u32x4 o; o.x = pk_bf16(v[0], v[1]); o.y = pk_bf16(v[2], v[3]); o.z = pk_bf16(v[4], v[5]); o.w = pk_bf16(v[6], v[7]);
        cB[ks] = __builtin_bit_cast(bf16x8, o);
    }
    LAS float* BU = (LAS float*)ldsw;
    LAS bf16_t* X = (LAS bf16_t*)(ldsw + 8192);
    float xr = 0.f, xi = 0.f;
    struct UF { u32x4 ur; bf16_t ue[4]; };
    auto uload = [&](int tile) __attribute__((always_inline)) {
        UF f; const size_t row0 = (size_t)b * SEQ + tile * 16;
        f.ur = (u32x4){0u, 0u, 0u, 0u};
        if (fq < 2) f.ur = *(const u32x4*)(Z + (row0 + fr) * ZW + SU + g * 16 + fq * 8);
#pragma unroll
        for (int r = 0; r < 4; ++r) f.ue[r] = Z[(row0 + fq * 4 + r) * ZW + SU + g * 16 + fr];
        return f; };
    UF u0 = uload(0), u1 = uload(1);
#pragma unroll 1
    for (int tile = 0; tile < 256; ++tile) {
        const size_t row0 = (size_t)b * SEQ + tile * 16;
        const UF u2 = uload(tile < 254 ? tile + 2 : 255);
        const bf16x8 ua = __builtin_bit_cast(bf16x8, u0.ur);
#pragma unroll
        for (int nt = 0; nt < 8; ++nt) {
            f32x4 acc = {0.f, 0.f, 0.f, 0.f};
            acc = mfma16(ua, bB[nt], acc);
#pragma unroll
            for (int r = 0; r < 4; ++r) BU[(fq * 4 + r) * 128 + nt * 16 + fr] = acc[r];
        }
        asm volatile("s_waitcnt lgkmcnt(0)" ::: "memory");
#pragma unroll
        for (int tt = 0; tt < 16; ++tt) {
            const float bur = BU[tt * 128 + lane], bui = BU[tt * 128 + 64 + lane];
            const float nxr = ar * xr - ai * xi + bur, nxi = ar * xi + ai * xr + bui;
            xr = nxr; xi = nxi;
            X[tt * 136 + lane] = f2bf(xr); X[tt * 136 + 64 + lane] = f2bf(xi);
        }
        asm volatile("s_waitcnt lgkmcnt(0)" ::: "memory");
        f32x4 acc = {0.f, 0.f, 0.f, 0.f};
#pragma unroll
        for (int ks = 0; ks < 4; ++ks) { const bf16x8 xa = *(const LAS bf16x8*)(X + fr * 136 + ks * 32 + fq * 8); acc = mfma16(xa, cB[ks], acc); }
#pragma unroll
        for (int r = 0; r < 4; ++r) {
            bf16_t* zp = Z + (row0 + fq * 4 + r) * ZW + ZQ + g * 16 + fr;
            const float u = bf2f(u0.ue[r]);
            *zp = f2bf(geluf_(acc[r] + dsk * u));
        }
        asm volatile("s_waitcnt lgkmcnt(0)" ::: "memory");
        u0 = u1; u1 = u2;
    }
}

template <int W> __device__ void head_norm_gate(bf16_t* O, const bf16_t* Zg  , const float* nw, const int wid_s) {
    constexpr int LPG = W / 8;
    constexpr unsigned HPR = 1024 / W;
    const unsigned total = (unsigned)MTOK * HPR * LPG;
    const int t_ = fresh_tid(wid_s), lane_ = t_ & 63;
    const unsigned gthreads = (unsigned)fresh_gdim() * 512u, gid = (unsigned)fresh_bid() * 512u + (unsigned)t_;
    const int l = (int)(gid % LPG);
    float nwv[8];
#pragma unroll
    for (int c = 0; c < 8; ++c) nwv[c] = nw[l * 8 + c];
    u32x4 w, gz;
    auto ldit = [&](unsigned idx) __attribute__((always_inline)) {
        const unsigned grp = idx / LPG, row = grp / HPR, hh = grp % HPR; const unsigned col = hh * W + l * 8;
        w = *(const u32x4*)(O + (size_t)row * 1024 + col); gz = *(const u32x4*)(Zg + (size_t)row * ZW + col);
    };
    if (gid < total) ldit(gid);
    for (unsigned idx = gid; idx < total; idx += gthreads) {
        const unsigned grp = idx / LPG, row = grp / HPR, hh = grp % HPR; const unsigned col = hh * W + l * 8;
        float v[8] = {lo_bf(w.x), hi_bf(w.x), lo_bf(w.y), hi_bf(w.y), lo_bf(w.z), hi_bf(w.z), lo_bf(w.w), hi_bf(w.w)};
        const float gzv[8] = {lo_bf(gz.x), hi_bf(gz.x), lo_bf(gz.y), hi_bf(gz.y), lo_bf(gz.z), hi_bf(gz.z), lo_bf(gz.w), hi_bf(gz.w)};
        if (idx + gthreads < total) ldit(idx + gthreads);
        float ss = 0.f;
#pragma unroll
        for (int c = 0; c < 8; ++c) ss += v[c] * v[c];
#pragma unroll
        for (int o = 1; o < LPG; o <<= 1) ss += shx(ss, o, lane_);
        const float inv = rsqrtf(ss * (1.f / W) + EPS);
#pragma unroll
        for (int c = 0; c < 8; ++c) v[c] = v[c] * inv * nwv[c] * siluf_(gzv[c]);
        u32x4 o; o.x = pk_bf16(v[0], v[1]); o.y = pk_bf16(v[2], v[3]); o.z = pk_bf16(v[4], v[5]); o.w = pk_bf16(v[6], v[7]);
        *(u32x4*)(O + (size_t)row * 1024 + col) = o;
    }
}

__device__ void xattn(LAS unsigned char* lds, const bf16_t* XQ, const bf16_t* Kb, const bf16_t* VTg, bf16_t* XO, const int wid_s) {
    const int t = fresh_tid(wid_s), wv = t >> 6, lane = t & 63, fr = lane & 15, fq = lane >> 4;
    LAS bf16_t* Pw = (LAS bf16_t*)(lds + wv * 8448);
    for (int item = fresh_bid(); item < 512; item += fresh_gdim()) {
        const int qt = item & 31, hd = (item >> 5) & 3, b = item >> 7;
        const size_t r0 = (size_t)b * SEQ + qt * 128 + wv * 16;
        bf16x8 qf[4];
#pragma unroll
        for (int ks = 0; ks < 4; ++ks) qf[ks] = *(const bf16x8*)(XQ + (r0 + fr) * 512 + hd * 128 + ks * 32 + fq * 8);
        f32x4 s[16];
#pragma unroll
        for (int nt = 0; nt < 16; ++nt) {
            f32x4 a = {0.f, 0.f, 0.f, 0.f};
#pragma unroll
            for (int ks = 0; ks < 4; ++ks) { const bf16x8 kfr = *(const bf16x8*)(Kb + ((size_t)b * 256 + nt * 16 + fr) * 512 + hd * 128 + ks * 32 + fq * 8); a = mfma16(qf[ks], kfr, a); }
            s[nt] = a * 0.08838834764831845f;
        }
        float mx[4], sm[4];
#pragma unroll
        for (int r = 0; r < 4; ++r) {
            float m = s[0][r];
#pragma unroll
            for (int nt = 1; nt < 16; ++nt) m = fmaxf(m, s[nt][r]);
            m = fmaxf(m, shx(m, 1, lane)); m = fmaxf(m, shx(m, 2, lane)); m = fmaxf(m, shx(m, 4, lane)); m = fmaxf(m, shx(m, 8, lane));
            mx[r] = m;
            float su = 0.f;
#pragma unroll
            for (int nt = 0; nt < 16; ++nt) { const float e = __expf(s[nt][r] - m); s[nt][r] = e; su += e; }
            su += shx(su, 1, lane); su += shx(su, 2, lane); su += shx(su, 4, lane); su += shx(su, 8, lane);
            sm[r] = 1.f / su;
        }
#pragma unroll
        for (int nt = 0; nt < 16; ++nt)
#pragma unroll
            for (int r = 0; r < 4; ++r) Pw[(fq * 4 + r) * 264 + nt * 16 + fr] = f2bf(s[nt][r] * sm[r]);
        __syncthreads();
        bf16x8 pf[8];
#pragma unroll
        for (int ks = 0; ks < 8; ++ks) pf[ks] = *(const LAS bf16x8*)(Pw + fr * 264 + ks * 32 + fq * 8);
#pragma unroll
        for (int dtile = 0; dtile < 8; ++dtile) {
            f32x4 o = {0.f, 0.f, 0.f, 0.f};
#pragma unroll
            for (int ks = 0; ks < 8; ++ks) { const bf16x8 vfr = *(const bf16x8*)(VTg + ((size_t)(b * 4 + hd) * 128 + dtile * 16 + fr) * 256 + ks * 32 + fq * 8); o = mfma16(pf[ks], vfr, o); }
#pragma unroll
            for (int r = 0; r < 4; ++r) XO[(r0 + fq * 4 + r) * 512 + hd * 128 + dtile * 16 + fr] = f2bf(o[r]);
        }
        __syncthreads();
    }
}

__device__ void ffn_act(const bf16_t* G, const bf16_t* U, const float* cw, bf16_t* ACT, const int wid_s) {
    const unsigned nitems = (unsigned)(FF / 8) * (MTOK / 16);
    const unsigned gthreads = (unsigned)fresh_gdim() * 512u, gid = (unsigned)fresh_bid() * 512u + (unsigned)fresh_tid(wid_s);
    for (unsigned idx = gid; idx < nitems; idx += gthreads) {
        const unsigned cg = idx % (FF / 8), tb = idx / (FF / 8);
        const unsigned c0 = cg * 8, t0 = tb * 16;
        float w0[8], w1[8], w2[8];
#pragma unroll
        for (int c = 0; c < 8; ++c) { w0[c] = cw[(c0 + c) * 3]; w1[c] = cw[(c0 + c) * 3 + 1]; w2[c] = cw[(c0 + c) * 3 + 2]; }
        float g2[8], g1[8];
        const bool start = (t0 & (SEQ - 1)) == 0;
        const unsigned base = t0 * FF + c0;
        { u32x4 a = {0u, 0u, 0u, 0u}, bq = {0u, 0u, 0u, 0u};
          if (!start) { a = *(const u32x4*)(G + (base - 2 * FF)); bq = *(const u32x4*)(G + (base - FF)); }
          g2[0] = lo_bf(a.x); g2[1] = hi_bf(a.x); g2[2] = lo_bf(a.y); g2[3] = hi_bf(a.y); g2[4] = lo_bf(a.z); g2[5] = hi_bf(a.z); g2[6] = lo_bf(a.w); g2[7] = hi_bf(a.w);
          g1[0] = lo_bf(bq.x); g1[1] = hi_bf(bq.x); g1[2] = lo_bf(bq.y); g1[3] = hi_bf(bq.y); g1[4] = lo_bf(bq.z); g1[5] = hi_bf(bq.z); g1[6] = lo_bf(bq.w); g1[7] = hi_bf(bq.w); }
#pragma unroll 4
        for (unsigned tt = 0; tt < 16; ++tt) {
            const unsigned off = base + tt * FF;
            const u32x4 a = *(const u32x4*)(G + off);
            const u32x4 uq = *(const u32x4*)(U + off);
            const float g0[8] = {lo_bf(a.x), hi_bf(a.x), lo_bf(a.y), hi_bf(a.y), lo_bf(a.z), hi_bf(a.z), lo_bf(a.w), hi_bf(a.w)};
            const float uu[8] = {lo_bf(uq.x), hi_bf(uq.x), lo_bf(uq.y), hi_bf(uq.y), lo_bf(uq.z), hi_bf(uq.z), lo_bf(uq.w), hi_bf(uq.w)};
            float r[8];
#pragma unroll
            for (int c = 0; c < 8; ++c) { const float y = w0[c] * g2[c] + w1[c] * g1[c] + w2[c] * g0[c]; r[c] = geluf_(y) * uu[c]; g2[c] = g1[c]; g1[c] = g0[c]; }
            u32x4 o; o.x = pk_bf16(r[0], r[1]); o.y = pk_bf16(r[2], r[3]); o.z = pk_bf16(r[4], r[5]); o.w = pk_bf16(r[6], r[7]);
            *(u32x4*)(ACT + off) = o;
        }
    }
}

__device__ void ffn_fix(const bf16_t* GB, const bf16_t* UB, const float* cw, bf16_t* ACT, const int wid_s) {
    const unsigned nitems = 256u * 2u * (FF / 8);
    const unsigned gthreads = (unsigned)fresh_gdim() * 512u, gid = (unsigned)fresh_bid() * 512u + (unsigned)fresh_tid(wid_s);
    for (unsigned idx = gid; idx < nitems; idx += gthreads) {
        const unsigned cg = idx % (FF / 8), rest = idx / (FF / 8), rr = rest & 1u, rb = rest >> 1;
        const unsigned c0 = cg * 8;
        const bool first = (rb & 63u) == 0u;
        const u32x4 zero = {0u, 0u, 0u, 0u};
        const u32x4 a0 = *(const u32x4*)(GB + (size_t)(rb * 4 + 2 + rr) * FF + c0);
        u32x4 a1, a2;
        if (rr == 0) { a1 = first ? zero : *(const u32x4*)(GB + (size_t)((rb - 1) * 4 + 1) * FF + c0); a2 = first ? zero : *(const u32x4*)(GB + (size_t)((rb - 1) * 4 + 0) * FF + c0); }
        else         { a1 = *(const u32x4*)(GB + (size_t)(rb * 4 + 2) * FF + c0);                     a2 = first ? zero : *(const u32x4*)(GB + (size_t)((rb - 1) * 4 + 1) * FF + c0); }
        const u32x4 uq = *(const u32x4*)(UB + (size_t)(rb * 2 + rr) * FF + c0);
        const float g0[8] = {lo_bf(a0.x), hi_bf(a0.x), lo_bf(a0.y), hi_bf(a0.y), lo_bf(a0.z), hi_bf(a0.z), lo_bf(a0.w), hi_bf(a0.w)};
        const float g1[8] = {lo_bf(a1.x), hi_bf(a1.x), lo_bf(a1.y), hi_bf(a1.y), lo_bf(a1.z), hi_bf(a1.z), lo_bf(a1.w), hi_bf(a1.w)};
        const float g2[8] = {lo_bf(a2.x), hi_bf(a2.x), lo_bf(a2.y), hi_bf(a2.y), lo_bf(a2.z), hi_bf(a2.z), lo_bf(a2.w), hi_bf(a2.w)};
        const float uu[8] = {lo_bf(uq.x), hi_bf(uq.x), lo_bf(uq.y), hi_bf(uq.y), lo_bf(uq.z), hi_bf(uq.z), lo_bf(uq.w), hi_bf(uq.w)};
        float r[8];
#pragma unroll
        for (int c = 0; c < 8; ++c) { const float y = cw[(c0 + c) * 3] * g2[c] + cw[(c0 + c) * 3 + 1] * g1[c] + cw[(c0 + c) * 3 + 2] * g0[c]; r[c] = geluf_(y) * uu[c]; }
        u32x4 o; o.x = pk_bf16(r[0], r[1]); o.y = pk_bf16(r[2], r[3]); o.z = pk_bf16(r[4], r[5]); o.w = pk_bf16(r[6], r[7]);
        *(u32x4*)(ACT + (size_t)(rb * 64 + rr) * FF + c0) = o;
    }
}

__device__ void convert_layer_small(LAS float* ldsf, PPtr p, int l, const int wid_s) {
    unsigned char* ws = p->ws;
    convert_w(ldsf, p->in[4] + (size_t)l * 2048 * 14368, (bf16_t*)(ws + WS_WA), 2048, 14368, ZN, 1, wid_s);
    convert_w(ldsf, p->in[9] + (size_t)l * 1024 * 2048, (bf16_t*)(ws + WS_WDN), 1024, 2048, 2048, 0, wid_s);
    convert_w(ldsf, p->in[13] + (size_t)l * 1024 * 2048, (bf16_t*)(ws + WS_WGLA), 1024, 2048, 2048, 0, wid_s);
    convert_w(ldsf, p->in[22] + (size_t)l * 1024 * 4096, (bf16_t*)(ws + WS_WGLU), 1024, 4096, 4096, 2, wid_s);
    convert_w(ldsf, p->in[23] + (size_t)l * 2048 * 2048, (bf16_t*)(ws + WS_WMIX), 2048, 2048, 2048, 0, wid_s);
    convert_w(ldsf, p->in[27] + (size_t)l * 2048 * 512, (bf16_t*)(ws + WS_WXQ), 2048, 512, 512, 0, wid_s);
    convert_w(ldsf, p->in[28] + (size_t)l * 2048 * 1024, (bf16_t*)(ws + WS_WXKV), 2048, 1024, 1024, 0, wid_s);
    convert_w(ldsf, p->in[29] + (size_t)l * 512 * 2048, (bf16_t*)(ws + WS_WXO), 512, 2048, 2048, 0, wid_s);
}
__device__ void convert_layer_ffn(LAS float* ldsf, PPtr p, int l, const int wid_s, int nb, int bi) {
    unsigned char* ws = p->ws;
    convert_w(ldsf, p->in[32] + (size_t)l * 2048 * 11264, (bf16_t*)(ws + WS_WA), 2048, 11264, 11264, 3, wid_s, nb, bi);
    convert_w(ldsf, p->in[34] + (size_t)l * 5632 * 2048, (bf16_t*)(ws + WS_WA + 46137344), 5632, 2048, 2048, 0, wid_s, nb, bi);
}


#ifdef DEBUG_NAN
__device__ __noinline__ void chk_f32(const float* q, size_t n, unsigned bit, unsigned* flag) {
    const size_t gthreads = (size_t)gridDim.x * 512, gid = (size_t)blockIdx.x * 512 + threadIdx.x; bool bad = false;
    for (size_t i = gid; i < n; i += gthreads) { const float v = q[i]; if (!(fabsf(v) < 1e30f)) bad = true; }
    if (bad) atomicOr(flag, 1u << bit);
}
__device__ __noinline__ void chk_bf16(const bf16_t* q, size_t n, unsigned bit, unsigned* flag) {
    const size_t gthreads = (size_t)gridDim.x * 512, gid = (size_t)blockIdx.x * 512 + threadIdx.x; bool bad = false;
    for (size_t i = gid; i < n; i += gthreads) { const float v = bf2f(q[i]); if (!(fabsf(v) < 1e30f)) bad = true; }
    if (bad) atomicOr(flag, 1u << bit);
}
#define CHKF(ptr, n, bit) do { if (l == DEBUG_NAN - 1) { chk_f32(ptr, n, bit, (unsigned*)(PP()->ws + WS_MISC + 32768)); } gsync(grid); } while (0)
#define CHKB(ptr, n, bit) do { if (l == DEBUG_NAN - 1) { chk_bf16(ptr, n, bit, (unsigned*)(PP()->ws + WS_MISC + 32768)); } xbar(wid_s); } while (0)
#else
#define CHKF(ptr, n, bit) do {} while (0)
#define CHKB(ptr, n, bit) do {} while (0)
#endif
#ifdef DEBUG_TS
__device__ __forceinline__ bool ts_in(const int* sel, int n, int k) { for (int q = 0; q < n; ++q) if (sel[q] == k) return true; return false; }
#define TS(k) do { const unsigned long long t_ = __builtin_amdgcn_s_memrealtime(); const int selA_[] = DEBUG_TS_A; const int selB_[] = DEBUG_TS_B; \
    const int kk_ = (k) % 20; \
    if (ts_in(selA_, (int)(sizeof(selA_) / sizeof(int)), kk_)) tsA += t_ - tsL; if (ts_in(selB_, (int)(sizeof(selB_) / sizeof(int)), kk_)) tsB += t_ - tsL; tsL = t_; } while (0)
#else
#define TS(k) do {} while (0)
#endif
#ifndef PMASK
#define PMASK 0xFFFFFFFFu
#endif
#define ON(k) ((PMASK >> (k)) & 1u)
constexpr size_t WS_LIMIT = 941621248;
static_assert(WS_END <= WS_LIMIT, "workspace map exceeds the guaranteed workspace size");
static_assert(WS_DNP + (size_t)MTOK * FF * 2 <= WS_MISC, "ACT does not fit");
static_assert((size_t)MTOK * FF * 2 * 2 <= SZ_Z, "G,U do not fit in Z");

#define m_ws (PP()->ws)
#define m_Z ((bf16_t*)(m_ws + WS_Z))
#define m_Y ((bf16_t*)(m_ws + WS_Z))
#define m_SMp ((float*)(m_ws + WS_SM))
#define m_H ((bf16_t*)(m_ws + WS_H))
#define m_OA m_H
#define m_OB (m_H + (size_t)MTOK * 1024)
#define m_MRG ((bf16_t*)(m_ws + WS_DNP))
#define m_XQ ((bf16_t*)(m_ws + WS_DNP))
#define m_XO ((bf16_t*)(m_ws + WS_DNP + (size_t)MTOK * 512 * 2))
#define m_ACT ((bf16_t*)(m_ws + WS_DNP))
#define m_MB ((bf16_t*)(m_ws + WS_GLP))
#define m_MEMN ((bf16_t*)(m_ws + WS_GLP))
#define m_KB ((bf16_t*)(m_ws + WS_GLP + 4194304))
#define m_VTG ((bf16_t*)(m_ws + WS_GLP + 5242880))
#define m_G ((bf16_t*)(m_ws + WS_Z))
#define m_U ((bf16_t*)(m_ws + WS_Z + 16777216))
#define m_xs ((bf16_t*)(m_ws + WS_XS))
#define m_out (PP()->out)
#define p PP()
__global__ void __launch_bounds__(512, 2) fwd_megakernel(Params p_unused) {
    extern __shared__ __attribute__((aligned(16))) unsigned char lds_raw[];
    LAS unsigned char* lds = (LAS unsigned char*)lds_raw;
    LAS float* ldsf = (LAS float*)lds_raw;
    cg::grid_group grid = cg::this_grid();
    if ((threadIdx.x & 63) == 0) ((LAS int*)(lds + 131072))[__builtin_amdgcn_s_getreg(10244) & 63] = (int)(threadIdx.x >> 6);
    { unsigned* bar0 = (unsigned*)(PP()->ws + WS_BAR);
      if (threadIdx.x == 0) { volatile LAS unsigned* st = (volatile LAS unsigned*)(lds + XB_LDS_OFF); st[0] = 0u; st[1] = 0u;
          (void)xb_add(&bar0[XB_XCNT(xb_xcc_id())], 1u); } }
    __syncthreads();
    constexpr int wid_s = 0;
#ifdef DEBUG_TS
    unsigned long long tsA = 0ull, tsB = 0ull, tsL = __builtin_amdgcn_s_memrealtime();
#endif
    if (ON(0)) convert_layer_small(ldsf, p, 0, wid_s);
    if (ON(1)) norm_rows_f(p->in[0], m_xs, p->in[2], m_H, MTOK, wid_s);
    if (PP()->ws == nullptr) grid.sync();
    xbar(wid_s); TS(0);

#pragma unroll 1
    for (int l = 0; l < 2; ++l) {
        if (ON(2)) { EpiZ e; e.Z = m_Z; e.SMp = m_SMp; run_gemm(lds, m_H, DM, (const bf16_t*)(m_ws + WS_WA), MTOK, ZN, DM, e, wid_s); }
#ifdef REPEAT_PH1
        { EpiZ e; e.Z = m_Z; e.SMp = m_SMp; run_gemm(lds, m_H, DM, (const bf16_t*)(m_ws + WS_WA), MTOK, ZN, DM, e, wid_s); }
#endif
        xbar(wid_s); TS(l * 20 + 1);

#ifdef DEBUG_Z
        {
            unsigned long long* cw = (unsigned long long*)(PP()->ws + WS_MISC + 32768);
            const size_t gthreads = (size_t)gridDim.x * 512, gid = (size_t)blockIdx.x * 512 + threadIdx.x;
            const bf16_t* zz = m_Z; const bf16_t* wa = (const bf16_t*)(m_ws + WS_WA);
            unsigned long long c = 0, mi = ~0ull, cwa = 0;
            for (size_t i = gid; i < (size_t)MTOK * ZW; i += gthreads) { const float v = bf2f(zz[i]); if (!(fabsf(v) < 1e30f)) { ++c; if (i < mi) mi = i; } }
            for (size_t i = gid; i < (size_t)ZN * 2048; i += gthreads) { const float v = bf2f(wa[i]); if (!(fabsf(v) < 1e30f)) ++cwa; }
            if (c) { atomicAdd(cw, c); atomicMin(cw + 1, mi); }
            if (cwa) atomicAdd(cw + 2, cwa);
            xbar(wid_s);
            const unsigned long long C = cw[0], MI = cw[1], WB = cw[2];
            const int pnf = (int)((MI % ZW) / 256), pmf = (int)((MI / ZW) / 256);
            const int wb = WB == 0 ? 0 : (WB < 1000 ? 1 : 2), zb = C < 10000 ? 0 : (C < 10000000 ? 1 : 2);
            const float e1 = exp10f(10.f + (float)(pmf / 4));
            const float v1 = (10.f + pnf) * e1, v2 = (10.f + 10.f * (3 * wb + zb)) * e1 * 0.01f;
            float* o = PP()->out;
            for (size_t i = gid; i < (size_t)MTOK * DM; i += gthreads) o[i] = (i == 0) ? v1 : v2;
            return;
        }
#endif

        CHKB(m_H, (size_t)MTOK * DM, 0); CHKB(m_Z, (size_t)MTOK * ZW, 1); CHKF(m_SMp, (size_t)MTOK * 32, 2);
        if (ON(3)) dn_prep(lds, p, l, wid_s);
        if (ON(4)) gla_prep(lds, p, l, wid_s);
        xbar(wid_s); TS(l * 20 + 2);
        CHKB((const bf16_t*)(m_ws + WS_DNP), (size_t)DN_ITEM * 1024, 3); CHKB((const bf16_t*)(m_ws + WS_GLP), (size_t)GL_ITEM * 512, 4);
        for (int role = blockIdx.x; role < 256; role += gridDim.x) {
            if (role < 128) { if (ON(5)) dn_scan(lds, p, role >> 2, role & 3, wid_s); }
            else if (role < 192) { if (ON(6)) gla_scan(lds, p, (role - 128) >> 2, (role - 128) & 3, wid_s); }
            else { const int wv = fresh_tid(wid_s) >> 6; if (ON(7) && wv < 4) { const int pair = (role - 192) * 4 + wv; s5_scan(lds + wv * 12544, p, l, pair >> 6, pair & 63, wid_s); } }
            __syncthreads();
        }
        { const int bid_ = fresh_bid(), gd_ = fresh_gdim(), nbc = gd_ >= 256 ? 192 : gd_; if (ON(0) && bid_ < nbc) convert_layer_ffn(ldsf, p, l, wid_s, nbc, bid_); }
        xbar(wid_s); TS(l * 20 + 3);
#ifdef REPEAT_PH3
        for (int role = blockIdx.x; role < 256; role += gridDim.x) {
            if (role < 128) { if (ON(5)) dn_scan(lds, p, role >> 2, role & 3, wid_s); }
            else if (role < 192) { if (ON(6)) gla_scan(lds, p, (role - 128) >> 2, (role - 128) & 3, wid_s); }
            else { const int wv = fresh_tid(wid_s) >> 6; if (ON(7) && wv < 4) { const int pair = (role - 192) * 4 + wv; s5_scan(lds + wv * 12544, p, l, pair >> 6, pair & 63, wid_s); } }
            __syncthreads();
        }
        xbar(wid_s);
#endif
        CHKB(m_OA, (size_t)MTOK * 1024, 5); CHKB(m_OB, (size_t)MTOK * 1024, 6); CHKB(m_Z, (size_t)MTOK * ZW, 7);
        if (ON(8)) head_norm_gate<128>(m_OA, m_Z + ZZ, p->in[8] + l * 128, wid_s);
        if (ON(8)) head_norm_gate<256>(m_OB, m_Z + GR, p->in[12] + l * 256, wid_s);
        if (ON(9)) { EpiGLU e; e.Z = m_Z; e.MRG = m_MRG; run_gemm(lds, m_Z + ZQ, ZW, (const bf16_t*)(m_ws + WS_WGLU), MTOK, 4096, 1024, e, wid_s); }
        xbar(wid_s); TS(l * 20 + 4);
        CHKB(m_OA, (size_t)MTOK * 2048, 8); CHKB(m_MRG, (size_t)MTOK * DM, 9);
        if (ON(10)) { EpiAcc<false> e; e.Z = m_Z; e.MRG = m_MRG; e.MB = nullptr; e.goff = 0; run_gemm(lds, m_OA, 1024, (const bf16_t*)(m_ws + WS_WDN), MTOK, DM, 1024, e, wid_s); }
        if (ON(10)) { EpiAcc<true> e; e.Z = m_Z; e.MRG = m_MRG; e.MB = m_MB; e.goff = 2048; run_gemm(lds, m_OB, 1024, (const bf16_t*)(m_ws + WS_WGLA), MTOK, DM, 1024, e, wid_s); }
        xbar(wid_s); TS(l * 20 + 5);
        CHKB(m_MB, (size_t)MTOK * DM, 10);
        if (ON(11)) { EpiBf16 e; e.C = m_Y; e.ldc = DM; run_gemm(lds, m_MB, DM, (const bf16_t*)(m_ws + WS_WMIX), MTOK, DM, DM, e, wid_s); }
        xbar(wid_s); TS(l * 20 + 6);
        CHKF(m_Y, (size_t)MTOK * DM, 11);
        if (ON(1)) norm_rows(m_xs, m_Y, p->in[3] + l * DM, nullptr, m_xs, p->in[24] + l * DM, m_H, MTOK, wid_s);
        if (ON(1)) norm_rows_f(p->in[1], nullptr, p->in[26] + l * DM, m_MEMN, 1024, wid_s);
        xbar(wid_s); TS(l * 20 + 7);
        CHKB(m_xs, (size_t)MTOK * DM, 12); CHKB(m_H, (size_t)MTOK * DM, 13);
        if (ON(12)) { EpiBf16 e; e.C = m_XQ; e.ldc = 512; run_gemm(lds, m_H, DM, (const bf16_t*)(m_ws + WS_WXQ), MTOK, 512, DM, e, wid_s); }
        if (ON(13)) { EpiKV e; e.Kb = m_KB; e.VT = m_VTG; run_gemm(lds, m_MEMN, DM, (const bf16_t*)(m_ws + WS_WXKV), 1024, 1024, DM, e, wid_s, 128); }
        xbar(wid_s); TS(l * 20 + 8);
        CHKB(m_XQ, (size_t)MTOK * 512, 14); CHKB(m_KB, (size_t)1024 * 1024, 15);
        if (ON(14)) xattn(lds, m_XQ, m_KB, m_VTG, m_XO, wid_s);
        xbar(wid_s); TS(l * 20 + 9);
        CHKB(m_XO, (size_t)MTOK * 512, 16);
        if (ON(11)) { EpiBf16 e; e.C = m_Y; e.ldc = DM; run_gemm(lds, m_XO, 512, (const bf16_t*)(m_ws + WS_WXO), MTOK, DM, 512, e, wid_s); }
        xbar(wid_s); TS(l * 20 + 10);
        CHKF(m_Y, (size_t)MTOK * DM, 17);
        if (ON(1)) norm_rows(m_xs, m_Y, p->in[25] + l * DM, nullptr, m_xs, p->in[30] + l * DM, m_H, MTOK, wid_s);
        xbar(wid_s); TS(l * 20 + 11);
        CHKB(m_xs, (size_t)MTOK * DM, 18);
        if (ON(15)) { EpiFFN e; e.ACT = m_ACT; e.GB = m_G; e.UB = m_U; e.cw = p->in[33] + (size_t)l * FF * 3; run_gemm(lds, m_H, DM, (const bf16_t*)(m_ws + WS_WA), MTOK, 2 * FF, DM, e, wid_s); }
        xbar(wid_s); TS(l * 20 + 12);
        CHKB(m_G, (size_t)MTOK * FF * 2, 19);
        if (ON(16)) ffn_fix(m_G, m_U, p->in[33] + (size_t)l * FF * 3, m_ACT, wid_s);
        xbar(wid_s); TS(l * 20 + 13);
        CHKB(m_ACT, (size_t)MTOK * FF, 20);
        if (ON(11)) { EpiBf16 e; e.C = m_Y; e.ldc = DM; run_gemm(lds, m_ACT, FF, (const bf16_t*)(m_ws + WS_WA + 46137344), MTOK, DM, FF, e, wid_s); }
        xbar(wid_s); TS(l * 20 + 14);
        CHKF(m_Y, (size_t)MTOK * DM, 21);
        if (l == 0) {
            if (ON(1)) norm_rows(m_xs, m_Y, p->in[31] + l * DM, nullptr, m_xs, p->in[2] + DM, m_H, MTOK, wid_s);
            if (ON(0)) convert_layer_small(ldsf, p, 1, wid_s);
        } else {
            if (ON(1)) norm_rows(m_xs, m_Y, p->in[31] + l * DM, m_out, nullptr, nullptr, nullptr, MTOK, wid_s);
        }
        xbar(wid_s); TS(l * 20 + 15);
        }
#ifdef DEBUG_TS
    {   const float A = (float)tsA * 0.01f, B = (float)tsB * 0.01f;
        xbar(wid_s);
        const unsigned gthreads = (unsigned)fresh_gdim() * 512u, gid = (unsigned)fresh_bid() * 512u + (unsigned)fresh_tid(wid_s);
        float* o = PP()->out;
        for (unsigned i = gid; i < (unsigned)MTOK * DM; i += gthreads) o[i] = (i == 0u) ? B * 10000.f : A;
    }
#endif
#ifdef DEBUG_NAN
    { const unsigned f = *(volatile unsigned*)(PP()->ws + WS_MISC + 32768); int idx = -1; for (int k = 0; k < 32; ++k) if ((f >> k) & 1u) { idx = k; break; }
      bool finalbad = false; const size_t gthreads = (size_t)gridDim.x * 512, gid = (size_t)blockIdx.x * 512 + threadIdx.x;
      const float val = idx < 0 ? 16.f : exp2f(5.f + idx);
      float* o = PP()->out;
      for (size_t i = gid; i < (size_t)MTOK * DM; i += gthreads) { if (idx >= 0) o[i] = val; else { const float v = o[i]; if (!(fabsf(v) < 1e30f)) o[i] = 16.f; } } }
#endif
}

#undef m_ws
#undef m_Z
#undef m_Y
#undef m_SMp
#undef m_H
#undef m_OA
#undef m_OB
#undef m_MRG
#undef m_XQ
#undef m_XO
#undef m_ACT
#undef m_MB
#undef m_MEMN
#undef m_KB
#undef m_VTG
#undef m_G
#undef m_U
#undef m_xs
#undef m_out
#undef p
extern "C" void kernel_launch(void* const* d_in, const int* in_sizes, int n_in,
                              void* d_out, int out_size, void* d_ws, size_t ws_size,
                              hipStream_t stream) {
    static int grid_blocks = 0;
    constexpr int kDynLds = 131072 + 512;
    if (!grid_blocks) {
        int dev = 0, cus = 0, per_cu = 0;
        (void)hipGetDevice(&dev);
        (void)hipDeviceGetAttribute(&cus, hipDeviceAttributeMultiprocessorCount, dev);
        if (hipFuncSetAttribute((const void*)fwd_megakernel, hipFuncAttributeMaxDynamicSharedMemorySize, kDynLds) != hipSuccess) fprintf(stderr, "hipFuncSetAttribute failed\n");
        if (hipOccupancyMaxActiveBlocksPerMultiprocessor(&per_cu, (const void*)fwd_megakernel, 512, kDynLds) != hipSuccess || per_cu < 1) { fprintf(stderr, "occupancy query: %d\n", per_cu); per_cu = 1; }
        (void)hipGetLastError();
        grid_blocks = cus;
        if (n_in != 35 || ws_size < WS_END) fprintf(stderr, "kernel_launch: unexpected n_in %d or ws_size %zu (< %zu)\n", n_in, ws_size, (size_t)WS_END);
    }
    Params hp{};
    for (int i = 0; i < 35; ++i) hp.in[i] = (const float*)d_in[i];
    hp.out = (float*)d_out; hp.ws = (unsigned char*)d_ws;
    (void)hipMemsetAsync((unsigned char*)d_ws + WS_BAR, 0, XCD_BAR_WORDS * 4, stream);
    void* args[] = {&hp};
    hipError_t e = hipLaunchCooperativeKernel((const void*)fwd_megakernel, dim3(grid_blocks), dim3(512), args, kDynLds, stream);
    if (e != hipSuccess) fprintf(stderr, "cooperative launch failed: %s (grid %d)\n", hipGetErrorString(e), grid_blocks);
}
```

```cpp
#include <hip/hip_runtime.h>
#include <hip/hip_cooperative_groups.h>
#include <cstdio>
#include <type_traits>
namespace cg = cooperative_groups;

#define LAS __attribute__((address_space(3)))
typedef unsigned short bf16_t;
typedef short bf16x8 __attribute__((ext_vector_type(8)));
typedef float f32x4 __attribute__((ext_vector_type(4)));
typedef unsigned u32x2 __attribute__((ext_vector_type(2)));
typedef unsigned u32x4 __attribute__((ext_vector_type(4)));

constexpr int MTOK = 16384, DM = 2048, SEQ = 4096, NB = 4;
constexpr int ZW = 14336;
constexpr int ZN = 14592;
constexpr int ZQ = 0, ZK = 1024, ZV = 2048, ZZ = 3072, GQ = 4096, GK = 4608, GV = 5120, GR = 6144, SU = 7168, GT = 8192;
constexpr int FF = 5632;
constexpr float EPS = 1e-6f;

constexpr size_t WS_WA   = 0;
constexpr size_t SZ_WA   = 69206016;
constexpr size_t WS_WDN  = WS_WA + SZ_WA;
constexpr size_t WS_WGLA = WS_WDN + 4194304;
constexpr size_t WS_WGLU = WS_WGLA + 4194304;
constexpr size_t WS_WMIX = WS_WGLU + 8388608;
constexpr size_t WS_WXQ  = WS_WMIX + 8388608;
constexpr size_t WS_WXKV = WS_WXQ + 2097152;
constexpr size_t WS_WXO  = WS_WXKV + 4194304;
constexpr size_t WS_Z    = WS_WXO + 2097152;
constexpr size_t SZ_Z    = (size_t)MTOK * ZW * 2;
constexpr size_t WS_SM   = WS_Z + SZ_Z;
constexpr size_t WS_H    = WS_SM + (size_t)MTOK * 32 * 4;
constexpr size_t WS_DNP  = WS_H + (size_t)MTOK * DM * 2;
constexpr size_t DN_ITEM = 73728;
constexpr size_t WS_GLP  = WS_DNP + DN_ITEM * 2048;
constexpr size_t GL_ITEM = 74240;
constexpr size_t WS_MISC = WS_GLP + GL_ITEM * 1024;
constexpr size_t WS_BAR  = WS_MISC + 16384;
constexpr size_t WS_XS   = WS_MISC + 65536;
constexpr size_t WS_END  = WS_XS + (size_t)MTOK * DM * 2;

struct Params { const float* in[35]; float* out; unsigned char* ws; };
typedef const __attribute__((address_space(4))) Params* PPtr;
__device__ __forceinline__ int fresh_tid(int) {
    int hw = __builtin_amdgcn_s_getreg(10244) & 63; asm volatile("" : "+s"(hw));
    const int w = __builtin_amdgcn_readfirstlane(*(const volatile LAS int*)((LAS unsigned char*)nullptr + 131072 + hw * 4));
    unsigned z0_; asm volatile("s_mov_b32 %0, 0" : "=s"(z0_));
    const int ln = __builtin_amdgcn_mbcnt_hi(~0u, __builtin_amdgcn_mbcnt_lo(~0u, z0_)); int t = w * 64 + ln; asm volatile("" : "+v"(t)); return t; }
__device__ __forceinline__ int fresh_bid() { int b = blockIdx.x; asm volatile("" : "+s"(b)); return b; }
__device__ __forceinline__ int fresh_gdim() { int b = gridDim.x; asm volatile("" : "+s"(b)); return b; }
__device__ __forceinline__ PPtr PP() { auto kp = __builtin_amdgcn_kernarg_segment_ptr(); asm volatile("" : "+s"(kp)); return (PPtr)kp; }

__device__ __forceinline__ float bf2f(bf16_t v) { return __uint_as_float(((unsigned)v) << 16); }
typedef float f32x2_t __attribute__((ext_vector_type(2)));
typedef __bf16 bf16x2_t __attribute__((ext_vector_type(2)));
__device__ __forceinline__ unsigned pk_bf16(float lo, float hi) { const f32x2_t v = {lo, hi}; const bf16x2_t b = __builtin_convertvector(v, bf16x2_t); return __builtin_bit_cast(unsigned, b); }
__device__ __forceinline__ bf16_t f2bf(float f) { return (bf16_t)(pk_bf16(f, 0.f) & 0xffffu); }
__device__ __forceinline__ float sigmoidf_(float x) { return 1.f / (1.f + __expf(-x)); }
__device__ __forceinline__ float siluf_(float x) { return x * sigmoidf_(x); }
__device__ __forceinline__ float geluf_(float x) { const float u = 1.5957691216057308f * (x + 0.044715f * x * x * x); return x * sigmoidf_(u); }
__device__ __forceinline__ float softplusf_(float x) { return x > 20.f ? x : log1pf(__expf(x)); }
__device__ __forceinline__ float shx(float v, int mask, int lane) { return __int_as_float(__builtin_amdgcn_ds_bpermute((lane ^ mask) << 2, __float_as_int(v))); }
__device__ __forceinline__ float shup(float v, int delta, int lane) { return __int_as_float(__builtin_amdgcn_ds_bpermute((lane - delta) << 2, __float_as_int(v))); }
__device__ __forceinline__ float lo_bf(unsigned w) { return __uint_as_float(w << 16); }
__device__ __forceinline__ float hi_bf(unsigned w) { return __uint_as_float(w & 0xffff0000u); }
__device__ __forceinline__ f32x4 mfma16(bf16x8 a, bf16x8 b, f32x4 c) { return __builtin_amdgcn_mfma_f32_16x16x32_bf16(a, b, c, 0, 0, 0); }

__device__ __forceinline__ void gsync(cg::grid_group& grid) {
    __builtin_amdgcn_fence(__ATOMIC_RELEASE, "agent");
    asm volatile("s_waitcnt vmcnt(0) lgkmcnt(0)" ::: "memory");
    grid.sync();
    __builtin_amdgcn_fence(__ATOMIC_ACQUIRE, "agent");
    asm volatile("s_waitcnt vmcnt(0)" ::: "memory");
#ifdef EXTRA_SYNC
    __builtin_amdgcn_fence(__ATOMIC_RELEASE, "agent");
    asm volatile("s_waitcnt vmcnt(0) lgkmcnt(0)" ::: "memory");
    grid.sync();
    __builtin_amdgcn_fence(__ATOMIC_ACQUIRE, "agent");
    asm volatile("s_waitcnt vmcnt(0)" ::: "memory");
#endif
}


#define XB_TMO      128
#define XB_XCNT(j)  (256  + 64 * (j))
#define XB_XSUB(j)  (1280 + 64 * (j))
#define XB_XGEN(j)  (2304 + 64 * (j))
#define XB_TOP      3328
#define XB_TOPGEN   3392
#define XCD_BAR_WORDS 3456
#define XB_SPIN_CAP (1u << 20)
constexpr int XB_LDS_OFF = 131072 + 256;
__device__ __forceinline__ unsigned xb_ld(unsigned* p)              { return __hip_atomic_load(p, __ATOMIC_RELAXED, __HIP_MEMORY_SCOPE_AGENT); }
__device__ __forceinline__ unsigned xb_add(unsigned* p, unsigned v) { return __hip_atomic_fetch_add(p, v, __ATOMIC_RELAXED, __HIP_MEMORY_SCOPE_AGENT); }
__device__ __forceinline__ unsigned xb_xcc_id() { return (unsigned)__builtin_amdgcn_s_getreg((3 << 11) | 20) & 0xFu; }
#define XB_SPIN(cond, bar) do { unsigned _sp = 0; while (cond) { __builtin_amdgcn_s_sleep(1); \
    if ((++_sp & 255u) == 0u) { if (xb_ld(&(bar)[XB_TMO])) break; if (_sp > XB_SPIN_CAP) { atomicAdd(&(bar)[XB_TMO], 1u); break; } } } } while (0)
__device__ __forceinline__ void xcd_barrier_complete(unsigned* bar, unsigned x, unsigned& nloc, unsigned& nx) {
    const unsigned G = gridDim.x;
    unsigned sum, cnt, mine, sp = 0u;
    for (;;) {
        sum = 0u; cnt = 0u; mine = 0u;
#pragma unroll
        for (unsigned j = 0; j < 16; ++j) { const unsigned c = xb_ld(&bar[XB_XCNT(j)]); sum += c; cnt += (c > 0u) ? 1u : 0u; mine = (j == x) ? c : mine; }
        if (sum == G) break;
        __builtin_amdgcn_s_sleep(1);
        if ((++sp & 255u) == 0u) { if (xb_ld(&bar[XB_TMO])) break; if (sp > XB_SPIN_CAP) { atomicAdd(&bar[XB_TMO], 1u); break; } }
    }
    nloc = mine > 0u ? mine : 1u; nx = cnt > 0u ? cnt : 1u;
}
__device__ __forceinline__ void xbar(const int wid_s) {
    asm volatile("s_waitcnt vmcnt(0)" ::: "memory");
    __syncthreads();
    unsigned* bar = (unsigned*)(PP()->ws + WS_BAR);
    if (fresh_tid(wid_s) == 0) {
        volatile LAS unsigned* st = (volatile LAS unsigned*)((LAS unsigned char*)nullptr + XB_LDS_OFF);
        const unsigned x = xb_xcc_id();
        __builtin_amdgcn_s_waitcnt(0);
        unsigned nloc = st[0], nx = st[1];
        if (nloc == 0u) { xcd_barrier_complete(bar, x, nloc, nx); st[0] = nloc; st[1] = nx; }
        const unsigned old = xb_add(&bar[XB_XSUB(x)], 1u);
        const unsigned gen = old / nloc;
        if (old + 1u == (gen + 1u) * nloc) {
            __builtin_amdgcn_fence(__ATOMIC_RELEASE, "agent");
            asm volatile("s_waitcnt vmcnt(0)" ::: "memory");
            const unsigned og = xb_add(&bar[XB_TOP], 1u);
            const unsigned tg = og / nx;
            if (og + 1u == (tg + 1u) * nx) xb_add(&bar[XB_TOPGEN], 1u);
            else XB_SPIN(xb_ld(&bar[XB_TOPGEN]) == tg, bar);
            __builtin_amdgcn_fence(__ATOMIC_ACQUIRE, "agent");
            xb_add(&bar[XB_XGEN(x)], 1u);
            asm volatile("s_waitcnt vmcnt(0)" ::: "memory");
        } else {
            XB_SPIN(xb_ld(&bar[XB_XGEN(x)]) == gen, bar);
            __builtin_amdgcn_fence(__ATOMIC_ACQUIRE, "agent");
            asm volatile("s_waitcnt vmcnt(0)" ::: "memory");
        }
    }
    __syncthreads();
}

constexpr int BM = 256, BK = 64, HALF = 128, HTB = HALF * BK * 2, STAGE_BYTES = 8 * HTB, NXCD = 8, WGM = 8;
__device__ __forceinline__ int lds_byte(int r, int c) { const int st = (r >> 4) * 2 + (c >> 5), rr = r & 15, cc = c & 31, ob = rr * 64 + cc * 2; return st * 1024 + (ob ^ (((ob >> 9) & 1) << 5)); }
__device__ __forceinline__ void stage_rc(int b, int& R, int& C) { const int st = b / 1024, sb = b % 1024, swz = sb ^ (((sb >> 9) & 1) << 5); R = (st >> 1) * 16 + swz / 64; C = (st & 1) * 32 + (swz % 64) / 2; }
__device__ __forceinline__ int perm32(int rho) { const int n = rho >> 4, i = rho & 15; return 8 * (i >> 2) + 4 * n + (i & 3); }
struct Unit { int pm, pn; };
struct Gemm { const bf16_t* A; const bf16_t* Bt; int M, N, K, lda; };
struct StaticOrder {
    int nM, nN, nwg, G, c;
    __device__ void init(int M, int N, int G_, int c_) { nM = M / BM; nN = N / BM; nwg = nM * nN; G = G_; c = c_; }
    __device__ bool next(int i, Unit& u) const {
        const long L = (long)i * G + c; if (L >= nwg) return false;
        int wgid = (int)L; { const int q = nwg / NXCD, r = nwg % NXCD, xcd = wgid % NXCD, off = wgid / NXCD; wgid = (xcd < r ? xcd * (q + 1) : r * (q + 1) + (xcd - r) * q) + off; }
        const int nig = WGM * nN, gid = wgid / nig, fm = gid * WGM, gsz = (nM - fm) < WGM ? (nM - fm) : WGM;
        u.pm = fm + ((wgid % nig) % gsz); u.pn = (wgid % nig) / gsz; return true;
    }
};

template <class Epi>
__device__ __forceinline__ void gemm_phase(LAS unsigned char* lds, const Gemm g, const StaticOrder& S, const Epi& E, const int wid_s) {
    const int tid = fresh_tid(wid_s), wid = __builtin_amdgcn_readfirstlane(tid >> 6), lane = tid & 63, wr = wid >> 2, wc = wid & 3, fr = lane & 15, fq = lane >> 4;
    const int K = g.K, nt = K / BK, lda = g.lda;
    unsigned voffA[2], voffB[2];
#pragma unroll
    for (int i = 0; i < 2; ++i) { int R, C; stage_rc(tid * 16 + i * 8192, R, C); const int Rb = Epi::PERM ? ((R & ~31) + perm32(R & 31)) : R; voffA[i] = (unsigned)(R * lda + C) * 2u; voffB[i] = (unsigned)(Rb * K + C) * 2u; }
    const size_t kstep = (size_t)(BK * 2);
    const size_t hstepA = (size_t)HALF * lda * 2, hstepB = (size_t)HALF * K * 2;
    const size_t tstepA = 2 * hstepA, tstepB = 2 * hstepB;
    const unsigned ldsw = (unsigned)wid * 1024u;
    const int aoff = lds_byte(wr * 64 + fr, fq * 8), boff = lds_byte(wc * 32 + fr, fq * 8);
#define PG8_SA(b, h) (((b) * 2 + (h)) * HTB)
#define PG8_SB(b, h) ((4 + (b) * 2 + (h)) * HTB)
#define PG8_STAGE(bufoff, gbase, voff) do { _Pragma("unroll") for (int _i = 0; _i < 2; ++_i) \
        __builtin_amdgcn_global_load_lds((const unsigned*)((const char*)(gbase) + (voff)[_i]), (LAS unsigned*)(lds + (bufoff) + ldsw + _i * 8192), 16, 0, 0); } while (0)
#define PG8_LDA(dst, b, h) do { _Pragma("unroll") for (int m = 0; m < 4; ++m) _Pragma("unroll") for (int k = 0; k < 2; ++k) dst[m][k] = *(const LAS bf16x8*)(lds + PG8_SA(b, h) + aoff + m * 2048 + k * 1024); } while (0)
#define PG8_LDB(dst, b, h) do { _Pragma("unroll") for (int n = 0; n < 2; ++n) _Pragma("unroll") for (int k = 0; k < 2; ++k) dst[n][k] = *(const LAS bf16x8*)(lds + PG8_SB(b, h) + boff + n * 2048 + k * 1024); } while (0)
#define PG8_MMA(ai, bj, At, Bt) do { __builtin_amdgcn_s_setprio(1); _Pragma("unroll") for (int m = 0; m < 4; ++m) _Pragma("unroll") for (int n = 0; n < 2; ++n) _Pragma("unroll") for (int k = 0; k < 2; ++k) \
        acc[ai][bj][m][n] = __builtin_amdgcn_mfma_f32_16x16x32_bf16(Bt[n][k], At[m][k], acc[ai][bj][m][n], 0, 0, 0); __builtin_amdgcn_s_setprio(0); } while (0)
#define PG8_WAIT_V(n) asm volatile("s_waitcnt vmcnt(" #n ")" ::: "memory")
#define PG8_WAIT_L(n) asm volatile("s_waitcnt lgkmcnt(" #n ")" ::: "memory")
#define PG8_BAR __builtin_amdgcn_s_barrier()
#define PG8_SCHED __builtin_amdgcn_sched_barrier(0)
    Unit cur, nxt; int ui = 0;
    if (!S.next(0, cur)) return;
    f32x4 acc[2][2][4][2];
#pragma unroll
    for (int a = 0; a < 2; ++a)
#pragma unroll
        for (int b = 0; b < 2; ++b)
#pragma unroll
            for (int m = 0; m < 4; ++m)
#pragma unroll
                for (int n = 0; n < 2; ++n) acc[a][b][m][n] = (f32x4){0.f, 0.f, 0.f, 0.f};
    bf16x8 At[4][2], B0[2][2], B1[2][2];
    const char* cA = (const char*)g.A + (size_t)cur.pm * tstepA; const char* cB = (const char*)g.Bt + (size_t)cur.pn * tstepB;
    PG8_STAGE(PG8_SB(0, 0), cB, voffB); PG8_STAGE(PG8_SA(0, 0), cA, voffA); PG8_STAGE(PG8_SB(0, 1), cB + hstepB, voffB); PG8_STAGE(PG8_SA(0, 1), cA + hstepA, voffA);
    if (wr == 1) PG8_BAR;
    PG8_WAIT_V(4); PG8_BAR;
    PG8_STAGE(PG8_SB(1, 0), cB + kstep, voffB); PG8_STAGE(PG8_SA(1, 0), cA + kstep, voffA); PG8_STAGE(PG8_SB(1, 1), cB + hstepB + kstep, voffB);
    PG8_WAIT_V(6); PG8_BAR;
    for (;;) {
        const bool has_next = S.next(ui + 1, nxt);
        const char* nA = has_next ? (const char*)g.A + (size_t)nxt.pm * tstepA : cA; const char* nB = has_next ? (const char*)g.Bt + (size_t)nxt.pn * tstepB : cB;
        for (int t = 0; t < nt; t += 2) {
            const bool last = (t == nt - 2);
            const char* a1 = cA + (size_t)(t + 1) * kstep;
            const char* a2 = last ? nA : cA + (size_t)(t + 2) * kstep; const char* b2 = last ? nB : cB + (size_t)(t + 2) * kstep;
            const char* a3 = a2 + kstep; const char* b3 = b2 + kstep;
            PG8_LDB(B0, 0, 0); PG8_SCHED; PG8_LDA(At, 0, 0); PG8_STAGE(PG8_SA(1, 1), a1 + hstepA, voffA);
            PG8_WAIT_L(8); PG8_BAR; PG8_WAIT_L(0); PG8_MMA(0, 0, At, B0); PG8_BAR; PG8_SCHED;
            PG8_LDB(B1, 0, 1); PG8_STAGE(PG8_SB(0, 0), b2, voffB);
            PG8_BAR; PG8_WAIT_L(0); PG8_MMA(0, 1, At, B1); PG8_BAR;
            PG8_LDA(At, 0, 1); PG8_STAGE(PG8_SA(0, 0), a2, voffA);
            PG8_BAR; PG8_WAIT_L(0); PG8_MMA(1, 0, At, B0); PG8_BAR; PG8_SCHED;
            PG8_STAGE(PG8_SB(0, 1), b2 + hstepB, voffB);
            PG8_WAIT_V(6); PG8_BAR; PG8_MMA(1, 1, At, B1); PG8_BAR;
            PG8_LDB(B0, 1, 0); PG8_SCHED; PG8_LDA(At, 1, 0); PG8_STAGE(PG8_SA(0, 1), a2 + hstepA, voffA);
            PG8_WAIT_L(8); PG8_BAR; PG8_WAIT_L(0); PG8_MMA(0, 0, At, B0); PG8_BAR; PG8_SCHED;
            PG8_LDB(B1, 1, 1); PG8_STAGE(PG8_SB(1, 0), b3, voffB);
            PG8_BAR; PG8_WAIT_L(0); PG8_MMA(0, 1, At, B1); PG8_BAR;
            PG8_LDA(At, 1, 1); PG8_STAGE(PG8_SA(1, 0), a3, voffA);
            PG8_BAR; PG8_WAIT_L(0); PG8_MMA(1, 0, At, B0); PG8_BAR; PG8_SCHED;
            PG8_STAGE(PG8_SB(1, 1), b3 + hstepB, voffB);
            PG8_WAIT_V(6); PG8_BAR; PG8_MMA(1, 1, At, B1); PG8_BAR;
        }
        E(acc, cur, wr, wc, fr, fq);
        if (!has_next) break;
#pragma unroll
        for (int a = 0; a < 2; ++a)
#pragma unroll
            for (int b = 0; b < 2; ++b)
#pragma unroll
                for (int m = 0; m < 4; ++m)
#pragma unroll
                    for (int n = 0; n < 2; ++n) acc[a][b][m][n] = (f32x4){0.f, 0.f, 0.f, 0.f};
        cur = nxt; cA = nA; cB = nB; ++ui;
    }
    PG8_WAIT_V(0);
    if (wr == 0) PG8_BAR;
    PG8_BAR;
#undef PG8_SA
#undef PG8_SB
#undef PG8_STAGE
#undef PG8_LDA
#undef PG8_LDB
#undef PG8_MMA
#undef PG8_WAIT_V
#undef PG8_WAIT_L
#undef PG8_BAR
#undef PG8_SCHED
}

typedef const f32x4 (&AccRef)[2][2][4][2];
__device__ __forceinline__ u32x2 pk4(f32x4 v) { u32x2 r; r.x = pk_bf16(v[0], v[1]); r.y = pk_bf16(v[2], v[3]); return r; }
__device__ __forceinline__ f32x4 ld_bf4(const bf16_t* p) { const u32x2 w = *(const u32x2*)p; return (f32x4){lo_bf(w.x), hi_bf(w.x), lo_bf(w.y), hi_bf(w.y)}; }
__device__ __forceinline__ f32x4 sig4(f32x4 v) { return (f32x4){sigmoidf_(v[0]), sigmoidf_(v[1]), sigmoidf_(v[2]), sigmoidf_(v[3])}; }

struct EpiZ { static constexpr bool PERM = true; bf16_t* Z; float* SMp;
    __device__ __forceinline__ void operator()(AccRef acc, const Unit& u, int wr, int wc, int fr, int fq) const {
        const int row0 = u.pm * BM + wr * 64 + fr;
        if (u.pn < 56) {
#pragma unroll
            for (int ai = 0; ai < 2; ++ai)
#pragma unroll
                for (int m = 0; m < 4; ++m) { bf16_t* rp = Z + (size_t)(row0 + ai * HALF + m * 16) * ZW + u.pn * BM + wc * 32 + 8 * fq;
#pragma unroll
                    for (int bj = 0; bj < 2; ++bj) { const u32x2 lo = pk4(acc[ai][bj][m][0]), hi = pk4(acc[ai][bj][m][1]); *(u32x4*)(rp + bj * HALF) = (u32x4){lo.x, lo.y, hi.x, hi.y}; } }
        } else if (wc == 0) {
#pragma unroll
            for (int ai = 0; ai < 2; ++ai)
#pragma unroll
                for (int m = 0; m < 4; ++m) { float* rp = SMp + (size_t)(row0 + ai * HALF + m * 16) * 32 + 8 * fq;
#pragma unroll
                    for (int n = 0; n < 2; ++n) *(f32x4*)(rp + n * 4) = acc[ai][0][m][n]; }
        }
    }
};
struct EpiF32 { static constexpr bool PERM = false; float* C; int ldc;
    __device__ __forceinline__ void operator()(AccRef acc, const Unit& u, int wr, int wc, int fr, int fq) const {
        const int row0 = u.pm * BM + wr * 64 + fr, col0 = u.pn * BM + wc * 32 + 4 * fq;
#pragma unroll
        for (int ai = 0; ai < 2; ++ai)
#pragma unroll
            for (int m = 0; m < 4; ++m) { float* rp = C + (size_t)(row0 + ai * HALF + m * 16) * ldc + col0;
#pragma unroll
                for (int bj = 0; bj < 2; ++bj)
#pragma unroll
                    for (int n = 0; n < 2; ++n) *(f32x4*)(rp + bj * HALF + n * 16) = acc[ai][bj][m][n]; }
    }
};
struct EpiBf16 { static constexpr bool PERM = true; bf16_t* C; int ldc;
    __device__ __forceinline__ void operator()(AccRef acc, const Unit& u, int wr, int wc, int fr, int fq) const {
        const int row0 = u.pm * BM + wr * 64 + fr, col0 = u.pn * BM + wc * 32 + 8 * fq;
#pragma unroll
        for (int ai = 0; ai < 2; ++ai)
#pragma unroll
            for (int m = 0; m < 4; ++m) { bf16_t* rp = C + (size_t)(row0 + ai * HALF + m * 16) * ldc + col0;
#pragma unroll
                for (int bj = 0; bj < 2; ++bj) { const u32x2 lo = pk4(acc[ai][bj][m][0]), hi = pk4(acc[ai][bj][m][1]); *(u32x4*)(rp + bj * HALF) = (u32x4){lo.x, lo.y, hi.x, hi.y}; } }
    }
};
__device__ __forceinline__ void ld_bf8(const bf16_t* p, f32x4& lo, f32x4& hi) { const u32x4 w = *(const u32x4*)p; lo = (f32x4){lo_bf(w.x), hi_bf(w.x), lo_bf(w.y), hi_bf(w.y)}; hi = (f32x4){lo_bf(w.z), hi_bf(w.z), lo_bf(w.w), hi_bf(w.w)}; }
__device__ __forceinline__ void st_bf8(bf16_t* p, f32x4 lo, f32x4 hi) { const u32x2 a = pk4(lo), b = pk4(hi); *(u32x4*)p = (u32x4){a.x, a.y, b.x, b.y}; }
struct EpiGLU { static constexpr bool PERM = true; const bf16_t* Z; bf16_t* MRG;
    __device__ __forceinline__ void operator()(AccRef acc, const Unit& u, int wr, int wc, int fr, int fq) const {
        const int row0 = u.pm * BM + wr * 64 + fr, oc = u.pn * HALF + wc * 32 + 8 * fq;
#pragma unroll
        for (int ai = 0; ai < 2; ++ai)
#pragma unroll
            for (int m = 0; m < 4; ++m) { const int row = row0 + ai * HALF + m * 16;
                f32x4 g0, g1; ld_bf8(Z + (size_t)row * ZW + GT + 4096 + oc, g0, g1);
                st_bf8(MRG + (size_t)row * DM + oc, sig4(g0) * acc[ai][0][m][0] * sig4(acc[ai][1][m][0]), sig4(g1) * acc[ai][0][m][1] * sig4(acc[ai][1][m][1])); }
    }
};
template <bool FINAL> struct EpiAcc { static constexpr bool PERM = true; const bf16_t* Z; bf16_t* MRG; bf16_t* MB; int goff;
    __device__ __forceinline__ void operator()(AccRef acc, const Unit& u, int wr, int wc, int fr, int fq) const {
        const int row0 = u.pm * BM + wr * 64 + fr, col0 = u.pn * BM + wc * 32 + 8 * fq;
#pragma unroll
        for (int ai = 0; ai < 2; ++ai)
#pragma unroll
            for (int m = 0; m < 4; ++m) { const int row = row0 + ai * HALF + m * 16;
#pragma unroll
                for (int bj = 0; bj < 2; ++bj) { const int c = col0 + bj * HALF;
                    f32x4 g0, g1, m0, m1; ld_bf8(Z + (size_t)row * ZW + GT + goff + c, g0, g1); ld_bf8(MRG + (size_t)row * DM + c, m0, m1);
                    st_bf8((FINAL ? MB : MRG) + (size_t)row * DM + c, m0 + sig4(g0) * acc[ai][bj][m][0], m1 + sig4(g1) * acc[ai][bj][m][1]); } }
    }
};
struct EpiKV { static constexpr bool PERM = false; bf16_t* Kb; bf16_t* VT;
    __device__ __forceinline__ void operator()(AccRef acc, const Unit& u, int wr, int wc, int fr, int fq) const {
        const int row0 = u.pm * BM + wr * 64 + fr, col0 = u.pn * BM + wc * 32 + 4 * fq;
#pragma unroll
        for (int ai = 0; ai < 2; ++ai)
#pragma unroll
            for (int m = 0; m < 4; ++m) { const int row = row0 + ai * HALF + m * 16;
#pragma unroll
                for (int bj = 0; bj < 2; ++bj)
#pragma unroll
                    for (int n = 0; n < 2; ++n) { const int c = col0 + bj * HALF + n * 16; const f32x4 v = acc[ai][bj][m][n];
                        if (c < 512) *(u32x2*)(Kb + (size_t)row * 512 + c) = pk4(v);
                        else { const int cc = c - 512, b = row >> 8, key = row & 255;
#pragma unroll
                            for (int i = 0; i < 4; ++i) VT[((size_t)(b * 4 + ((cc + i) >> 7)) * 128 + ((cc + i) & 127)) * 256 + key] = f2bf(v[i]); } } }
    }
};
__device__ __forceinline__ float dpp_ror1(float v) { return __int_as_float(__builtin_amdgcn_update_dpp(0, __float_as_int(v), 0x121, 0xF, 0xF, false)); }
__device__ __forceinline__ float dpp_ror2(float v) { return __int_as_float(__builtin_amdgcn_update_dpp(0, __float_as_int(v), 0x122, 0xF, 0xF, false)); }
struct EpiFFN { static constexpr bool PERM = true; bf16_t* ACT; bf16_t* GB; bf16_t* UB; const float* cw;
    __device__ __forceinline__ void operator()(AccRef acc, const Unit& u, int wr, int wc, int fr, int fq) const {
        const int oc = u.pn * HALF + wc * 32 + 8 * fq;
#pragma unroll
        for (int ai = 0; ai < 2; ++ai) {
            const int rowb = u.pm * BM + ai * HALF + wr * 64;
            u32x2 pk0[4];
#pragma unroll
            for (int n = 0; n < 2; ++n) {
                const f32x4 wa = *(const f32x4*)(cw + (oc + 4 * n) * 3), wb = *(const f32x4*)(cw + (oc + 4 * n) * 3 + 4), wcc = *(const f32x4*)(cw + (oc + 4 * n) * 3 + 8);
                const float w0[4] = {wa[0], wa[3], wb[2], wcc[1]}, w1[4] = {wa[1], wb[0], wb[3], wcc[2]}, w2[4] = {wa[2], wb[1], wcc[0], wcc[3]};
                f32x4 v1 = {0.f, 0.f, 0.f, 0.f}, v2 = {0.f, 0.f, 0.f, 0.f};
#pragma unroll
                for (int m = 0; m < 4; ++m) {
                    f32x4 c1, c2, r;
#pragma unroll
                    for (int c = 0; c < 4; ++c) { c1[c] = dpp_ror1(acc[ai][0][m][n][c]); c2[c] = dpp_ror2(acc[ai][0][m][n][c]); }
#pragma unroll
                    for (int c = 0; c < 4; ++c) {
                        const float g = acc[ai][0][m][n][c], up = acc[ai][1][m][n][c];
                        const float q1 = (m == 0 || fr >= 1) ? c1[c] : v1[c];
                        const float q2 = (m == 0 || fr >= 2) ? c2[c] : v2[c];
                        r[c] = geluf_(w0[c] * q2 + w1[c] * q1 + w2[c] * g) * up;
                    }
                    v1 = c1; v2 = c2;
                    const u32x2 pr = pk4(r);
                    if (n == 0) pk0[m] = pr;
                    else { const int row = rowb + m * 16 + fr; if (m > 0 || fr >= 2) *(u32x4*)(ACT + (size_t)row * FF + oc) = (u32x4){pk0[m].x, pk0[m].y, pr.x, pr.y}; }
                    __builtin_amdgcn_sched_barrier(0);
                }
            }
            if (fr < 2) { st_bf8(GB + (size_t)((rowb >> 6) * 4 + 2 + fr) * FF + oc, acc[ai][0][0][0], acc[ai][0][0][1]); st_bf8(UB + (size_t)((rowb >> 6) * 2 + fr) * FF + oc, acc[ai][1][0][0], acc[ai][1][0][1]); }
            if (fr >= 14) st_bf8(GB + (size_t)((rowb >> 6) * 4 + (fr - 14)) * FF + oc, acc[ai][0][3][0], acc[ai][0][3][1]);
            __builtin_amdgcn_sched_barrier(0);
        }
    }
};

template <class Epi> __device__ __forceinline__ void run_gemm(LAS unsigned char* lds, const bf16_t* A, int lda, const bf16_t* Bt, int M, int N, int K, const Epi& E, const int wid_s, int shift = 0) {
    Gemm g; g.A = A; g.Bt = Bt; g.M = M; g.N = N; g.K = K; g.lda = lda;
    StaticOrder S; S.init(M, N, (int)fresh_gdim(), (int)((fresh_bid() + fresh_gdim() - shift) % fresh_gdim()));
    gemm_phase<Epi>(lds, g, S, E, wid_s);
}

__device__ __forceinline__ int src_col(int kind, int n) {
    if (kind == 0) return n;
    if (kind == 1) {
        if (n < 4096) return n;
        if (n < 6144) return n + 16;
        if (n < 14336) return n + 32;
        if (n < 14352) return n - 14336 + 4096;
        if (n < 14368) return n - 14352 + 6160;
        return -1;
    }
    if (kind == 2) { const int un = n >> 8, r = n & 255; return r < 128 ? un * 128 + r : 2048 + un * 128 + (r - 128); }
    { const int un = n >> 8, r = n & 255; return r < 128 ? un * 128 + r : FF + un * 128 + (r - 128); }
}
__device__ void convert_w(LAS float* ldsf, const float* __restrict__ W, bf16_t* __restrict__ Wt, int K, int Nsrc, int Ndst, int kind, const int wid_s, int nb = 0, int bi = 0) {
    const int t = fresh_tid(wid_s), ntn = Ndst >> 6, ntiles = ntn * (K >> 6);
    const int nn = t & 63, kq = t >> 6, row = t >> 3, seg = (t & 7) * 8;
    const int g = nb > 0 ? nb : fresh_gdim();
    int tile = nb > 0 ? bi : fresh_bid();
    float v[8];
    auto ld = [&](int tl) __attribute__((always_inline)) {
        const int n0 = (tl % ntn) << 6, k0 = (tl / ntn) << 6;
        const int sc = src_col(kind, n0 + nn);
#pragma unroll
        for (int i = 0; i < 8; ++i) v[i] = sc >= 0 ? W[(size_t)(k0 + kq + 8 * i) * Nsrc + sc] : 0.f;
    };
    if (tile < ntiles) ld(tile);
    for (; tile < ntiles; tile += g) {
        const int n0 = (tile % ntn) << 6, k0 = (tile / ntn) << 6;
#pragma unroll
        for (int i = 0; i < 8; ++i) ldsf[nn * 65 + kq + 8 * i] = v[i];
        __syncthreads();
        if (tile + g < ntiles) ld(tile + g);
        float o8[8];
#pragma unroll
        for (int j = 0; j < 8; ++j) o8[j] = ldsf[row * 65 + seg + j];
        u32x4 o; o.x = pk_bf16(o8[0], o8[1]); o.y = pk_bf16(o8[2], o8[3]); o.z = pk_bf16(o8[4], o8[5]); o.w = pk_bf16(o8[6], o8[7]);
        *(u32x4*)(Wt + (size_t)(n0 + row) * K + k0 + seg) = o;
        __syncthreads();
    }
}

__device__ __forceinline__ float wave_sum(float v, int lane) {
#pragma unroll
    for (int o = 32; o >= 1; o >>= 1) v += shx(v, o, lane);
    return v;
}
__device__ void norm_rows_f(const float* xin_f, bf16_t* xout_b, const float* gpre, bf16_t* hout, int nrows, const int wid_s) {
    const int t_ = fresh_tid(wid_s); const int lane = t_ & 63, gw = fresh_bid() * 8 + (t_ >> 6), nw = fresh_gdim() * 8;
    for (int row = gw; row < nrows; row += nw) {
        f32x4 v[8];
        const float* xr = xin_f + (size_t)row * DM;
#pragma unroll
        for (int i = 0; i < 8; ++i) v[i] = *(const f32x4*)(xr + (i * 64 + lane) * 4);
        if (xout_b) {
            bf16_t* xo = xout_b + (size_t)row * DM;
#pragma unroll
            for (int i = 0; i < 8; ++i) *(u32x2*)(xo + (i * 64 + lane) * 4) = pk4(v[i]);
        }
        float ss = 0.f;
#pragma unroll
        for (int i = 0; i < 8; ++i) ss += v[i][0] * v[i][0] + v[i][1] * v[i][1] + v[i][2] * v[i][2] + v[i][3] * v[i][3];
        ss = wave_sum(ss, lane);
        const float inv = rsqrtf(ss * (1.f / DM) + EPS);
        bf16_t* ho = hout + (size_t)row * DM;
#pragma unroll
        for (int i = 0; i < 8; ++i) { const f32x4 gp = *(const f32x4*)(gpre + (i * 64 + lane) * 4); *(u32x2*)(ho + (i * 64 + lane) * 4) = pk4(v[i] * inv * gp); }
    }
}
__device__ __forceinline__ void norm_rows(const bf16_t* xin_b, const bf16_t* y, const float* gpost, float* xout_f, bf16_t* xout_b, const float* gpre, bf16_t* hout, int nrows, const int wid_s) {
    const int t_ = fresh_tid(wid_s); const int lane = t_ & 63, gw = fresh_bid() * 8 + (t_ >> 6), nw = fresh_gdim() * 8;
    u32x4 rx[4], ry[4];
    auto ldrow = [&](int row) __attribute__((always_inline)) {
#pragma unroll
        for (int i = 0; i < 4; ++i) { rx[i] = *(const u32x4*)(xin_b + (size_t)row * DM + (i * 64 + lane) * 8); ry[i] = *(const u32x4*)(y + (size_t)row * DM + (i * 64 + lane) * 8); }
    };
    if (gw < nrows) ldrow(gw);
    for (int row = gw; row < nrows; row += nw) {
        f32x4 v[8], yv[8];
#pragma unroll
        for (int i = 0; i < 4; ++i) {
            v[2 * i] = (f32x4){lo_bf(rx[i].x), hi_bf(rx[i].x), lo_bf(rx[i].y), hi_bf(rx[i].y)}; v[2 * i + 1] = (f32x4){lo_bf(rx[i].z), hi_bf(rx[i].z), lo_bf(rx[i].w), hi_bf(rx[i].w)};
            yv[2 * i] = (f32x4){lo_bf(ry[i].x), hi_bf(ry[i].x), lo_bf(ry[i].y), hi_bf(ry[i].y)}; yv[2 * i + 1] = (f32x4){lo_bf(ry[i].z), hi_bf(ry[i].z), lo_bf(ry[i].w), hi_bf(ry[i].w)};
        }
        if (row + nw < nrows) ldrow(row + nw);
        float ss = 0.f;
#pragma unroll
        for (int i = 0; i < 8; ++i) ss += yv[i][0] * yv[i][0] + yv[i][1] * yv[i][1] + yv[i][2] * yv[i][2] + yv[i][3] * yv[i][3];
        ss = wave_sum(ss, lane);
        const float inv = rsqrtf(ss * (1.f / DM) + EPS);
#pragma unroll
        for (int i = 0; i < 4; ++i) {
            const f32x4 g0 = *(const f32x4*)(gpost + (i * 64 + lane) * 8), g1 = *(const f32x4*)(gpost + (i * 64 + lane) * 8 + 4);
            v[2 * i] += yv[2 * i] * inv * g0; v[2 * i + 1] += yv[2 * i + 1] * inv * g1;
        }
        if (xout_f) {
            float* xo = xout_f + (size_t)row * DM;
#pragma unroll
            for (int i = 0; i < 4; ++i) { *(f32x4*)(xo + (i * 64 + lane) * 8) = v[2 * i]; *(f32x4*)(xo + (i * 64 + lane) * 8 + 4) = v[2 * i + 1]; }
        }
        if (xout_b) {
            bf16_t* xo = xout_b + (size_t)row * DM;
#pragma unroll
            for (int i = 0; i < 4; ++i) st_bf8(xo + (i * 64 + lane) * 8, v[2 * i], v[2 * i + 1]);
        }
        if (hout) {
            float s2 = 0.f;
#pragma unroll
            for (int i = 0; i < 8; ++i) s2 += v[i][0] * v[i][0] + v[i][1] * v[i][1] + v[i][2] * v[i][2] + v[i][3] * v[i][3];
            s2 = wave_sum(s2, lane);
            const float inv2 = rsqrtf(s2 * (1.f / DM) + EPS);
            bf16_t* ho = hout + (size_t)row * DM;
#pragma unroll
            for (int i = 0; i < 4; ++i) {
                const f32x4 g0 = *(const f32x4*)(gpre + (i * 64 + lane) * 8), g1 = *(const f32x4*)(gpre + (i * 64 + lane) * 8 + 4);
                st_bf8(ho + (i * 64 + lane) * 8, v[2 * i] * inv2 * g0, v[2 * i + 1] * inv2 * g1);
            }
        }
    }
}

__device__ void dn_prep(LAS unsigned char* lds, PPtr p, int layer, const int wid_s) {
    const int t = fresh_tid(wid_s), wv = t >> 6, lane = t & 63, fr = lane & 15, fq = lane >> 4;
    LAS bf16_t* QS = (LAS bf16_t*)lds;
    LAS bf16_t* KS = (LAS bf16_t*)(lds + 17408);
    LAS float* KF = (LAS float*)(lds + 34816);
    LAS float* VF = (LAS float*)(lds + 67584);
    LAS float* LS = (LAS float*)(lds + 100352);
    LAS float* GC = (LAS float*)(lds + 117760);
    LAS float* BE = GC + 64;
    LAS float* EG = GC + 128;
    const bf16_t* Z = (const bf16_t*)(p->ws + WS_Z);
    const float* SMp = (const float*)(p->ws + WS_SM);
    bf16_t* DNP = (bf16_t*)(p->ws + WS_DNP);
    float* GLAST = (float*)(p->ws + WS_MISC);
    const float* convw = p->in[5] + (size_t)layer * 3072 * 4;
    for (int item = fresh_bid(); item < 2048; item += fresh_gdim()) {
        const int n = item & 63, h = (item >> 6) & 7, b = item >> 9;
        const size_t row0 = (size_t)b * SEQ + n * 64;
        bf16_t* it = DNP + (size_t)item * 36864;
        {
            const int c8 = (t & 15) * 8;
#pragma unroll 1
            for (int pass = 0; pass < 2; ++pass) {
                const int tok = pass * 32 + (t >> 4);
                u32x4 xz[3][4];
#pragma unroll
                for (int mat = 0; mat < 3; ++mat)
#pragma unroll
                    for (int j = 0; j < 4; ++j) {
                        const int tt = n * 64 + tok - 3 + j;
                        xz[mat][j] = (u32x4){0u, 0u, 0u, 0u};
                        if (tt >= 0) xz[mat][j] = *(const u32x4*)(Z + ((size_t)b * SEQ + tt) * ZW + mat * 1024 + h * 128 + c8);
                    }
#pragma unroll
                for (int mat = 0; mat < 3; ++mat) {
                    const int ch = mat * 1024 + h * 128 + c8;
                    float y[8];
#pragma unroll
                    for (int c = 0; c < 8; ++c) y[c] = 0.f;
                    f32x4 wc[8];
#pragma unroll
                    for (int c = 0; c < 8; ++c) wc[c] = *(const f32x4*)(convw + (size_t)(ch + c) * 4);
#pragma unroll
                    for (int j = 0; j < 4; ++j) {
                        const u32x4 xv = xz[mat][j];
                        y[0] += wc[0][j] * lo_bf(xv.x); y[1] += wc[1][j] * hi_bf(xv.x);
                        y[2] += wc[2][j] * lo_bf(xv.y); y[3] += wc[3][j] * hi_bf(xv.y);
                        y[4] += wc[4][j] * lo_bf(xv.z); y[5] += wc[5][j] * hi_bf(xv.z);
                        y[6] += wc[6][j] * lo_bf(xv.w); y[7] += wc[7][j] * hi_bf(xv.w);
                    }
                    float ss = 0.f;
#pragma unroll
                    for (int c = 0; c < 8; ++c) { y[c] = siluf_(y[c]); ss += y[c] * y[c]; }
                    if (mat < 2) {
                        ss += shx(ss, 1, lane); ss += shx(ss, 2, lane); ss += shx(ss, 4, lane); ss += shx(ss, 8, lane);
                        const float inv = rsqrtf(ss + EPS) * (mat == 0 ? 0.08838834764831845f : 1.f);
#pragma unroll
                        for (int c = 0; c < 8; ++c) y[c] *= inv;
                        u32x4 o; o.x = pk_bf16(y[0], y[1]); o.y = pk_bf16(y[2], y[3]); o.z = pk_bf16(y[4], y[5]); o.w = pk_bf16(y[6], y[7]);
                        if (mat == 0) *(LAS u32x4*)(QS + tok * 136 + c8) = o;
                        else { *(LAS u32x4*)(KS + tok * 136 + c8) = o;
#pragma unroll
                            for (int c = 0; c < 8; ++c) KF[tok * 128 + c8 + c] = y[c]; }
                    } else {
#pragma unroll
                        for (int c = 0; c < 8; ++c) VF[tok * 128 + c8 + c] = y[c];
                    }
                    __builtin_amdgcn_sched_barrier(0);
                }
            }
        }
        if (t < 64) {
            const float db = SMp[(row0 + t) * 32 + h], da = SMp[(row0 + t) * 32 + 8 + h];
            const float be = sigmoidf_(db);
            float g = -expf(p->in[6][layer * 8 + h]) * softplusf_(da + p->in[7][layer * 8 + h]);
#pragma unroll
            for (int o = 1; o < 64; o <<= 1) { const float v = shup(g, o, lane); if (lane >= o) g += v; }
            GC[t] = g; BE[t] = be; EG[t] = expf(g); GC[192 + t] = be * expf(g);
        }
        __syncthreads();
#pragma unroll
        for (int tt = 0; tt < 2; ++tt) {
            const int tile = wv * 2 + tt, mi = tile >> 2, ni = tile & 3;
            f32x4 aK = {0.f, 0.f, 0.f, 0.f}, aQ = {0.f, 0.f, 0.f, 0.f};
#pragma unroll
            for (int ks = 0; ks < 4; ++ks) {
                const bf16x8 bfr = *(const LAS bf16x8*)(KS + (ni * 16 + fr) * 136 + ks * 32 + fq * 8);
                const bf16x8 ak = *(const LAS bf16x8*)(KS + (mi * 16 + fr) * 136 + ks * 32 + fq * 8);
                const bf16x8 aq = *(const LAS bf16x8*)(QS + (mi * 16 + fr) * 136 + ks * 32 + fq * 8);
                aK = mfma16(ak, bfr, aK); aQ = mfma16(aq, bfr, aQ);
            }
            const int j = ni * 16 + fr; const float gj = GC[j];
#pragma unroll
            for (int r = 0; r < 4; ++r) {
                const int i = mi * 16 + fq * 4 + r;
                const float dec = (i >= j) ? expf(GC[i] - gj) : 0.f;
                LS[i * 68 + j] = (i > j) ? BE[i] * aK[r] * dec : 0.f;
                it[32768 + i * 64 + j] = f2bf(aQ[r] * dec);
            }
        }
        __syncthreads();
        if (t < 256) {
            const bool isw = t >= 128; const int cc = t & 127;
            bf16_t* op = it + (isw ? 8192 : 0) + cc;
            LAS const float* src = isw ? KF : VF;
            float x[64];
            int z0; asm volatile("v_mov_b32 %0, 0" : "=v"(z0));
            LAS const float* LSv = LS + z0;
            LAS const float* facp = (isw ? (GC + 192) : BE) + z0;
#pragma unroll
            for (int i = 0; i < 64; ++i) {
                float s = facp[i] * src[i * 128 + cc];
#pragma unroll
                for (int j = 0; j < i; ++j) s -= LSv[i * 68 + j] * x[j];
                x[i] = s;
                op[i * 128] = f2bf(s);
                asm volatile("" ::: "memory");
            }
        } else {
            const int t2 = t - 256;
            { const int i = t2 >> 2, cs = (t2 & 3) * 32; const float e = EG[i];
#pragma unroll
              for (int q = 0; q < 4; ++q) { const u32x4 w = *(const LAS u32x4*)(QS + i * 136 + cs + q * 8);
                  u32x4 o; o.x = pk_bf16(lo_bf(w.x) * e, hi_bf(w.x) * e); o.y = pk_bf16(lo_bf(w.y) * e, hi_bf(w.y) * e); o.z = pk_bf16(lo_bf(w.z) * e, hi_bf(w.z) * e); o.w = pk_bf16(lo_bf(w.w) * e, hi_bf(w.w) * e);
                  *(u32x4*)(it + 16384 + i * 128 + cs + q * 8) = o; } }
            { const int d = t2 >> 1, hf = t2 & 1; const float gl = GC[63];
#pragma unroll
              for (int q = 0; q < 4; ++q) { float v[8];
#pragma unroll
                  for (int e = 0; e < 8; ++e) { const int i = hf * 32 + q * 8 + e; v[e] = KF[i * 128 + d] * expf(gl - GC[i]); }
                  u32x4 o; o.x = pk_bf16(v[0], v[1]); o.y = pk_bf16(v[2], v[3]); o.z = pk_bf16(v[4], v[5]); o.w = pk_bf16(v[6], v[7]);
                  *(u32x4*)(it + 24576 + d * 64 + hf * 32 + q * 8) = o; } }
            if (t2 == 0) GLAST[item] = expf(GC[63]);
        }
        __syncthreads();
    }
}

__device__ void gla_prep(LAS unsigned char* lds, PPtr p, int layer, const int wid_s) {
    const int t = fresh_tid(wid_s), wv = t >> 6, lane = t & 63, fr = lane & 15, fq = lane >> 4;
    LAS bf16_t* QA = (LAS bf16_t*)(lds + 32768);
    LAS bf16_t* KD = (LAS bf16_t*)(lds + 50176);
    LAS float* TOT = (LAS float*)(lds + 67584);
    const bf16_t* Z = (const bf16_t*)(p->ws + WS_Z);
    const float* SMp = (const float*)(p->ws + WS_SM);
    unsigned char* GLP = p->ws + WS_GLP;
    for (int item = fresh_bid(); item < 1024; item += fresh_gdim()) {
        const int n = item & 63, h = (item >> 6) & 3, b = item >> 8;
        const size_t row0 = (size_t)b * SEQ + n * 64;
        bf16_t* it = (bf16_t*)(GLP + (size_t)item * GL_ITEM);
        const int d = t & 127, iq = __builtin_amdgcn_readfirstlane(t >> 7);
        float wup[16];
#pragma unroll
        for (int r = 0; r < 16; ++r) wup[r] = p->in[10][(size_t)layer * 16 * 512 + r * 512 + h * 128 + d];
        const float bup = p->in[11][layer * 512 + h * 128 + d];
        float la[16]; float run = 0.f;
#pragma unroll
        for (int ii = 0; ii < 16; ++ii) {
            const float* gl = SMp + (row0 + iq * 16 + ii) * 32 + 16;
            float dot = bup;
#pragma unroll
            for (int r = 0; r < 16; ++r) dot += gl[r] * wup[r];
            const float ls = fminf(dot, 0.f) - log1pf(__expf(-fabsf(dot)));
            run += ls * (1.f / 16.f); la[ii] = run;
        }
        TOT[iq * 128 + d] = run;
        __syncthreads();
        float off = 0.f, blast = 0.f;
#pragma unroll
        for (int q = 0; q < 4; ++q) { const float v = TOT[q * 128 + d]; blast += v; if (q < iq) off += v; }
        float kdv[16];
#pragma unroll
        for (int ii = 0; ii < 16; ++ii) {
            const int i = iq * 16 + ii; const float bc = la[ii] + off;
            const float q = bf2f(Z[(row0 + i) * ZW + GQ + h * 128 + d]) * 0.08838834764831845f;
            const float k = bf2f(Z[(row0 + i) * ZW + GK + h * 128 + d]);
            it[i * 128 + d] = f2bf(q * __expf(bc));
            QA[i * 136 + d] = f2bf(q * __expf(bc - blast));
            const float kd = k * __expf(blast - bc);
            KD[i * 136 + d] = f2bf(kd); kdv[ii] = kd;
        }
        { u32x4 o0, o1;
          o0.x = pk_bf16(kdv[0], kdv[1]); o0.y = pk_bf16(kdv[2], kdv[3]); o0.z = pk_bf16(kdv[4], kdv[5]); o0.w = pk_bf16(kdv[6], kdv[7]);
          o1.x = pk_bf16(kdv[8], kdv[9]); o1.y = pk_bf16(kdv[10], kdv[11]); o1.z = pk_bf16(kdv[12], kdv[13]); o1.w = pk_bf16(kdv[14], kdv[15]);
          *(u32x4*)(it + 8192 + d * 64 + iq * 16) = o0; *(u32x4*)(it + 8192 + d * 64 + iq * 16 + 8) = o1; }
        if (iq == 0) ((float*)((unsigned char*)it + 73728))[d] = __expf(blast);
        __syncthreads();
#pragma unroll
        for (int tt = 0; tt < 2; ++tt) {
            const int tile = wv * 2 + tt, mi = tile >> 2, ni = tile & 3;
            f32x4 a = {0.f, 0.f, 0.f, 0.f};
#pragma unroll
            for (int ks = 0; ks < 4; ++ks) {
                const bf16x8 bfr = *(const LAS bf16x8*)(KD + (ni * 16 + fr) * 136 + ks * 32 + fq * 8);
                const bf16x8 aq = *(const LAS bf16x8*)(QA + (mi * 16 + fr) * 136 + ks * 32 + fq * 8);
                a = mfma16(aq, bfr, a);
            }
            const int j = ni * 16 + fr;
#pragma unroll
            for (int r = 0; r < 4; ++r) { const int i = mi * 16 + fq * 4 + r; it[16384 + i * 64 + j] = f2bf(i >= j ? a[r] : 0.f); }
        }
        { const int e = t & 255, hf = t >> 8;
#pragma unroll
          for (int q = 0; q < 4; ++q) { bf16_t v[8];
#pragma unroll
              for (int e2 = 0; e2 < 8; ++e2) v[e2] = Z[(row0 + hf * 32 + q * 8 + e2) * ZW + GV + h * 256 + e];
              u32x4 o; o.x = v[0] | ((unsigned)v[1] << 16); o.y = v[2] | ((unsigned)v[3] << 16); o.z = v[4] | ((unsigned)v[5] << 16); o.w = v[6] | ((unsigned)v[7] << 16);
              *(u32x4*)(it + 20480 + e * 64 + hf * 32 + q * 8) = o; } }
        __syncthreads();
    }
}

__device__ void dn_scan(LAS unsigned char* lds, PPtr p, int bh, int es, const int wid_s) {
    const int t = fresh_tid(wid_s), wv = t >> 6, lane = t & 63, fr = lane & 15, fq = lane >> 4;
    const int mt = wv & 3, et = wv >> 2;
    LAS bf16_t* ST = (LAS bf16_t*)lds;
    LAS bf16_t* VT = (LAS bf16_t*)(lds + 8704);
    const bf16_t* DNP = (const bf16_t*)(p->ws + WS_DNP);
    const float* GLAST = (const float*)(p->ws + WS_MISC);
    bf16_t* OA = (bf16_t*)(p->ws + WS_H);
    for (int i = t; i < 32 * 136 / 2; i += 512) ((LAS unsigned*)ST)[i] = 0u;
    f32x4 S0 = {0.f, 0.f, 0.f, 0.f}, S1 = {0.f, 0.f, 0.f, 0.f};
    __syncthreads();
    const int b = bh >> 3, h = bh & 7;
    struct DF { bf16x8 wf[4], qf[4], af[2], kf[2]; float uv[4]; float gl; };
    auto dload = [&](int n) __attribute__((always_inline)) {
        DF f; const bf16_t* it = DNP + (size_t)(bh * 64 + n) * 36864;
#pragma unroll
        for (int ks = 0; ks < 4; ++ks) { f.wf[ks] = *(const bf16x8*)(it + 8192 + (mt * 16 + fr) * 128 + ks * 32 + fq * 8); f.qf[ks] = *(const bf16x8*)(it + 16384 + (mt * 16 + fr) * 128 + ks * 32 + fq * 8); }
#pragma unroll
        for (int ks = 0; ks < 2; ++ks) { f.af[ks] = *(const bf16x8*)(it + 32768 + (mt * 16 + fr) * 64 + ks * 32 + fq * 8); f.kf[ks] = *(const bf16x8*)(it + 24576 + (wv * 16 + fr) * 64 + ks * 32 + fq * 8); }
#pragma unroll
        for (int r = 0; r < 4; ++r) f.uv[r] = bf2f(it[(mt * 16 + fq * 4 + r) * 128 + es * 32 + et * 16 + fr]);
        f.gl = GLAST[bh * 64 + n];
        return f; };
    DF cf = dload(0);
#pragma unroll 1
    for (int n = 0; n < 64; ++n) {
        const DF nf = dload(n < 63 ? n + 1 : 63);
        const bf16x8 (&wf)[4] = cf.wf; const bf16x8 (&qf)[4] = cf.qf; const bf16x8 (&af)[2] = cf.af; const bf16x8 (&kf)[2] = cf.kf; const float (&uv)[4] = cf.uv; const float gl = cf.gl;
        f32x4 P = {0.f, 0.f, 0.f, 0.f}, Q = {0.f, 0.f, 0.f, 0.f};
#pragma unroll
        for (int ks = 0; ks < 4; ++ks) { const bf16x8 bfr = *(const LAS bf16x8*)(ST + (et * 16 + fr) * 136 + ks * 32 + fq * 8); P = mfma16(wf[ks], bfr, P); Q = mfma16(qf[ks], bfr, Q); }
        const f32x4 vn = {uv[0] - P[0], uv[1] - P[1], uv[2] - P[2], uv[3] - P[3]};
        *(LAS u32x2*)(VT + (et * 16 + fr) * 72 + mt * 16 + fq * 4) = pk4(vn);
        __syncthreads();
#pragma unroll
        for (int ks = 0; ks < 2; ++ks) { const bf16x8 bfr = *(const LAS bf16x8*)(VT + (et * 16 + fr) * 72 + ks * 32 + fq * 8); Q = mfma16(af[ks], bfr, Q); }
#pragma unroll
        for (int r = 0; r < 4; ++r) OA[((size_t)b * SEQ + n * 64 + mt * 16 + fq * 4 + r) * 1024 + h * 128 + es * 32 + et * 16 + fr] = f2bf(Q[r]);
        S0 *= gl; S1 *= gl;
#pragma unroll
        for (int ks = 0; ks < 2; ++ks) {
            const bf16x8 b0 = *(const LAS bf16x8*)(VT + fr * 72 + ks * 32 + fq * 8);
            const bf16x8 b1 = *(const LAS bf16x8*)(VT + (16 + fr) * 72 + ks * 32 + fq * 8);
            S0 = mfma16(kf[ks], b0, S0); S1 = mfma16(kf[ks], b1, S1);
        }
        *(LAS u32x2*)(ST + fr * 136 + wv * 16 + fq * 4) = pk4(S0);
        *(LAS u32x2*)(ST + (16 + fr) * 136 + wv * 16 + fq * 4) = pk4(S1);
        __syncthreads();
        cf = nf;
    }
}

__device__ void gla_scan(LAS unsigned char* lds, PPtr p, int bh, int es, const int wid_s) {
    const int t = fresh_tid(wid_s), wv = t >> 6, lane = t & 63, fr = lane & 15, fq = lane >> 4;
    const int mt = wv & 3, eh = wv >> 2;
    LAS bf16_t* STb = (LAS bf16_t*)lds;
    const unsigned char* GLP = p->ws + WS_GLP;
    bf16_t* OB = (bf16_t*)(p->ws + WS_H) + (size_t)MTOK * 1024;
    for (int i = t; i < 64 * 136 / 2; i += 512) ((LAS unsigned*)STb)[i] = 0u;
    f32x4 S[4];
#pragma unroll
    for (int e = 0; e < 4; ++e) S[e] = (f32x4){0.f, 0.f, 0.f, 0.f};
    __syncthreads();
    const int b = bh >> 2, h = bh & 3;
    struct GF { bf16x8 qf[4], af[2], kf[2], vB[4][2]; };
    auto gload = [&](int n) __attribute__((always_inline)) {
        GF f; const unsigned char* itb = GLP + (size_t)(bh * 64 + n) * GL_ITEM; const bf16_t* it = (const bf16_t*)itb;
#pragma unroll
        for (int ks = 0; ks < 4; ++ks) f.qf[ks] = *(const bf16x8*)(it + (mt * 16 + fr) * 128 + ks * 32 + fq * 8);
#pragma unroll
        for (int ks = 0; ks < 2; ++ks) { f.af[ks] = *(const bf16x8*)(it + 16384 + (mt * 16 + fr) * 64 + ks * 32 + fq * 8); f.kf[ks] = *(const bf16x8*)(it + 8192 + (wv * 16 + fr) * 64 + ks * 32 + fq * 8); }
#pragma unroll
        for (int e = 0; e < 4; ++e)
#pragma unroll
            for (int ks = 0; ks < 2; ++ks) f.vB[e][ks] = *(const bf16x8*)(it + 20480 + (es * 64 + e * 16 + fr) * 64 + ks * 32 + fq * 8);
        return f; };
    auto alload = [&](int n) __attribute__((always_inline)) { return *(const f32x4*)((const float*)(GLP + (size_t)(bh * 64 + n) * GL_ITEM + 73728) + wv * 16 + fq * 4); };
    f32x4 alc = alload(0);
    GF cf = gload(0), nf = gload(1);
#pragma unroll 1
    for (int n = 0; n < 64; ++n) {
        const GF nnf = gload(n < 62 ? n + 2 : 63);
        LAS bf16_t* cur = STb + (n & 1) * (64 * 136);
        LAS bf16_t* nxt = STb + ((n + 1) & 1) * (64 * 136);
        const bf16x8 (&qf)[4] = cf.qf; const bf16x8 (&af)[2] = cf.af; const bf16x8 (&kf)[2] = cf.kf; const bf16x8 (&vB)[4][2] = cf.vB; const f32x4 al = alc; const f32x4 aln = alload(n < 63 ? n + 1 : 63);
#pragma unroll
        for (int e2 = 0; e2 < 2; ++e2) {
            const int etile = eh * 2 + e2;
            f32x4 O = {0.f, 0.f, 0.f, 0.f};
#pragma unroll
            for (int ks = 0; ks < 4; ++ks) { const bf16x8 bfr = *(const LAS bf16x8*)(cur + (etile * 16 + fr) * 136 + ks * 32 + fq * 8); O = mfma16(qf[ks], bfr, O); }
#pragma unroll
            for (int ks = 0; ks < 2; ++ks) O = eh ? mfma16(af[ks], vB[2 + e2][ks], O) : mfma16(af[ks], vB[e2][ks], O);
#pragma unroll
            for (int r = 0; r < 4; ++r) OB[((size_t)b * SEQ + n * 64 + mt * 16 + fq * 4 + r) * 1024 + h * 256 + es * 64 + etile * 16 + fr] = f2bf(O[r]);
        }
#pragma unroll
        for (int e = 0; e < 4; ++e) {
            S[e] *= al;
#pragma unroll
            for (int ks = 0; ks < 2; ++ks) S[e] = mfma16(kf[ks], vB[e][ks], S[e]);
            *(LAS u32x2*)(nxt + (e * 16 + fr) * 136 + wv * 16 + fq * 4) = pk4(S[e]);
        }
        __syncthreads();
        cf = nf; nf = nnf; alc = aln;
    }
}

constexpr int S5_LDS_WAVE = 16384 + 8704;
__device__ __forceinline__ void s5_scan(LAS unsigned char* ldsw, PPtr p, int layer, int b, int g, const int wid_s) {
    const int lane = fresh_tid(wid_s) & 63, fr = lane & 15, fq = lane >> 4;
    bf16_t* Z = (bf16_t*)(p->ws + WS_Z);
    const float* lam_re = p->in[14] + (size_t)(layer * 64 + g) * 64;
    const float* lam_im = p->in[15] + (size_t)(layer * 64 + g) * 64;
    const float dt = expf(p->in[16][layer * 64 + g]);
    const float* b_re = p->in[17] + (size_t)(layer * 64 + g) * 64 * 16;
    const float* b_im = p->in[18] + (size_t)(layer * 64 + g) * 64 * 16;
    const float* c_re = p->in[19] + (size_t)(layer * 64 + g) * 16 * 64;
    const float* c_im = p->in[20] + (size_t)(layer * 64 + g) * 16 * 64;
    const float dsk = p->in[21][layer * 1024 + g * 16 + fr];
    float ar, ai;
    { const float lr = fminf(lam_re[lane], -1e-4f), li = lam_im[lane]; const float mag = expf(lr * dt); ar = mag * cosf(li * dt); ai = mag * sinf(li * dt); }
    bf16x8 bB[8];
#pragma unroll
    for (int nt = 0; nt < 8; ++nt) {
        const int pp = (nt * 16 + fr) & 63;
        const float lr = fminf(lam_re[pp], -1e-4f), li = lam_im[pp]; const float mag = expf(lr * dt);
        const float a_r = mag * cosf(li * dt), a_i = mag * sinf(li * dt), nr = a_r - 1.f, den = lr * lr + li * li;
        const float zr = (nr * lr + a_i * li) / den, zi = (a_i * lr - nr * li) / den;
        float v[8];
#pragma unroll
        for (int j = 0; j < 8; ++j) {
            float val = 0.f;
            if (fq < 2) { const float br = b_re[pp * 16 + fq * 8 + j], bi = b_im[pp * 16 + fq * 8 + j]; val = (nt >= 4) ? (zr * bi + zi * br) : (zr * br - zi * bi); }
            v[j] = val;
        }
        u32x4 o; o.x = pk_bf16(v[0], v[1]); o.y = pk_bf16(v[2], v[3]); o.z = pk_bf16(v[4], v[5]); o.w = pk_bf16(v[6], v[7]);
        bB[nt] = __builtin_bit_cast(bf16x8, o);
    }
    bf16x8 cB[4];
#pragma unroll
    for (int ks = 0; ks < 4; ++ks) {
        const int p0 = (ks * 32 + fq * 8) >> 1;
        float v[8];
#pragma unroll
        for (int j = 0; j < 4; ++j) { v[2 * j] = c_re[fr * 64 + p0 + j]; v[2 * j + 1] = -c_im[fr * 64 + p0 + j]; }
        u32x4 o; o.x = pk_bf16(v[0], v[1]); o.y = pk_bf16(v[2], v[3]); o.z = pk_bf16(v[4], v[5]); o.w = pk_bf16(v[6], v[7]);
        cB[ks] = __builtin_bit_cast(bf16x8, o);
    }
    LAS float* const BU0 = (LAS float*)ldsw;
    LAS unsigned* const X0 = (LAS unsigned*)(ldsw + 16384);
    float xr = 0.f, xi = 0.f;
    const size_t rowb = (size_t)b * SEQ;
    auto ldfrag = [&](int tile) __attribute__((always_inline)) {
        u32x4 r = {0u, 0u, 0u, 0u};
        if (fq < 2) r = *(const u32x4*)(Z + (rowb + tile * 16 + fr) * ZW + SU + g * 16 + fq * 8);
        return r; };
    auto stageA = [&](u32x4 uraw, LAS float* bu) __attribute__((always_inline)) {
        const bf16x8 ua = __builtin_bit_cast(bf16x8, uraw);
#pragma unroll
        for (int nt = 0; nt < 8; ++nt) {
            f32x4 acc = {0.f, 0.f, 0.f, 0.f};
            acc = mfma16(ua, bB[nt], acc);
#pragma unroll
            for (int r = 0; r < 4; ++r) bu[(fq * 4 + r) * 128 + nt * 16 + fr] = acc[r];
        } };
    auto stageB = [&](LAS const float* bu, LAS unsigned* xw) __attribute__((always_inline)) {
        float br_[16], bi_[16];
#pragma unroll
        for (int tt = 0; tt < 16; ++tt) { br_[tt] = bu[tt * 128 + lane]; bi_[tt] = bu[tt * 128 + 64 + lane]; }
#pragma unroll
        for (int tt = 0; tt < 16; ++tt) {
            const float nxr = ar * xr - ai * xi + br_[tt], nxi = ar * xi + ai * xr + bi_[tt];
            xr = nxr; xi = nxi;
            xw[tt * 68 + lane] = pk_bf16(xr, xi);
        } };
    auto stageC = [&](LAS const unsigned* xrd, int tile, const bf16_t (&ue)[4], bool doit) __attribute__((always_inline)) {
        f32x4 acc = {0.f, 0.f, 0.f, 0.f};
#pragma unroll
        for (int ks = 0; ks < 4; ++ks) { const bf16x8 xa = *(const LAS bf16x8*)((const LAS bf16_t*)xrd + fr * 136 + ks * 32 + fq * 8); acc = mfma16(xa, cB[ks], acc); }
        if (doit) {
#pragma unroll
            for (int r = 0; r < 4; ++r) {
                bf16_t* zp = Z + (rowb + tile * 16 + fq * 4 + r) * ZW + ZQ + g * 16 + fr;
                *zp = f2bf(geluf_(acc[r] + dsk * bf2f(ue[r])));
            }
        } };
    auto ldue = [&](int tile, bf16_t (&ue)[4]) __attribute__((always_inline)) {
#pragma unroll
        for (int r = 0; r < 4; ++r) ue[r] = Z[(rowb + tile * 16 + fq * 4 + r) * ZW + SU + g * 16 + fr]; };
    u32x4 q1 = ldfrag(1), q2 = ldfrag(2);
    stageA(ldfrag(0), BU0);
    bf16_t uec[4] = {0, 0, 0, 0}, uen[4];
    asm volatile("s_waitcnt lgkmcnt(0)" ::: "memory");
#pragma unroll 1
    for (int t = 0; t < 256; t += 2) {
        { const u32x4 q3 = ldfrag(t + 3 < 256 ? t + 3 : 255); ldue(t, uen);
          stageA(q1, BU0 + 2048); stageB(BU0, X0); stageC(X0 + 1088, t - 1, uec, t > 0);
          q1 = q2; q2 = q3;
#pragma unroll
          for (int r = 0; r < 4; ++r) uec[r] = uen[r];
          asm volatile("s_waitcnt lgkmcnt(0)" ::: "memory"); }
        { const u32x4 q3 = ldfrag(t + 4 < 256 ? t + 4 : 255); ldue(t + 1, uen);
          stageA(q1, BU0); stageB(BU0 + 2048, X0 + 1088); stageC(X0, t, uec, true);
          q1 = q2; q2 = q3;
#pragma unroll
          for (int r = 0; r < 4; ++r) uec[r] = uen[r];
          asm volatile("s_waitcnt lgkmcnt(0)" ::: "memory"); }
    }
    stageC(X0 + 1088, 255, uec, true);
    asm volatile("s_waitcnt lgkmcnt(0)" ::: "memory");
}

template <int W> __device__ void head_norm_gate(bf16_t* O, const bf16_t* Zg  , const float* nw, const int wid_s) {
    constexpr int LPG = W / 8;
    constexpr unsigned HPR = 1024 / W;
    const unsigned total = (unsigned)MTOK * HPR * LPG;
    const int t_ = fresh_tid(wid_s), lane_ = t_ & 63;
    const unsigned gthreads = (unsigned)fresh_gdim() * 512u, gid = (unsigned)fresh_bid() * 512u + (unsigned)t_;
    const int l = (int)(gid % LPG);
    float nwv[8];
#pragma unroll
    for (int c = 0; c < 8; ++c) nwv[c] = nw[l * 8 + c];
    u32x4 w, gz;
    auto ldit = [&](unsigned idx) __attribute__((always_inline)) {
        const unsigned grp = idx / LPG, row = grp / HPR, hh = grp % HPR; const unsigned col = hh * W + l * 8;
        w = *(const u32x4*)(O + (size_t)row * 1024 + col); gz = *(const u32x4*)(Zg + (size_t)row * ZW + col);
    };
    if (gid < total) ldit(gid);
    for (unsigned idx = gid; idx < total; idx += gthreads) {
        const unsigned grp = idx / LPG, row = grp / HPR, hh = grp % HPR; const unsigned col = hh * W + l * 8;
        float v[8] = {lo_bf(w.x), hi_bf(w.x), lo_bf(w.y), hi_bf(w.y), lo_bf(w.z), hi_bf(w.z), lo_bf(w.w), hi_bf(w.w)};
        const float gzv[8] = {lo_bf(gz.x), hi_bf(gz.x), lo_bf(gz.y), hi_bf(gz.y), lo_bf(gz.z), hi_bf(gz.z), lo_bf(gz.w), hi_bf(gz.w)};
        if (idx + gthreads < total) ldit(idx + gthreads);
        float ss = 0.f;
#pragma unroll
        for (int c = 0; c < 8; ++c) ss += v[c] * v[c];
#pragma unroll
        for (int o = 1; o < LPG; o <<= 1) ss += shx(ss, o, lane_);
        const float inv = rsqrtf(ss * (1.f / W) + EPS);
#pragma unroll
        for (int c = 0; c < 8; ++c) v[c] = v[c] * inv * nwv[c] * siluf_(gzv[c]);
        u32x4 o; o.x = pk_bf16(v[0], v[1]); o.y = pk_bf16(v[2], v[3]); o.z = pk_bf16(v[4], v[5]); o.w = pk_bf16(v[6], v[7]);
        *(u32x4*)(O + (size_t)row * 1024 + col) = o;
    }
}

__device__ void xattn(LAS unsigned char* lds, const bf16_t* XQ, const bf16_t* Kb, const bf16_t* VTg, bf16_t* XO, const int wid_s) {
    const int t = fresh_tid(wid_s), wv = t >> 6, lane = t & 63, fr = lane & 15, fq = lane >> 4;
    LAS bf16_t* Pw = (LAS bf16_t*)(lds + wv * 8448);
    for (int item = fresh_bid(); item < 512; item += fresh_gdim()) {
        const int qt = item & 31, hd = (item >> 5) & 3, b = item >> 7;
        const size_t r0 = (size_t)b * SEQ + qt * 128 + wv * 16;
        bf16x8 qf[4];
#pragma unroll
        for (int ks = 0; ks < 4; ++ks) qf[ks] = *(const bf16x8*)(XQ + (r0 + fr) * 512 + hd * 128 + ks * 32 + fq * 8);
        f32x4 s[16];
#pragma unroll
        for (int nt = 0; nt < 16; ++nt) {
            f32x4 a = {0.f, 0.f, 0.f, 0.f};
#pragma unroll
            for (int ks = 0; ks < 4; ++ks) { const bf16x8 kfr = *(const bf16x8*)(Kb + ((size_t)b * 256 + nt * 16 + fr) * 512 + hd * 128 + ks * 32 + fq * 8); a = mfma16(qf[ks], kfr, a); }
            s[nt] = a * 0.08838834764831845f;
        }
        float mx[4], sm[4];
#pragma unroll
        for (int r = 0; r < 4; ++r) {
            float m = s[0][r];
#pragma unroll
            for (int nt = 1; nt < 16; ++nt) m = fmaxf(m, s[nt][r]);
            m = fmaxf(m, shx(m, 1, lane)); m = fmaxf(m, shx(m, 2, lane)); m = fmaxf(m, shx(m, 4, lane)); m = fmaxf(m, shx(m, 8, lane));
            mx[r] = m;
            float su = 0.f;
#pragma unroll
            for (int nt = 0; nt < 16; ++nt) { const float e = __expf(s[nt][r] - m); s[nt][r] = e; su += e; }
            su += shx(su, 1, lane); su += shx(su, 2, lane); su += shx(su, 4, lane); su += shx(su, 8, lane);
            sm[r] = 1.f / su;
        }
#pragma unroll
        for (int nt = 0; nt < 16; ++nt)
#pragma unroll
            for (int r = 0; r < 4; ++r) Pw[(fq * 4 + r) * 264 + nt * 16 + fr] = f2bf(s[nt][r] * sm[r]);
        __syncthreads();
        bf16x8 pf[8];
#pragma unroll
        for (int ks = 0; ks < 8; ++ks) pf[ks] = *(const LAS bf16x8*)(Pw + fr * 264 + ks * 32 + fq * 8);
#pragma unroll
        for (int dtile = 0; dtile < 8; ++dtile) {
            f32x4 o = {0.f, 0.f, 0.f, 0.f};
#pragma unroll
            for (int ks = 0; ks < 8; ++ks) { const bf16x8 vfr = *(const bf16x8*)(VTg + ((size_t)(b * 4 + hd) * 128 + dtile * 16 + fr) * 256 + ks * 32 + fq * 8); o = mfma16(pf[ks], vfr, o); }
#pragma unroll
            for (int r = 0; r < 4; ++r) XO[(r0 + fq * 4 + r) * 512 + hd * 128 + dtile * 16 + fr] = f2bf(o[r]);
        }
        __syncthreads();
    }
}

__device__ void ffn_act(const bf16_t* G, const bf16_t* U, const float* cw, bf16_t* ACT, const int wid_s) {
    const unsigned nitems = (unsigned)(FF / 8) * (MTOK / 16);
    const unsigned gthreads = (unsigned)fresh_gdim() * 512u, gid = (unsigned)fresh_bid() * 512u + (unsigned)fresh_tid(wid_s);
    for (unsigned idx = gid; idx < nitems; idx += gthreads) {
        const unsigned cg = idx % (FF / 8), tb = idx / (FF / 8);
        const unsigned c0 = cg * 8, t0 = tb * 16;
        float w0[8], w1[8], w2[8];
#pragma unroll
        for (int c = 0; c < 8; ++c) { w0[c] = cw[(c0 + c) * 3]; w1[c] = cw[(c0 + c) * 3 + 1]; w2[c] = cw[(c0 + c) * 3 + 2]; }
        float g2[8], g1[8];
        const bool start = (t0 & (SEQ - 1)) == 0;
        const unsigned base = t0 * FF + c0;
        { u32x4 a = {0u, 0u, 0u, 0u}, bq = {0u, 0u, 0u, 0u};
          if (!start) { a = *(const u32x4*)(G + (base - 2 * FF)); bq = *(const u32x4*)(G + (base - FF)); }
          g2[0] = lo_bf(a.x); g2[1] = hi_bf(a.x); g2[2] = lo_bf(a.y); g2[3] = hi_bf(a.y); g2[4] = lo_bf(a.z); g2[5] = hi_bf(a.z); g2[6] = lo_bf(a.w); g2[7] = hi_bf(a.w);
          g1[0] = lo_bf(bq.x); g1[1] = hi_bf(bq.x); g1[2] = lo_bf(bq.y); g1[3] = hi_bf(bq.y); g1[4] = lo_bf(bq.z); g1[5] = hi_bf(bq.z); g1[6] = lo_bf(bq.w); g1[7] = hi_bf(bq.w); }
#pragma unroll 4
        for (unsigned tt = 0; tt < 16; ++tt) {
            const unsigned off = base + tt * FF;
            const u32x4 a = *(const u32x4*)(G + off);
            const u32x4 uq = *(const u32x4*)(U + off);
            const float g0[8] = {lo_bf(a.x), hi_bf(a.x), lo_bf(a.y), hi_bf(a.y), lo_bf(a.z), hi_bf(a.z), lo_bf(a.w), hi_bf(a.w)};
            const float uu[8] = {lo_bf(uq.x), hi_bf(uq.x), lo_bf(uq.y), hi_bf(uq.y), lo_bf(uq.z), hi_bf(uq.z), lo_bf(uq.w), hi_bf(uq.w)};
            float r[8];
#pragma unroll
            for (int c = 0; c < 8; ++c) { const float y = w0[c] * g2[c] + w1[c] * g1[c] + w2[c] * g0[c]; r[c] = geluf_(y) * uu[c]; g2[c] = g1[c]; g1[c] = g0[c]; }
            u32x4 o; o.x = pk_bf16(r[0], r[1]); o.y = pk_bf16(r[2], r[3]); o.z = pk_bf16(r[4], r[5]); o.w = pk_bf16(r[6], r[7]);
            *(u32x4*)(ACT + off) = o;
        }
    }
}

__device__ void ffn_fix(const bf16_t* GB, const bf16_t* UB, const float* cw, bf16_t* ACT, const int wid_s) {
    const unsigned nitems = 256u * 2u * (FF / 8);
    const unsigned gthreads = (unsigned)fresh_gdim() * 512u, gid = (unsigned)fresh_bid() * 512u + (unsigned)fresh_tid(wid_s);
    for (unsigned idx = gid; idx < nitems; idx += gthreads) {
        const unsigned cg = idx % (FF / 8), rest = idx / (FF / 8), rr = rest & 1u, rb = rest >> 1;
        const unsigned c0 = cg * 8;
        const bool first = (rb & 63u) == 0u;
        const u32x4 zero = {0u, 0u, 0u, 0u};
        const u32x4 a0 = *(const u32x4*)(GB + (size_t)(rb * 4 + 2 + rr) * FF + c0);
        u32x4 a1, a2;
        if (rr == 0) { a1 = first ? zero : *(const u32x4*)(GB + (size_t)((rb - 1) * 4 + 1) * FF + c0); a2 = first ? zero : *(const u32x4*)(GB + (size_t)((rb - 1) * 4 + 0) * FF + c0); }
        else         { a1 = *(const u32x4*)(GB + (size_t)(rb * 4 + 2) * FF + c0);                     a2 = first ? zero : *(const u32x4*)(GB + (size_t)((rb - 1) * 4 + 1) * FF + c0); }
        const u32x4 uq = *(const u32x4*)(UB + (size_t)(rb * 2 + rr) * FF + c0);
        const float g0[8] = {lo_bf(a0.x), hi_bf(a0.x), lo_bf(a0.y), hi_bf(a0.y), lo_bf(a0.z), hi_bf(a0.z), lo_bf(a0.w), hi_bf(a0.w)};
        const float g1[8] = {lo_bf(a1.x), hi_bf(a1.x), lo_bf(a1.y), hi_bf(a1.y), lo_bf(a1.z), hi_bf(a1.z), lo_bf(a1.w), hi_bf(a1.w)};
        const float g2[8] = {lo_bf(a2.x), hi_bf(a2.x), lo_bf(a2.y), hi_bf(a2.y), lo_bf(a2.z), hi_bf(a2.z), lo_bf(a2.w), hi_bf(a2.w)};
        const float uu[8] = {lo_bf(uq.x), hi_bf(uq.x), lo_bf(uq.y), hi_bf(uq.y), lo_bf(uq.z), hi_bf(uq.z), lo_bf(uq.w), hi_bf(uq.w)};
        float r[8];
#pragma unroll
        for (int c = 0; c < 8; ++c) { const float y = cw[(c0 + c) * 3] * g2[c] + cw[(c0 + c) * 3 + 1] * g1[c] + cw[(c0 + c) * 3 + 2] * g0[c]; r[c] = geluf_(y) * uu[c]; }
        u32x4 o; o.x = pk_bf16(r[0], r[1]); o.y = pk_bf16(r[2], r[3]); o.z = pk_bf16(r[4], r[5]); o.w = pk_bf16(r[6], r[7]);
        *(u32x4*)(ACT + (size_t)(rb * 64 + rr) * FF + c0) = o;
    }
}

__device__ void convert_layer_small(LAS float* ldsf, PPtr p, int l, const int wid_s) {
    unsigned char* ws = p->ws;
    convert_w(ldsf, p->in[4] + (size_t)l * 2048 * 14368, (bf16_t*)(ws + WS_WA), 2048, 14368, ZN, 1, wid_s);
    convert_w(ldsf, p->in[9] + (size_t)l * 1024 * 2048, (bf16_t*)(ws + WS_WDN), 1024, 2048, 2048, 0, wid_s);
    convert_w(ldsf, p->in[13] + (size_t)l * 1024 * 2048, (bf16_t*)(ws + WS_WGLA), 1024, 2048, 2048, 0, wid_s);
    convert_w(ldsf, p->in[22] + (size_t)l * 1024 * 4096, (bf16_t*)(ws + WS_WGLU), 1024, 4096, 4096, 2, wid_s);
    convert_w(ldsf, p->in[23] + (size_t)l * 2048 * 2048, (bf16_t*)(ws + WS_WMIX), 2048, 2048, 2048, 0, wid_s);
    convert_w(ldsf, p->in[27] + (size_t)l * 2048 * 512, (bf16_t*)(ws + WS_WXQ), 2048, 512, 512, 0, wid_s);
    convert_w(ldsf, p->in[28] + (size_t)l * 2048 * 1024, (bf16_t*)(ws + WS_WXKV), 2048, 1024, 1024, 0, wid_s);
    convert_w(ldsf, p->in[29] + (size_t)l * 512 * 2048, (bf16_t*)(ws + WS_WXO), 512, 2048, 2048, 0, wid_s);
}
__device__ void convert_layer_ffn(LAS float* ldsf, PPtr p, int l, const int wid_s, int nb, int bi) {
    unsigned char* ws = p->ws;
    convert_w(ldsf, p->in[32] + (size_t)l * 2048 * 11264, (bf16_t*)(ws + WS_WA), 2048, 11264, 11264, 3, wid_s, nb, bi);
    convert_w(ldsf, p->in[34] + (size_t)l * 5632 * 2048, (bf16_t*)(ws + WS_WA + 46137344), 5632, 2048, 2048, 0, wid_s, nb, bi);
}


#ifdef DEBUG_NAN
__device__ __noinline__ void chk_f32(const float* q, size_t n, unsigned bit, unsigned* flag) {
    const size_t gthreads = (size_t)gridDim.x * 512, gid = (size_t)blockIdx.x * 512 + threadIdx.x; bool bad = false;
    for (size_t i = gid; i < n; i += gthreads) { const float v = q[i]; if (!(fabsf(v) < 1e30f)) bad = true; }
    if (bad) atomicOr(flag, 1u << bit);
}
__device__ __noinline__ void chk_bf16(const bf16_t* q, size_t n, unsigned bit, unsigned* flag) {
    const size_t gthreads = (size_t)gridDim.x * 512, gid = (size_t)blockIdx.x * 512 + threadIdx.x; bool bad = false;
    for (size_t i = gid; i < n; i += gthreads) { const float v = bf2f(q[i]); if (!(fabsf(v) < 1e30f)) bad = true; }
    if (bad) atomicOr(flag, 1u << bit);
}
#define CHKF(ptr, n, bit) do { if (l == DEBUG_NAN - 1) { chk_f32(ptr, n, bit, (unsigned*)(PP()->ws + WS_MISC + 32768)); } gsync(grid); } while (0)
#define CHKB(ptr, n, bit) do { if (l == DEBUG_NAN - 1) { chk_bf16(ptr, n, bit, (unsigned*)(PP()->ws + WS_MISC + 32768)); } xbar(wid_s); } while (0)
#else
#define CHKF(ptr, n, bit) do {} while (0)
#define CHKB(ptr, n, bit) do {} while (0)
#endif
#ifdef DEBUG_TS
__device__ __forceinline__ bool ts_in(const int* sel, int n, int k) { for (int q = 0; q < n; ++q) if (sel[q] == k) return true; return false; }
#define TS(k) do { const unsigned long long t_ = __builtin_amdgcn_s_memrealtime(); const int selA_[] = DEBUG_TS_A; const int selB_[] = DEBUG_TS_B; \
    const int kk_ = (k) % 20; \
    if (ts_in(selA_, (int)(sizeof(selA_) / sizeof(int)), kk_)) tsA += t_ - tsL; if (ts_in(selB_, (int)(sizeof(selB_) / sizeof(int)), kk_)) tsB += t_ - tsL; tsL = t_; } while (0)
#else
#define TS(k) do {} while (0)
#endif
#ifndef PMASK
#define PMASK 0xFFFFFFFFu
#endif
#define ON(k) ((PMASK >> (k)) & 1u)
constexpr size_t WS_LIMIT = 941621248;
static_assert(WS_END <= WS_LIMIT, "workspace map exceeds the guaranteed workspace size");
static_assert(WS_DNP + (size_t)MTOK * FF * 2 <= WS_MISC, "ACT does not fit");
static_assert((size_t)MTOK * FF * 2 * 2 <= SZ_Z, "G,U do not fit in Z");

#define m_ws (PP()->ws)
#define m_Z ((bf16_t*)(m_ws + WS_Z))
#define m_Y ((bf16_t*)(m_ws + WS_Z))
#define m_SMp ((float*)(m_ws + WS_SM))
#define m_H ((bf16_t*)(m_ws + WS_H))
#define m_OA m_H
#define m_OB (m_H + (size_t)MTOK * 1024)
#define m_MRG ((bf16_t*)(m_ws + WS_DNP))
#define m_XQ ((bf16_t*)(m_ws + WS_DNP))
#define m_XO ((bf16_t*)(m_ws + WS_DNP + (size_t)MTOK * 512 * 2))
#define m_ACT ((bf16_t*)(m_ws + WS_DNP))
#define m_MB ((bf16_t*)(m_ws + WS_GLP))
#define m_MEMN ((bf16_t*)(m_ws + WS_GLP))
#define m_KB ((bf16_t*)(m_ws + WS_GLP + 4194304))
#define m_VTG ((bf16_t*)(m_ws + WS_GLP + 5242880))
#define m_G ((bf16_t*)(m_ws + WS_Z))
#define m_U ((bf16_t*)(m_ws + WS_Z + 16777216))
#define m_xs ((bf16_t*)(m_ws + WS_XS))
#define m_out (PP()->out)
#define p PP()
__global__ void __launch_bounds__(512, 2) fwd_megakernel(Params p_unused) {
    extern __shared__ __attribute__((aligned(16))) unsigned char lds_raw[];
    LAS unsigned char* lds = (LAS unsigned char*)lds_raw;
    LAS float* ldsf = (LAS float*)lds_raw;
    cg::grid_group grid = cg::this_grid();
    if ((threadIdx.x & 63) == 0) ((LAS int*)(lds + 131072))[__builtin_amdgcn_s_getreg(10244) & 63] = (int)(threadIdx.x >> 6);
    { unsigned* bar0 = (unsigned*)(PP()->ws + WS_BAR);
      if (threadIdx.x == 0) { volatile LAS unsigned* st = (volatile LAS unsigned*)(lds + XB_LDS_OFF); st[0] = 0u; st[1] = 0u;
          (void)xb_add(&bar0[XB_XCNT(xb_xcc_id())], 1u); } }
    __syncthreads();
    constexpr int wid_s = 0;
#ifdef DEBUG_TS
    unsigned long long tsA = 0ull, tsB = 0ull, tsL = __builtin_amdgcn_s_memrealtime();
#endif
    if (ON(0)) convert_layer_small(ldsf, p, 0, wid_s);
    if (ON(1)) norm_rows_f(p->in[0], m_xs, p->in[2], m_H, MTOK, wid_s);
    if (PP()->ws == nullptr) grid.sync();
    xbar(wid_s); TS(0);

#pragma unroll 1
    for (int l = 0; l < 2; ++l) {
        if (ON(2)) { EpiZ e; e.Z = m_Z; e.SMp = m_SMp; run_gemm(lds, m_H, DM, (const bf16_t*)(m_ws + WS_WA), MTOK, ZN, DM, e, wid_s); }
#ifdef REPEAT_PH1
        { EpiZ e; e.Z = m_Z; e.SMp = m_SMp; run_gemm(lds, m_H, DM, (const bf16_t*)(m_ws + WS_WA), MTOK, ZN, DM, e, wid_s); }
#endif
        xbar(wid_s); TS(l * 20 + 1);

#ifdef DEBUG_Z
        {
            unsigned long long* cw = (unsigned long long*)(PP()->ws + WS_MISC + 32768);
            const size_t gthreads = (size_t)gridDim.x * 512, gid = (size_t)blockIdx.x * 512 + threadIdx.x;
            const bf16_t* zz = m_Z; const bf16_t* wa = (const bf16_t*)(m_ws + WS_WA);
            unsigned long long c = 0, mi = ~0ull, cwa = 0;
            for (size_t i = gid; i < (size_t)MTOK * ZW; i += gthreads) { const float v = bf2f(zz[i]); if (!(fabsf(v) < 1e30f)) { ++c; if (i < mi) mi = i; } }
            for (size_t i = gid; i < (size_t)ZN * 2048; i += gthreads) { const float v = bf2f(wa[i]); if (!(fabsf(v) < 1e30f)) ++cwa; }
            if (c) { atomicAdd(cw, c); atomicMin(cw + 1, mi); }
            if (cwa) atomicAdd(cw + 2, cwa);
            xbar(wid_s);
            const unsigned long long C = cw[0], MI = cw[1], WB = cw[2];
            const int pnf = (int)((MI % ZW) / 256), pmf = (int)((MI / ZW) / 256);
            const int wb = WB == 0 ? 0 : (WB < 1000 ? 1 : 2), zb = C < 10000 ? 0 : (C < 10000000 ? 1 : 2);
            const float e1 = exp10f(10.f + (float)(pmf / 4));
            const float v1 = (10.f + pnf) * e1, v2 = (10.f + 10.f * (3 * wb + zb)) * e1 * 0.01f;
            float* o = PP()->out;
            for (size_t i = gid; i < (size_t)MTOK * DM; i += gthreads) o[i] = (i == 0) ? v1 : v2;
            return;
        }
#endif

        CHKB(m_H, (size_t)MTOK * DM, 0); CHKB(m_Z, (size_t)MTOK * ZW, 1); CHKF(m_SMp, (size_t)MTOK * 32, 2);
        if (ON(3)) dn_prep(lds, p, l, wid_s);
        if (ON(4)) gla_prep(lds, p, l, wid_s);
        xbar(wid_s); TS(l * 20 + 2);
        CHKB((const bf16_t*)(m_ws + WS_DNP), (size_t)DN_ITEM * 1024, 3); CHKB((const bf16_t*)(m_ws + WS_GLP), (size_t)GL_ITEM * 512, 4);
        for (int role = blockIdx.x; role < 256; role += gridDim.x) {
            if (role < 128) { if (ON(5)) { const int x_ = role & 7, j_ = role >> 3; dn_scan(lds, p, x_ * 4 + (j_ >> 2), j_ & 3, wid_s); } }
            else if (role < 192) { if (ON(6)) { const int li_ = role - 128, x_ = li_ & 7, j_ = li_ >> 3; gla_scan(lds, p, x_ * 2 + (j_ >> 2), j_ & 3, wid_s); } }
            else { const int wv = fresh_tid(wid_s) >> 6; if (ON(7) && wv < 4) { const int pair = (role - 192) * 4 + wv; s5_scan(lds + wv * S5_LDS_WAVE, p, l, pair >> 6, pair & 63, wid_s); } }
            __syncthreads();
        }
        { const int bid_ = fresh_bid(), gd_ = fresh_gdim(), nbc = gd_ >= 256 ? 192 : gd_; if (ON(0) && bid_ < nbc) convert_layer_ffn(ldsf, p, l, wid_s, nbc, bid_); }
        xbar(wid_s); TS(l * 20 + 3);
#ifdef REPEAT_PH3
        for (int role = blockIdx.x; role < 256; role += gridDim.x) {
            if (role < 128) { if (ON(5)) { const int x_ = role & 7, j_ = role >> 3; dn_scan(lds, p, x_ * 4 + (j_ >> 2), j_ & 3, wid_s); } }
            else if (role < 192) { if (ON(6)) { const int li_ = role - 128, x_ = li_ & 7, j_ = li_ >> 3; gla_scan(lds, p, x_ * 2 + (j_ >> 2), j_ & 3, wid_s); } }
            else { const int wv = fresh_tid(wid_s) >> 6; if (ON(7) && wv < 4) { const int pair = (role - 192) * 4 + wv; s5_scan(lds + wv * S5_LDS_WAVE, p, l, pair >> 6, pair & 63, wid_s); } }
            __syncthreads();
        }
        xbar(wid_s);
#endif
        CHKB(m_OA, (size_t)MTOK * 1024, 5); CHKB(m_OB, (size_t)MTOK * 1024, 6); CHKB(m_Z, (size_t)MTOK * ZW, 7);
        if (ON(8)) head_norm_gate<128>(m_OA, m_Z + ZZ, p->in[8] + l * 128, wid_s);
        if (ON(8)) head_norm_gate<256>(m_OB, m_Z + GR, p->in[12] + l * 256, wid_s);
        if (ON(9)) { EpiGLU e; e.Z = m_Z; e.MRG = m_MRG; run_gemm(lds, m_Z + ZQ, ZW, (const bf16_t*)(m_ws + WS_WGLU), MTOK, 4096, 1024, e, wid_s); }
        xbar(wid_s); TS(l * 20 + 4);
        CHKB(m_OA, (size_t)MTOK * 2048, 8); CHKB(m_MRG, (size_t)MTOK * DM, 9);
        if (ON(10)) { EpiAcc<false> e; e.Z = m_Z; e.MRG = m_MRG; e.MB = nullptr; e.goff = 0; run_gemm(lds, m_OA, 1024, (const bf16_t*)(m_ws + WS_WDN), MTOK, DM, 1024, e, wid_s); }
        if (ON(10)) { EpiAcc<true> e; e.Z = m_Z; e.MRG = m_MRG; e.MB = m_MB; e.goff = 2048; run_gemm(lds, m_OB, 1024, (const bf16_t*)(m_ws + WS_WGLA), MTOK, DM, 1024, e, wid_s); }
        xbar(wid_s); TS(l * 20 + 5);
        CHKB(m_MB, (size_t)MTOK * DM, 10);
        if (ON(11)) { EpiBf16 e; e.C = m_Y; e.ldc = DM; run_gemm(lds, m_MB, DM, (const bf16_t*)(m_ws + WS_WMIX), MTOK, DM, DM, e, wid_s); }
        xbar(wid_s); TS(l * 20 + 6);
        CHKF(m_Y, (size_t)MTOK * DM, 11);
        if (ON(1)) norm_rows(m_xs, m_Y, p->in[3] + l * DM, nullptr, m_xs, p->in[24] + l * DM, m_H, MTOK, wid_s);
        if (ON(1)) norm_rows_f(p->in[1], nullptr, p->in[26] + l * DM, m_MEMN, 1024, wid_s);
        xbar(wid_s); TS(l * 20 + 7);
        CHKB(m_xs, (size_t)MTOK * DM, 12); CHKB(m_H, (size_t)MTOK * DM, 13);
        if (ON(12)) { EpiBf16 e; e.C = m_XQ; e.ldc = 512; run_gemm(lds, m_H, DM, (const bf16_t*)(m_ws + WS_WXQ), MTOK, 512, DM, e, wid_s); }
        if (ON(13)) { EpiKV e; e.Kb = m_KB; e.VT = m_VTG; run_gemm(lds, m_MEMN, DM, (const bf16_t*)(m_ws + WS_WXKV), 1024, 1024, DM, e, wid_s, 128); }
        xbar(wid_s); TS(l * 20 + 8);
        CHKB(m_XQ, (size_t)MTOK * 512, 14); CHKB(m_KB, (size_t)1024 * 1024, 15);
        if (ON(14)) xattn(lds, m_XQ, m_KB, m_VTG, m_XO, wid_s);
        xbar(wid_s); TS(l * 20 + 9);
        CHKB(m_XO, (size_t)MTOK * 512, 16);
        if (ON(11)) { EpiBf16 e; e.C = m_Y; e.ldc = DM; run_gemm(lds, m_XO, 512, (const bf16_t*)(m_ws + WS_WXO), MTOK, DM, 512, e, wid_s); }
        xbar(wid_s); TS(l * 20 + 10);
        CHKF(m_Y, (size_t)MTOK * DM, 17);
        if (ON(1)) norm_rows(m_xs, m_Y, p->in[25] + l * DM, nullptr, m_xs, p->in[30] + l * DM, m_H, MTOK, wid_s);
        xbar(wid_s); TS(l * 20 + 11);
        CHKB(m_xs, (size_t)MTOK * DM, 18);
        if (ON(15)) { EpiFFN e; e.ACT = m_ACT; e.GB = m_G; e.UB = m_U; e.cw = p->in[33] + (size_t)l * FF * 3; run_gemm(lds, m_H, DM, (const bf16_t*)(m_ws + WS_WA), MTOK, 2 * FF, DM, e, wid_s); }
        xbar(wid_s); TS(l * 20 + 12);
        CHKB(m_G, (size_t)MTOK * FF * 2, 19);
        if (ON(16)) ffn_fix(m_G, m_U, p->in[33] + (size_t)l * FF * 3, m_ACT, wid_s);
        xbar(wid_s); TS(l * 20 + 13);
        CHKB(m_ACT, (size_t)MTOK * FF, 20);
        if (ON(11)) { EpiBf16 e; e.C = m_Y; e.ldc = DM; run_gemm(lds, m_ACT, FF, (const bf16_t*)(m_ws + WS_WA + 46137344), MTOK, DM, FF, e, wid_s); }
        xbar(wid_s); TS(l * 20 + 14);
        CHKF(m_Y, (size_t)MTOK * DM, 21);
        if (l == 0) {
            if (ON(1)) norm_rows(m_xs, m_Y, p->in[31] + l * DM, nullptr, m_xs, p->in[2] + DM, m_H, MTOK, wid_s);
            if (ON(0)) convert_layer_small(ldsf, p, 1, wid_s);
        } else {
            if (ON(1)) norm_rows(m_xs, m_Y, p->in[31] + l * DM, m_out, nullptr, nullptr, nullptr, MTOK, wid_s);
        }
        xbar(wid_s); TS(l * 20 + 15);
        }
#ifdef DEBUG_TS
    {   const float A = (float)tsA * 0.01f, B = (float)tsB * 0.01f;
        xbar(wid_s);
        const unsigned gthreads = (unsigned)fresh_gdim() * 512u, gid = (unsigned)fresh_bid() * 512u + (unsigned)fresh_tid(wid_s);
        float* o = PP()->out;
        for (unsigned i = gid; i < (unsigned)MTOK * DM; i += gthreads) o[i] = (i == 0u) ? B * 10000.f : A;
    }
#endif
#ifdef DEBUG_NAN
    { const unsigned f = *(volatile unsigned*)(PP()->ws + WS_MISC + 32768); int idx = -1; for (int k = 0; k < 32; ++k) if ((f >> k) & 1u) { idx = k; break; }
      bool finalbad = false; const size_t gthreads = (size_t)gridDim.x * 512, gid = (size_t)blockIdx.x * 512 + threadIdx.x;
      const float val = idx < 0 ? 16.f : exp2f(5.f + idx);
      float* o = PP()->out;
      for (size_t i = gid; i < (size_t)MTOK * DM; i += gthreads) { if (idx >= 0) o[i] = val; else { const float v = o[i]; if (!(fabsf(v) < 1e30f)) o[i] = 16.f; } } }
#endif
}

#undef m_ws
#undef m_Z
#undef m_Y
#undef m_SMp
#undef m_H
#undef m_OA
#undef m_OB
#undef m_MRG
#undef m_XQ
#undef m_XO
#undef m_ACT
#undef m_MB
#undef m_MEMN
#undef m_KB
#undef m_VTG
#undef m_G
#undef m_U
#undef m_xs
#undef m_out
#undef p
extern "C" void kernel_launch(void* const* d_in, const int* in_sizes, int n_in,
                              void* d_out, int out_size, void* d_ws, size_t ws_size,
                              hipStream_t stream) {
    static int grid_blocks = 0;
    constexpr int kDynLds = 131072 + 512;
    if (!grid_blocks) {
        int dev = 0, cus = 0, per_cu = 0;
        (void)hipGetDevice(&dev);
        (void)hipDeviceGetAttribute(&cus, hipDeviceAttributeMultiprocessorCount, dev);
        if (hipFuncSetAttribute((const void*)fwd_megakernel, hipFuncAttributeMaxDynamicSharedMemorySize, kDynLds) != hipSuccess) fprintf(stderr, "hipFuncSetAttribute failed\n");
        if (hipOccupancyMaxActiveBlocksPerMultiprocessor(&per_cu, (const void*)fwd_megakernel, 512, kDynLds) != hipSuccess || per_cu < 1) { fprintf(stderr, "occupancy query: %d\n", per_cu); per_cu = 1; }
        (void)hipGetLastError();
        grid_blocks = cus;
        if (n_in != 35 || ws_size < WS_END) fprintf(stderr, "kernel_launch: unexpected n_in %d or ws_size %zu (< %zu)\n", n_in, ws_size, (size_t)WS_END);
    }
    Params hp{};
    for (int i = 0; i < 35; ++i) hp.in[i] = (const float*)d_in[i];
    hp.out = (float*)d_out; hp.ws = (unsigned char*)d_ws;
    (void)hipMemsetAsync((unsigned char*)d_ws + WS_BAR, 0, XCD_BAR_WORDS * 4, stream);
    void* args[] = {&hp};
    hipError_t e = hipLaunchCooperativeKernel((const void*)fwd_megakernel, dim3(grid_blocks), dim3(512), args, kDynLds, stream);
    if (e != hipSuccess) fprintf(stderr, "cooperative launch failed: %s (grid %d)\n", hipGetErrorString(e), grid_blocks);
}
```

```cpp
#include <hip/hip_runtime.h>
#include <hip/hip_cooperative_groups.h>
#include <cstdio>
#include <type_traits>
namespace cg = cooperative_groups;

#define LAS __attribute__((address_space(3)))
typedef unsigned short bf16_t;
typedef short bf16x8 __attribute__((ext_vector_type(8)));
typedef float f32x4 __attribute__((ext_vector_type(4)));
typedef unsigned u32x2 __attribute__((ext_vector_type(2)));
typedef unsigned u32x4 __attribute__((ext_vector_type(4)));

constexpr int MTOK = 16384, DM = 2048, SEQ = 4096, NB = 4;
constexpr int ZW = 14336;
constexpr int ZN = 14592;
constexpr int ZQ = 0, ZK = 1024, ZV = 2048, ZZ = 3072, GQ = 4096, GK = 4608, GV = 5120, GR = 6144, SU = 7168, GT = 8192;
constexpr int FF = 5632;
constexpr float EPS = 1e-6f;

constexpr size_t WS_WA   = 0;
constexpr size_t SZ_WA   = 69206016;
constexpr size_t WS_WDN  = WS_WA + SZ_WA;
constexpr size_t WS_WGLA = WS_WDN + 4194304;
constexpr size_t WS_WGLU = WS_WGLA + 4194304;
constexpr size_t WS_WMIX = WS_WGLU + 8388608;
constexpr size_t WS_WXQ  = WS_WMIX + 8388608;
constexpr size_t WS_WXKV = WS_WXQ + 2097152;
constexpr size_t WS_WXO  = WS_WXKV + 4194304;
constexpr size_t WS_Z    = WS_WXO + 2097152;
constexpr size_t SZ_Z    = (size_t)MTOK * ZW * 2;
constexpr size_t WS_SM   = WS_Z + SZ_Z;
constexpr size_t WS_H    = WS_SM + (size_t)MTOK * 32 * 4;
constexpr size_t WS_DNP  = WS_H + (size_t)MTOK * DM * 2;
constexpr size_t DN_ITEM = 73728;
constexpr size_t WS_GLP  = WS_DNP + DN_ITEM * 2048;
constexpr size_t GL_ITEM = 74240;
constexpr size_t WS_MISC = WS_GLP + GL_ITEM * 1024;
constexpr size_t WS_BAR  = WS_MISC + 16384;
constexpr size_t WS_XS   = WS_MISC + 65536;
constexpr size_t WS_END  = WS_XS + (size_t)MTOK * DM * 2;

struct Params { const float* in[35]; float* out; unsigned char* ws; };
typedef const __attribute__((address_space(4))) Params* PPtr;
__device__ __forceinline__ int fresh_tid(int) {
    int hw = __builtin_amdgcn_s_getreg(10244) & 63; asm volatile("" : "+s"(hw));
    const int w = __builtin_amdgcn_readfirstlane(*(const volatile LAS int*)((LAS unsigned char*)nullptr + 131072 + hw * 4));
    unsigned z0_; asm volatile("s_mov_b32 %0, 0" : "=s"(z0_));
    const int ln = __builtin_amdgcn_mbcnt_hi(~0u, __builtin_amdgcn_mbcnt_lo(~0u, z0_)); int t = w * 64 + ln; asm volatile("" : "+v"(t)); return t; }
__device__ __forceinline__ int fresh_bid() { int b = blockIdx.x; asm volatile("" : "+s"(b)); return b; }
__device__ __forceinline__ int fresh_gdim() { int b = gridDim.x; asm volatile("" : "+s"(b)); return b; }
__device__ __forceinline__ PPtr PP() { auto kp = __builtin_amdgcn_kernarg_segment_ptr(); asm volatile("" : "+s"(kp)); return (PPtr)kp; }

__device__ __forceinline__ float bf2f(bf16_t v) { return __uint_as_float(((unsigned)v) << 16); }
typedef float f32x2_t __attribute__((ext_vector_type(2)));
typedef __bf16 bf16x2_t __attribute__((ext_vector_type(2)));
__device__ __forceinline__ unsigned pk_bf16(float lo, float hi) { const f32x2_t v = {lo, hi}; const bf16x2_t b = __builtin_convertvector(v, bf16x2_t); return __builtin_bit_cast(unsigned, b); }
__device__ __forceinline__ bf16_t f2bf(float f) { return (bf16_t)(pk_bf16(f, 0.f) & 0xffffu); }
__device__ __forceinline__ float sigmoidf_(float x) { return 1.f / (1.f + __expf(-x)); }
__device__ __forceinline__ float siluf_(float x) { return x * sigmoidf_(x); }
__device__ __forceinline__ float geluf_(float x) { const float u = 1.5957691216057308f * (x + 0.044715f * x * x * x); return x * sigmoidf_(u); }
__device__ __forceinline__ float softplusf_(float x) { return x > 20.f ? x : log1pf(__expf(x)); }
__device__ __forceinline__ float shx(float v, int mask, int lane) { return __int_as_float(__builtin_amdgcn_ds_bpermute((lane ^ mask) << 2, __float_as_int(v))); }
__device__ __forceinline__ float shup(float v, int delta, int lane) { return __int_as_float(__builtin_amdgcn_ds_bpermute((lane - delta) << 2, __float_as_int(v))); }
__device__ __forceinline__ float lo_bf(unsigned w) { return __uint_as_float(w << 16); }
__device__ __forceinline__ float hi_bf(unsigned w) { return __uint_as_float(w & 0xffff0000u); }
__device__ __forceinline__ f32x4 mfma16(bf16x8 a, bf16x8 b, f32x4 c) { return __builtin_amdgcn_mfma_f32_16x16x32_bf16(a, b, c, 0, 0, 0); }

__device__ __forceinline__ void gsync(cg::grid_group& grid) {
    __builtin_amdgcn_fence(__ATOMIC_RELEASE, "agent");
    asm volatile("s_waitcnt vmcnt(0) lgkmcnt(0)" ::: "memory");
    grid.sync();
    __builtin_amdgcn_fence(__ATOMIC_ACQUIRE, "agent");
    asm volatile("s_waitcnt vmcnt(0)" ::: "memory");
#ifdef EXTRA_SYNC
    __builtin_amdgcn_fence(__ATOMIC_RELEASE, "agent");
    asm volatile("s_waitcnt vmcnt(0) lgkmcnt(0)" ::: "memory");
    grid.sync();
    __builtin_amdgcn_fence(__ATOMIC_ACQUIRE, "agent");
    asm volatile("s_waitcnt vmcnt(0)" ::: "memory");
#endif
}


#define XB_TMO      128
#define XB_XCNT(j)  (256  + 64 * (j))
#define XB_XSUB(j)  (1280 + 64 * (j))
#define XB_XGEN(j)  (2304 + 64 * (j))
#define XB_TOP      3328
#define XB_TOPGEN   3392
#define XCD_BAR_WORDS 3456
#define XB_SPIN_CAP (1u << 20)
constexpr int XB_LDS_OFF = 131072 + 256;
__device__ __forceinline__ unsigned xb_ld(unsigned* p)              { return __hip_atomic_load(p, __ATOMIC_RELAXED, __HIP_MEMORY_SCOPE_AGENT); }
__device__ __forceinline__ unsigned xb_add(unsigned* p, unsigned v) { return __hip_atomic_fetch_add(p, v, __ATOMIC_RELAXED, __HIP_MEMORY_SCOPE_AGENT); }
__device__ __forceinline__ unsigned xb_xcc_id() { return (unsigned)__builtin_amdgcn_s_getreg((3 << 11) | 20) & 0xFu; }
#define XB_SPIN(cond, bar) do { unsigned _sp = 0; while (cond) { __builtin_amdgcn_s_sleep(16);   \
    if ((++_sp & 255u) == 0u) { if (xb_ld(&(bar)[XB_TMO])) break; if (_sp > XB_SPIN_CAP) { atomicAdd(&(bar)[XB_TMO], 1u); break; } } } } while (0)
__device__ __forceinline__ void xcd_barrier_complete(unsigned* bar, unsigned x, unsigned& nloc, unsigned& nx) {
    const unsigned G = gridDim.x;
    unsigned sum, cnt, mine, sp = 0u;
    for (;;) {
        sum = 0u; cnt = 0u; mine = 0u;
#pragma unroll
        for (unsigned j = 0; j < 16; ++j) { const unsigned c = xb_ld(&bar[XB_XCNT(j)]); sum += c; cnt += (c > 0u) ? 1u : 0u; mine = (j == x) ? c : mine; }
        if (sum == G) break;
        __builtin_amdgcn_s_sleep(1);
        if ((++sp & 255u) == 0u) { if (xb_ld(&bar[XB_TMO])) break; if (sp > XB_SPIN_CAP) { atomicAdd(&bar[XB_TMO], 1u); break; } }
    }
    nloc = mine > 0u ? mine : 1u; nx = cnt > 0u ? cnt : 1u;
}
__device__ __forceinline__ void xbar(const int wid_s) {
    asm volatile("s_waitcnt vmcnt(0)" ::: "memory");
    __syncthreads();
    unsigned* bar = (unsigned*)(PP()->ws + WS_BAR);
    if (fresh_tid(wid_s) == 0) {
        volatile LAS unsigned* st = (volatile LAS unsigned*)((LAS unsigned char*)nullptr + XB_LDS_OFF);
        const unsigned x = xb_xcc_id();
        __builtin_amdgcn_s_waitcnt(0);
        unsigned nloc = st[0], nx = st[1];
        if (nloc == 0u) { xcd_barrier_complete(bar, x, nloc, nx); st[0] = nloc; st[1] = nx; }
        const unsigned old = xb_add(&bar[XB_XSUB(x)], 1u);
        const unsigned gen = old / nloc;
        if (old + 1u == (gen + 1u) * nloc) {
            __builtin_amdgcn_fence(__ATOMIC_RELEASE, "agent");
            asm volatile("s_waitcnt vmcnt(0)" ::: "memory");
            const unsigned og = xb_add(&bar[XB_TOP], 1u);
            const unsigned tg = og / nx;
            if (og + 1u == (tg + 1u) * nx) xb_add(&bar[XB_TOPGEN], 1u);
            else XB_SPIN(xb_ld(&bar[XB_TOPGEN]) == tg, bar);
            __builtin_amdgcn_fence(__ATOMIC_ACQUIRE, "agent");
            xb_add(&bar[XB_XGEN(x)], 1u);
            asm volatile("s_waitcnt vmcnt(0)" ::: "memory");
        } else {
            XB_SPIN(xb_ld(&bar[XB_XGEN(x)]) == gen, bar);
            __builtin_amdgcn_fence(__ATOMIC_ACQUIRE, "agent");
            asm volatile("s_waitcnt vmcnt(0)" ::: "memory");
        }
    }
    __syncthreads();
}

constexpr int BM = 256, BK = 64, HALF = 128, HTB = HALF * BK * 2, STAGE_BYTES = 8 * HTB, NXCD = 8, WGM = 8;
__device__ __forceinline__ int lds_byte(int r, int c) { const int st = (r >> 4) * 2 + (c >> 5), rr = r & 15, cc = c & 31, ob = rr * 64 + cc * 2; return st * 1024 + (ob ^ (((ob >> 9) & 1) << 5)); }
__device__ __forceinline__ void stage_rc(int b, int& R, int& C) { const int st = b / 1024, sb = b % 1024, swz = sb ^ (((sb >> 9) & 1) << 5); R = (st >> 1) * 16 + swz / 64; C = (st & 1) * 32 + (swz % 64) / 2; }
__device__ __forceinline__ int perm32(int rho) { const int n = rho >> 4, i = rho & 15; return 8 * (i >> 2) + 4 * n + (i & 3); }
struct Unit { int pm, pn; };
struct Gemm { const bf16_t* A; const bf16_t* Bt; int M, N, K, lda; };
struct StaticOrder {
    int nM, nN, nwg, G, c;
    __device__ void init(int M, int N, int G_, int c_) { nM = M / BM; nN = N / BM; nwg = nM * nN; G = G_; c = c_; }
    __device__ bool next(int i, Unit& u) const {
        const long L = (long)i * G + c; if (L >= nwg) return false;
        int wgid = (int)L; { const int q = nwg / NXCD, r = nwg % NXCD, xcd = wgid % NXCD, off = wgid / NXCD; wgid = (xcd < r ? xcd * (q + 1) : r * (q + 1) + (xcd - r) * q) + off; }
        const int nig = WGM * nN, gid = wgid / nig, fm = gid * WGM, gsz = (nM - fm) < WGM ? (nM - fm) : WGM;
        u.pm = fm + ((wgid % nig) % gsz); u.pn = (wgid % nig) / gsz; return true;
    }
};

template <class Epi>
__device__ __forceinline__ void gemm_phase(LAS unsigned char* lds, const Gemm g, const StaticOrder& S, const Epi& E, const int wid_s) {
    const int tid = fresh_tid(wid_s), wid = __builtin_amdgcn_readfirstlane(tid >> 6), lane = tid & 63, wr = wid >> 2, wc = wid & 3, fr = lane & 15, fq = lane >> 4;
    const int K = g.K, nt = K / BK, lda = g.lda;
    unsigned voffA[2], voffB[2];
#pragma unroll
    for (int i = 0; i < 2; ++i) { int R, C; stage_rc(tid * 16 + i * 8192, R, C); const int Rb = Epi::PERM ? ((R & ~31) + perm32(R & 31)) : R; voffA[i] = (unsigned)(R * lda + C) * 2u; voffB[i] = (unsigned)(Rb * K + C) * 2u; }
    const size_t kstep = (size_t)(BK * 2);
    const size_t hstepA = (size_t)HALF * lda * 2, hstepB = (size_t)HALF * K * 2;
    const size_t tstepA = 2 * hstepA, tstepB = 2 * hstepB;
    const unsigned ldsw = (unsigned)wid * 1024u;
    const int aoff = lds_byte(wr * 64 + fr, fq * 8), boff = lds_byte(wc * 32 + fr, fq * 8);
#define PG8_SA(b, h) (((b) * 2 + (h)) * HTB)
#define PG8_SB(b, h) ((4 + (b) * 2 + (h)) * HTB)
#define PG8_STAGE(bufoff, gbase, voff) do { _Pragma("unroll") for (int _i = 0; _i < 2; ++_i) \
        __builtin_amdgcn_global_load_lds((const unsigned*)((const char*)(gbase) + (voff)[_i]), (LAS unsigned*)(lds + (bufoff) + ldsw + _i * 8192), 16, 0, 0); } while (0)
#define PG8_LDA(dst, b, h) do { _Pragma("unroll") for (int m = 0; m < 4; ++m) _Pragma("unroll") for (int k = 0; k < 2; ++k) dst[m][k] = *(const LAS bf16x8*)(lds + PG8_SA(b, h) + aoff + m * 2048 + k * 1024); } while (0)
#define PG8_LDB(dst, b, h) do { _Pragma("unroll") for (int n = 0; n < 2; ++n) _Pragma("unroll") for (int k = 0; k < 2; ++k) dst[n][k] = *(const LAS bf16x8*)(lds + PG8_SB(b, h) + boff + n * 2048 + k * 1024); } while (0)
#define PG8_MMA(ai, bj, At, Bt) do { __builtin_amdgcn_s_setprio(1); _Pragma("unroll") for (int m = 0; m < 4; ++m) _Pragma("unroll") for (int n = 0; n < 2; ++n) _Pragma("unroll") for (int k = 0; k < 2; ++k) \
        acc[ai][bj][m][n] = __builtin_amdgcn_mfma_f32_16x16x32_bf16(Bt[n][k], At[m][k], acc[ai][bj][m][n], 0, 0, 0); __builtin_amdgcn_s_setprio(0); } while (0)
#define PG8_WAIT_V(n) asm volatile("s_waitcnt vmcnt(" #n ")" ::: "memory")
#define PG8_WAIT_L(n) asm volatile("s_waitcnt lgkmcnt(" #n ")" ::: "memory")
#define PG8_BAR __builtin_amdgcn_s_barrier()
#define PG8_SCHED __builtin_amdgcn_sched_barrier(0)
    Unit cur, nxt; int ui = 0;
    if (!S.next(0, cur)) return;
    f32x4 acc[2][2][4][2];
#pragma unroll
    for (int a = 0; a < 2; ++a)
#pragma unroll
        for (int b = 0; b < 2; ++b)
#pragma unroll
            for (int m = 0; m < 4; ++m)
#pragma unroll
                for (int n = 0; n < 2; ++n) acc[a][b][m][n] = (f32x4){0.f, 0.f, 0.f, 0.f};
    bf16x8 At[4][2], B0[2][2], B1[2][2];
    const char* cA = (const char*)g.A + (size_t)cur.pm * tstepA; const char* cB = (const char*)g.Bt + (size_t)cur.pn * tstepB;
    PG8_STAGE(PG8_SB(0, 0), cB, voffB); PG8_STAGE(PG8_SA(0, 0), cA, voffA); PG8_STAGE(PG8_SB(0, 1), cB + hstepB, voffB); PG8_STAGE(PG8_SA(0, 1), cA + hstepA, voffA);
    if (wr == 1) PG8_BAR;
    PG8_WAIT_V(4); PG8_BAR;
    PG8_STAGE(PG8_SB(1, 0), cB + kstep, voffB); PG8_STAGE(PG8_SA(1, 0), cA + kstep, voffA); PG8_STAGE(PG8_SB(1, 1), cB + hstepB + kstep, voffB);
    PG8_WAIT_V(6); PG8_BAR;
    for (;;) {
        const bool has_next = S.next(ui + 1, nxt);
        const char* nA = has_next ? (const char*)g.A + (size_t)nxt.pm * tstepA : cA; const char* nB = has_next ? (const char*)g.Bt + (size_t)nxt.pn * tstepB : cB;
        for (int t = 0; t < nt; t += 2) {
            const bool last = (t == nt - 2);
            const char* a1 = cA + (size_t)(t + 1) * kstep;
            const char* a2 = last ? nA : cA + (size_t)(t + 2) * kstep; const char* b2 = last ? nB : cB + (size_t)(t + 2) * kstep;
            const char* a3 = a2 + kstep; const char* b3 = b2 + kstep;
            PG8_LDB(B0, 0, 0); PG8_SCHED; PG8_LDA(At, 0, 0); PG8_STAGE(PG8_SA(1, 1), a1 + hstepA, voffA);
            PG8_WAIT_L(8); PG8_BAR; PG8_WAIT_L(0); PG8_MMA(0, 0, At, B0); PG8_BAR; PG8_SCHED;
            PG8_LDB(B1, 0, 1); PG8_STAGE(PG8_SB(0, 0), b2, voffB);
            PG8_BAR; PG8_WAIT_L(0); PG8_MMA(0, 1, At, B1); PG8_BAR;
            PG8_LDA(At, 0, 1); PG8_STAGE(PG8_SA(0, 0), a2, voffA);
            PG8_BAR; PG8_WAIT_L(0); PG8_MMA(1, 0, At, B0); PG8_BAR; PG8_SCHED;
            PG8_STAGE(PG8_SB(0, 1), b2 + hstepB, voffB);
            PG8_WAIT_V(6); PG8_BAR; PG8_MMA(1, 1, At, B1); PG8_BAR;
            PG8_LDB(B0, 1, 0); PG8_SCHED; PG8_LDA(At, 1, 0); PG8_STAGE(PG8_SA(0, 1), a2 + hstepA, voffA);
            PG8_WAIT_L(8); PG8_BAR; PG8_WAIT_L(0); PG8_MMA(0, 0, At, B0); PG8_BAR; PG8_SCHED;
            PG8_LDB(B1, 1, 1); PG8_STAGE(PG8_SB(1, 0), b3, voffB);
            PG8_BAR; PG8_WAIT_L(0); PG8_MMA(0, 1, At, B1); PG8_BAR;
            PG8_LDA(At, 1, 1); PG8_STAGE(PG8_SA(1, 0), a3, voffA);
            PG8_BAR; PG8_WAIT_L(0); PG8_MMA(1, 0, At, B0); PG8_BAR; PG8_SCHED;
            PG8_STAGE(PG8_SB(1, 1), b3 + hstepB, voffB);
            PG8_WAIT_V(6); PG8_BAR; PG8_MMA(1, 1, At, B1); PG8_BAR;
        }
        E(acc, cur, wr, wc, fr, fq);
        if (!has_next) break;
#pragma unroll
        for (int a = 0; a < 2; ++a)
#pragma unroll
            for (int b = 0; b < 2; ++b)
#pragma unroll
                for (int m = 0; m < 4; ++m)
#pragma unroll
                    for (int n = 0; n < 2; ++n) acc[a][b][m][n] = (f32x4){0.f, 0.f, 0.f, 0.f};
        cur = nxt; cA = nA; cB = nB; ++ui;
    }
    PG8_WAIT_V(0);
    if (wr == 0) PG8_BAR;
    PG8_BAR;
#undef PG8_SA
#undef PG8_SB
#undef PG8_STAGE
#undef PG8_LDA
#undef PG8_LDB
#undef PG8_MMA
#undef PG8_WAIT_V
#undef PG8_WAIT_L
#undef PG8_BAR
#undef PG8_SCHED
}

typedef const f32x4 (&AccRef)[2][2][4][2];
__device__ __forceinline__ u32x2 pk4(f32x4 v) { u32x2 r; r.x = pk_bf16(v[0], v[1]); r.y = pk_bf16(v[2], v[3]); return r; }
__device__ __forceinline__ f32x4 ld_bf4(const bf16_t* p) { const u32x2 w = *(const u32x2*)p; return (f32x4){lo_bf(w.x), hi_bf(w.x), lo_bf(w.y), hi_bf(w.y)}; }
__device__ __forceinline__ f32x4 sig4(f32x4 v) { return (f32x4){sigmoidf_(v[0]), sigmoidf_(v[1]), sigmoidf_(v[2]), sigmoidf_(v[3])}; }

struct EpiZ { static constexpr bool PERM = true; bf16_t* Z; float* SMp;
    __device__ __forceinline__ void operator()(AccRef acc, const Unit& u, int wr, int wc, int fr, int fq) const {
        const int row0 = u.pm * BM + wr * 64 + fr;
        if (u.pn < 56) {
#pragma unroll
            for (int ai = 0; ai < 2; ++ai)
#pragma unroll
                for (int m = 0; m < 4; ++m) { bf16_t* rp = Z + (size_t)(row0 + ai * HALF + m * 16) * ZW + u.pn * BM + wc * 32 + 8 * fq;
#pragma unroll
                    for (int bj = 0; bj < 2; ++bj) { const u32x2 lo = pk4(acc[ai][bj][m][0]), hi = pk4(acc[ai][bj][m][1]); *(u32x4*)(rp + bj * HALF) = (u32x4){lo.x, lo.y, hi.x, hi.y}; } }
        } else if (wc == 0) {
#pragma unroll
            for (int ai = 0; ai < 2; ++ai)
#pragma unroll
                for (int m = 0; m < 4; ++m) { float* rp = SMp + (size_t)(row0 + ai * HALF + m * 16) * 32 + 8 * fq;
#pragma unroll
                    for (int n = 0; n < 2; ++n) *(f32x4*)(rp + n * 4) = acc[ai][0][m][n]; }
        }
    }
};
struct EpiF32 { static constexpr bool PERM = false; float* C; int ldc;
    __device__ __forceinline__ void operator()(AccRef acc, const Unit& u, int wr, int wc, int fr, int fq) const {
        const int row0 = u.pm * BM + wr * 64 + fr, col0 = u.pn * BM + wc * 32 + 4 * fq;
#pragma unroll
        for (int ai = 0; ai < 2; ++ai)
#pragma unroll
            for (int m = 0; m < 4; ++m) { float* rp = C + (size_t)(row0 + ai * HALF + m * 16) * ldc + col0;
#pragma unroll
                for (int bj = 0; bj < 2; ++bj)
#pragma unroll
                    for (int n = 0; n < 2; ++n) *(f32x4*)(rp + bj * HALF + n * 16) = acc[ai][bj][m][n]; }
    }
};
struct EpiBf16 { static constexpr bool PERM = true; bf16_t* C; int ldc;
    __device__ __forceinline__ void operator()(AccRef acc, const Unit& u, int wr, int wc, int fr, int fq) const {
        const int row0 = u.pm * BM + wr * 64 + fr, col0 = u.pn * BM + wc * 32 + 8 * fq;
#pragma unroll
        for (int ai = 0; ai < 2; ++ai)
#pragma unroll
            for (int m = 0; m < 4; ++m) { bf16_t* rp = C + (size_t)(row0 + ai * HALF + m * 16) * ldc + col0;
#pragma unroll
                for (int bj = 0; bj < 2; ++bj) { const u32x2 lo = pk4(acc[ai][bj][m][0]), hi = pk4(acc[ai][bj][m][1]); *(u32x4*)(rp + bj * HALF) = (u32x4){lo.x, lo.y, hi.x, hi.y}; } }
    }
};
__device__ __forceinline__ void ld_bf8(const bf16_t* p, f32x4& lo, f32x4& hi) { const u32x4 w = *(const u32x4*)p; lo = (f32x4){lo_bf(w.x), hi_bf(w.x), lo_bf(w.y), hi_bf(w.y)}; hi = (f32x4){lo_bf(w.z), hi_bf(w.z), lo_bf(w.w), hi_bf(w.w)}; }
__device__ __forceinline__ void st_bf8(bf16_t* p, f32x4 lo, f32x4 hi) { const u32x2 a = pk4(lo), b = pk4(hi); *(u32x4*)p = (u32x4){a.x, a.y, b.x, b.y}; }
struct EpiGLU { static constexpr bool PERM = true; const bf16_t* Z; bf16_t* MRG;
    __device__ __forceinline__ void operator()(AccRef acc, const Unit& u, int wr, int wc, int fr, int fq) const {
        const int row0 = u.pm * BM + wr * 64 + fr, oc = u.pn * HALF + wc * 32 + 8 * fq;
#pragma unroll
        for (int ai = 0; ai < 2; ++ai)
#pragma unroll
            for (int m = 0; m < 4; ++m) { const int row = row0 + ai * HALF + m * 16;
                f32x4 g0, g1; ld_bf8(Z + (size_t)row * ZW + GT + 4096 + oc, g0, g1);
                st_bf8(MRG + (size_t)row * DM + oc, sig4(g0) * acc[ai][0][m][0] * sig4(acc[ai][1][m][0]), sig4(g1) * acc[ai][0][m][1] * sig4(acc[ai][1][m][1])); }
    }
};
template <bool FINAL> struct EpiAcc { static constexpr bool PERM = true; const bf16_t* Z; bf16_t* MRG; bf16_t* MB; int goff;
    __device__ __forceinline__ void operator()(AccRef acc, const Unit& u, int wr, int wc, int fr, int fq) const {
        const int row0 = u.pm * BM + wr * 64 + fr, col0 = u.pn * BM + wc * 32 + 8 * fq;
#pragma unroll
        for (int ai = 0; ai < 2; ++ai)
#pragma unroll
            for (int m = 0; m < 4; ++m) { const int row = row0 + ai * HALF + m * 16;
#pragma unroll
                for (int bj = 0; bj < 2; ++bj) { const int c = col0 + bj * HALF;
                    f32x4 g0, g1, m0, m1; ld_bf8(Z + (size_t)row * ZW + GT + goff + c, g0, g1); ld_bf8(MRG + (size_t)row * DM + c, m0, m1);
                    st_bf8((FINAL ? MB : MRG) + (size_t)row * DM + c, m0 + sig4(g0) * acc[ai][bj][m][0], m1 + sig4(g1) * acc[ai][bj][m][1]); } }
    }
};
struct EpiKV { static constexpr bool PERM = false; bf16_t* Kb; bf16_t* VT;
    __device__ __forceinline__ void operator()(AccRef acc, const Unit& u, int wr, int wc, int fr, int fq) const {
        const int row0 = u.pm * BM + wr * 64 + fr, col0 = u.pn * BM + wc * 32 + 4 * fq;
#pragma unroll
        for (int ai = 0; ai < 2; ++ai)
#pragma unroll
            for (int m = 0; m < 4; ++m) { const int row = row0 + ai * HALF + m * 16;
#pragma unroll
                for (int bj = 0; bj < 2; ++bj)
#pragma unroll
                    for (int n = 0; n < 2; ++n) { const int c = col0 + bj * HALF + n * 16; const f32x4 v = acc[ai][bj][m][n];
                        if (c < 512) *(u32x2*)(Kb + (size_t)row * 512 + c) = pk4(v);
                        else { const int cc = c - 512, b = row >> 8, key = row & 255;
#pragma unroll
                            for (int i = 0; i < 4; ++i) VT[((size_t)(b * 4 + ((cc + i) >> 7)) * 128 + ((cc + i) & 127)) * 256 + key] = f2bf(v[i]); } } }
    }
};
__device__ __forceinline__ float dpp_ror1(float v) { return __int_as_float(__builtin_amdgcn_update_dpp(0, __float_as_int(v), 0x121, 0xF, 0xF, false)); }
__device__ __forceinline__ float dpp_ror2(float v) { return __int_as_float(__builtin_amdgcn_update_dpp(0, __float_as_int(v), 0x122, 0xF, 0xF, false)); }
struct EpiFFN { static constexpr bool PERM = true; bf16_t* ACT; bf16_t* GB; bf16_t* UB; const float* cw;
    __device__ __forceinline__ void operator()(AccRef acc, const Unit& u, int wr, int wc, int fr, int fq) const {
        const int oc = u.pn * HALF + wc * 32 + 8 * fq;
#pragma unroll
        for (int ai = 0; ai < 2; ++ai) {
            const int rowb = u.pm * BM + ai * HALF + wr * 64;
            u32x2 pk0[4];
#pragma unroll
            for (int n = 0; n < 2; ++n) {
                const f32x4 wa = *(const f32x4*)(cw + (oc + 4 * n) * 3), wb = *(const f32x4*)(cw + (oc + 4 * n) * 3 + 4), wcc = *(const f32x4*)(cw + (oc + 4 * n) * 3 + 8);
                const float w0[4] = {wa[0], wa[3], wb[2], wcc[1]}, w1[4] = {wa[1], wb[0], wb[3], wcc[2]}, w2[4] = {wa[2], wb[1], wcc[0], wcc[3]};
                f32x4 v1 = {0.f, 0.f, 0.f, 0.f}, v2 = {0.f, 0.f, 0.f, 0.f};
#pragma unroll
                for (int m = 0; m < 4; ++m) {
                    f32x4 c1, c2, r;
#pragma unroll
                    for (int c = 0; c < 4; ++c) { c1[c] = dpp_ror1(acc[ai][0][m][n][c]); c2[c] = dpp_ror2(acc[ai][0][m][n][c]); }
#pragma unroll
                    for (int c = 0; c < 4; ++c) {
                        const float g = acc[ai][0][m][n][c], up = acc[ai][1][m][n][c];
                        const float q1 = (m == 0 || fr >= 1) ? c1[c] : v1[c];
                        const float q2 = (m == 0 || fr >= 2) ? c2[c] : v2[c];
                        r[c] = geluf_(w0[c] * q2 + w1[c] * q1 + w2[c] * g) * up;
                    }
                    v1 = c1; v2 = c2;
                    const u32x2 pr = pk4(r);
                    if (n == 0) pk0[m] = pr;
                    else { const int row = rowb + m * 16 + fr; if (m > 0 || fr >= 2) *(u32x4*)(ACT + (size_t)row * FF + oc) = (u32x4){pk0[m].x, pk0[m].y, pr.x, pr.y}; }
                    __builtin_amdgcn_sched_barrier(0);
                }
            }
            if (fr < 2) { st_bf8(GB + (size_t)((rowb >> 6) * 4 + 2 + fr) * FF + oc, acc[ai][0][0][0], acc[ai][0][0][1]); st_bf8(UB + (size_t)((rowb >> 6) * 2 + fr) * FF + oc, acc[ai][1][0][0], acc[ai][1][0][1]); }
            if (fr >= 14) st_bf8(GB + (size_t)((rowb >> 6) * 4 + (fr - 14)) * FF + oc, acc[ai][0][3][0], acc[ai][0][3][1]);
            __builtin_amdgcn_sched_barrier(0);
        }
    }
};

template <class Epi> __device__ __forceinline__ void run_gemm(LAS unsigned char* lds, const bf16_t* A, int lda, const bf16_t* Bt, int M, int N, int K, const Epi& E, const int wid_s, int shift = 0) {
    Gemm g; g.A = A; g.Bt = Bt; g.M = M; g.N = N; g.K = K; g.lda = lda;
    StaticOrder S; S.init(M, N, (int)fresh_gdim(), (int)((fresh_bid() + fresh_gdim() - shift) % fresh_gdim()));
    gemm_phase<Epi>(lds, g, S, E, wid_s);
}

__device__ __forceinline__ int src_col(int kind, int n) {
    if (kind == 0) return n;
    if (kind == 1) {
        if (n < 4096) return n;
        if (n < 6144) return n + 16;
        if (n < 14336) return n + 32;
        if (n < 14352) return n - 14336 + 4096;
        if (n < 14368) return n - 14352 + 6160;
        return -1;
    }
    if (kind == 2) { const int un = n >> 8, r = n & 255; return r < 128 ? un * 128 + r : 2048 + un * 128 + (r - 128); }
    { const int un = n >> 8, r = n & 255; return r < 128 ? un * 128 + r : FF + un * 128 + (r - 128); }
}
__device__ void convert_w(LAS float* ldsf, const float* __restrict__ W, bf16_t* __restrict__ Wt, int K, int Nsrc, int Ndst, int kind, const int wid_s, int nb = 0, int bi = 0) {
    const int t = fresh_tid(wid_s), ntn = Ndst >> 6, ntiles = ntn * (K >> 6);
    const int nn = t & 63, kq = t >> 6, row = t >> 3, seg = (t & 7) * 8;
    const int g = nb > 0 ? nb : fresh_gdim();
    int tile = nb > 0 ? bi : fresh_bid();
    float v[8];
    auto ld = [&](int tl) __attribute__((always_inline)) {
        const int n0 = (tl % ntn) << 6, k0 = (tl / ntn) << 6;
        const int sc = src_col(kind, n0 + nn);
#pragma unroll
        for (int i = 0; i < 8; ++i) v[i] = sc >= 0 ? W[(size_t)(k0 + kq + 8 * i) * Nsrc + sc] : 0.f;
    };
    if (tile < ntiles) ld(tile);
    for (; tile < ntiles; tile += g) {
        const int n0 = (tile % ntn) << 6, k0 = (tile / ntn) << 6;
#pragma unroll
        for (int i = 0; i < 8; ++i) ldsf[nn * 65 + kq + 8 * i] = v[i];
        __syncthreads();
        if (tile + g < ntiles) ld(tile + g);
        float o8[8];
#pragma unroll
        for (int j = 0; j < 8; ++j) o8[j] = ldsf[row * 65 + seg + j];
        u32x4 o; o.x = pk_bf16(o8[0], o8[1]); o.y = pk_bf16(o8[2], o8[3]); o.z = pk_bf16(o8[4], o8[5]); o.w = pk_bf16(o8[6], o8[7]);
        *(u32x4*)(Wt + (size_t)(n0 + row) * K + k0 + seg) = o;
        __syncthreads();
    }
}

__device__ __forceinline__ float wave_sum(float v, int lane) {
#pragma unroll
    for (int o = 32; o >= 1; o >>= 1) v += shx(v, o, lane);
    return v;
}
__device__ void norm_rows_f(const float* xin_f, bf16_t* xout_b, const float* gpre, bf16_t* hout, int nrows, const int wid_s) {
    const int t_ = fresh_tid(wid_s); const int lane = t_ & 63, gw = fresh_bid() * 8 + (t_ >> 6), nw = fresh_gdim() * 8;
    for (int row = gw; row < nrows; row += nw) {
        f32x4 v[8];
        const float* xr = xin_f + (size_t)row * DM;
#pragma unroll
        for (int i = 0; i < 8; ++i) v[i] = *(const f32x4*)(xr + (i * 64 + lane) * 4);
        if (xout_b) {
            bf16_t* xo = xout_b + (size_t)row * DM;
#pragma unroll
            for (int i = 0; i < 8; ++i) *(u32x2*)(xo + (i * 64 + lane) * 4) = pk4(v[i]);
        }
        float ss = 0.f;
#pragma unroll
        for (int i = 0; i < 8; ++i) ss += v[i][0] * v[i][0] + v[i][1] * v[i][1] + v[i][2] * v[i][2] + v[i][3] * v[i][3];
        ss = wave_sum(ss, lane);
        const float inv = rsqrtf(ss * (1.f / DM) + EPS);
        bf16_t* ho = hout + (size_t)row * DM;
#pragma unroll
        for (int i = 0; i < 8; ++i) { const f32x4 gp = *(const f32x4*)(gpre + (i * 64 + lane) * 4); *(u32x2*)(ho + (i * 64 + lane) * 4) = pk4(v[i] * inv * gp); }
    }
}
__device__ __forceinline__ void norm_rows(const bf16_t* xin_b, const bf16_t* y, const float* gpost, float* xout_f, bf16_t* xout_b, const float* gpre, bf16_t* hout, int nrows, const int wid_s) {
    const int t_ = fresh_tid(wid_s); const int lane = t_ & 63, gw = fresh_bid() * 8 + (t_ >> 6), nw = fresh_gdim() * 8;
    u32x4 rx[4], ry[4];
    auto ldrow = [&](int row) __attribute__((always_inline)) {
#pragma unroll
        for (int i = 0; i < 4; ++i) { rx[i] = *(const u32x4*)(xin_b + (size_t)row * DM + (i * 64 + lane) * 8); ry[i] = *(const u32x4*)(y + (size_t)row * DM + (i * 64 + lane) * 8); }
    };
    if (gw < nrows) ldrow(gw);
    for (int row = gw; row < nrows; row += nw) {
        f32x4 v[8], yv[8];
#pragma unroll
        for (int i = 0; i < 4; ++i) {
            v[2 * i] = (f32x4){lo_bf(rx[i].x), hi_bf(rx[i].x), lo_bf(rx[i].y), hi_bf(rx[i].y)}; v[2 * i + 1] = (f32x4){lo_bf(rx[i].z), hi_bf(rx[i].z), lo_bf(rx[i].w), hi_bf(rx[i].w)};
            yv[2 * i] = (f32x4){lo_bf(ry[i].x), hi_bf(ry[i].x), lo_bf(ry[i].y), hi_bf(ry[i].y)}; yv[2 * i + 1] = (f32x4){lo_bf(ry[i].z), hi_bf(ry[i].z), lo_bf(ry[i].w), hi_bf(ry[i].w)};
        }
        if (row + nw < nrows) ldrow(row + nw);
        float ss = 0.f;
#pragma unroll
        for (int i = 0; i < 8; ++i) ss += yv[i][0] * yv[i][0] + yv[i][1] * yv[i][1] + yv[i][2] * yv[i][2] + yv[i][3] * yv[i][3];
        ss = wave_sum(ss, lane);
        const float inv = rsqrtf(ss * (1.f / DM) + EPS);
#pragma unroll
        for (int i = 0; i < 4; ++i) {
            const f32x4 g0 = *(const f32x4*)(gpost + (i * 64 + lane) * 8), g1 = *(const f32x4*)(gpost + (i * 64 + lane) * 8 + 4);
            v[2 * i] += yv[2 * i] * inv * g0; v[2 * i + 1] += yv[2 * i + 1] * inv * g1;
        }
        if (xout_f) {
            float* xo = xout_f + (size_t)row * DM;
#pragma unroll
            for (int i = 0; i < 4; ++i) { *(f32x4*)(xo + (i * 64 + lane) * 8) = v[2 * i]; *(f32x4*)(xo + (i * 64 + lane) * 8 + 4) = v[2 * i + 1]; }
        }
        if (xout_b) {
            bf16_t* xo = xout_b + (size_t)row * DM;
#pragma unroll
            for (int i = 0; i < 4; ++i) st_bf8(xo + (i * 64 + lane) * 8, v[2 * i], v[2 * i + 1]);
        }
        if (hout) {
            float s2 = 0.f;
#pragma unroll
            for (int i = 0; i < 8; ++i) s2 += v[i][0] * v[i][0] + v[i][1] * v[i][1] + v[i][2] * v[i][2] + v[i][3] * v[i][3];
            s2 = wave_sum(s2, lane);
            const float inv2 = rsqrtf(s2 * (1.f / DM) + EPS);
            bf16_t* ho = hout + (size_t)row * DM;
#pragma unroll
            for (int i = 0; i < 4; ++i) {
                const f32x4 g0 = *(const f32x4*)(gpre + (i * 64 + lane) * 8), g1 = *(const f32x4*)(gpre + (i * 64 + lane) * 8 + 4);
                st_bf8(ho + (i * 64 + lane) * 8, v[2 * i] * inv2 * g0, v[2 * i + 1] * inv2 * g1);
            }
        }
    }
}

__device__ void dn_prep(LAS unsigned char* lds, PPtr p, int layer, const int wid_s) {
    const int t = fresh_tid(wid_s), wv = t >> 6, lane = t & 63, fr = lane & 15, fq = lane >> 4;
    LAS bf16_t* QS = (LAS bf16_t*)lds;
    LAS bf16_t* KS = (LAS bf16_t*)(lds + 17408);
    LAS float* KF = (LAS float*)(lds + 34816);
    LAS float* VF = (LAS float*)(lds + 67584);
    LAS float* LS = (LAS float*)(lds + 100352);
    LAS float* GC = (LAS float*)(lds + 117760);
    LAS float* BE = GC + 64;
    LAS float* EG = GC + 128;
    const bf16_t* Z = (const bf16_t*)(p->ws + WS_Z);
    const float* SMp = (const float*)(p->ws + WS_SM);
    bf16_t* DNP = (bf16_t*)(p->ws + WS_DNP);
    float* GLAST = (float*)(p->ws + WS_MISC);
    const float* convw = p->in[5] + (size_t)layer * 3072 * 4;
    for (int item = fresh_bid(); item < 2048; item += fresh_gdim()) {
        const int n = item & 63, h = (item >> 6) & 7, b = item >> 9;
        const size_t row0 = (size_t)b * SEQ + n * 64;
        bf16_t* it = DNP + (size_t)item * 36864;
        {
            const int c8 = (t & 15) * 8;
#pragma unroll 1
            for (int pass = 0; pass < 2; ++pass) {
                const int tok = pass * 32 + (t >> 4);
                u32x4 xz[3][4];
#pragma unroll
                for (int mat = 0; mat < 3; ++mat)
#pragma unroll
                    for (int j = 0; j < 4; ++j) {
                        const int tt = n * 64 + tok - 3 + j;
                        xz[mat][j] = (u32x4){0u, 0u, 0u, 0u};
                        if (tt >= 0) xz[mat][j] = *(const u32x4*)(Z + ((size_t)b * SEQ + tt) * ZW + mat * 1024 + h * 128 + c8);
                    }
#pragma unroll
                for (int mat = 0; mat < 3; ++mat) {
                    const int ch = mat * 1024 + h * 128 + c8;
                    float y[8];
#pragma unroll
                    for (int c = 0; c < 8; ++c) y[c] = 0.f;
                    f32x4 wc[8];
#pragma unroll
                    for (int c = 0; c < 8; ++c) wc[c] = *(const f32x4*)(convw + (size_t)(ch + c) * 4);
#pragma unroll
                    for (int j = 0; j < 4; ++j) {
                        const u32x4 xv = xz[mat][j];
                        y[0] += wc[0][j] * lo_bf(xv.x); y[1] += wc[1][j] * hi_bf(xv.x);
                        y[2] += wc[2][j] * lo_bf(xv.y); y[3] += wc[3][j] * hi_bf(xv.y);
                        y[4] += wc[4][j] * lo_bf(xv.z); y[5] += wc[5][j] * hi_bf(xv.z);
                        y[6] += wc[6][j] * lo_bf(xv.w); y[7] += wc[7][j] * hi_bf(xv.w);
                    }
                    float ss = 0.f;
#pragma unroll
                    for (int c = 0; c < 8; ++c) { y[c] = siluf_(y[c]); ss += y[c] * y[c]; }
                    if (mat < 2) {
                        ss += shx(ss, 1, lane); ss += shx(ss, 2, lane); ss += shx(ss, 4, lane); ss += shx(ss, 8, lane);
                        const float inv = rsqrtf(ss + EPS) * (mat == 0 ? 0.08838834764831845f : 1.f);
#pragma unroll
                        for (int c = 0; c < 8; ++c) y[c] *= inv;
                        u32x4 o; o.x = pk_bf16(y[0], y[1]); o.y = pk_bf16(y[2], y[3]); o.z = pk_bf16(y[4], y[5]); o.w = pk_bf16(y[6], y[7]);
                        if (mat == 0) *(LAS u32x4*)(QS + tok * 136 + c8) = o;
                        else { *(LAS u32x4*)(KS + tok * 136 + c8) = o;
#pragma unroll
                            for (int c = 0; c < 8; ++c) KF[tok * 128 + c8 + c] = y[c]; }
                    } else {
#pragma unroll
                        for (int c = 0; c < 8; ++c) VF[tok * 128 + c8 + c] = y[c];
                    }
                    __builtin_amdgcn_sched_barrier(0);
                }
            }
        }
        if (t < 64) {
            const float db = SMp[(row0 + t) * 32 + h], da = SMp[(row0 + t) * 32 + 8 + h];
            const float be = sigmoidf_(db);
            float g = -expf(p->in[6][layer * 8 + h]) * softplusf_(da + p->in[7][layer * 8 + h]);
#pragma unroll
            for (int o = 1; o < 64; o <<= 1) { const float v = shup(g, o, lane); if (lane >= o) g += v; }
            GC[t] = g; BE[t] = be; EG[t] = expf(g); GC[192 + t] = be * expf(g);
        }
        __syncthreads();
#pragma unroll
        for (int tt = 0; tt < 2; ++tt) {
            const int tile = wv * 2 + tt, mi = tile >> 2, ni = tile & 3;
            f32x4 aK = {0.f, 0.f, 0.f, 0.f}, aQ = {0.f, 0.f, 0.f, 0.f};
#pragma unroll
            for (int ks = 0; ks < 4; ++ks) {
                const bf16x8 bfr = *(const LAS bf16x8*)(KS + (ni * 16 + fr) * 136 + ks * 32 + fq * 8);
                const bf16x8 ak = *(const LAS bf16x8*)(KS + (mi * 16 + fr) * 136 + ks * 32 + fq * 8);
                const bf16x8 aq = *(const LAS bf16x8*)(QS + (mi * 16 + fr) * 136 + ks * 32 + fq * 8);
                aK = mfma16(ak, bfr, aK); aQ = mfma16(aq, bfr, aQ);
            }
            const int j = ni * 16 + fr; const float gj = GC[j];
#pragma unroll
            for (int r = 0; r < 4; ++r) {
                const int i = mi * 16 + fq * 4 + r;
                const float dec = (i >= j) ? expf(GC[i] - gj) : 0.f;
                LS[i * 68 + j] = (i > j) ? BE[i] * aK[r] * dec : 0.f;
                it[32768 + i * 64 + j] = f2bf(aQ[r] * dec);
            }
        }
        __syncthreads();
        if (t < 256) {
            const bool isw = t >= 128; const int cc = t & 127;
            bf16_t* op = it + (isw ? 8192 : 0) + cc;
            LAS const float* src = isw ? KF : VF;
            float x[64];
            int z0; asm volatile("v_mov_b32 %0, 0" : "=v"(z0));
            LAS const float* LSv = LS + z0;
            LAS const float* facp = (isw ? (GC + 192) : BE) + z0;
#pragma unroll
            for (int i = 0; i < 64; ++i) {
                float s = facp[i] * src[i * 128 + cc];
#pragma unroll
                for (int j = 0; j < i; ++j) s -= LSv[i * 68 + j] * x[j];
                x[i] = s;
                op[i * 128] = f2bf(s);
                asm volatile("" ::: "memory");
            }
        } else {
            const int t2 = t - 256;
            { const int i = t2 >> 2, cs = (t2 & 3) * 32; const float e = EG[i];
#pragma unroll
              for (int q = 0; q < 4; ++q) { const u32x4 w = *(const LAS u32x4*)(QS + i * 136 + cs + q * 8);
                  u32x4 o; o.x = pk_bf16(lo_bf(w.x) * e, hi_bf(w.x) * e); o.y = pk_bf16(lo_bf(w.y) * e, hi_bf(w.y) * e); o.z = pk_bf16(lo_bf(w.z) * e, hi_bf(w.z) * e); o.w = pk_bf16(lo_bf(w.w) * e, hi_bf(w.w) * e);
                  *(u32x4*)(it + 16384 + i * 128 + cs + q * 8) = o; } }
            { const int d = t2 >> 1, hf = t2 & 1; const float gl = GC[63];
#pragma unroll
              for (int q = 0; q < 4; ++q) { float v[8];
#pragma unroll
                  for (int e = 0; e < 8; ++e) { const int i = hf * 32 + q * 8 + e; v[e] = KF[i * 128 + d] * expf(gl - GC[i]); }
                  u32x4 o; o.x = pk_bf16(v[0], v[1]); o.y = pk_bf16(v[2], v[3]); o.z = pk_bf16(v[4], v[5]); o.w = pk_bf16(v[6], v[7]);
                  *(u32x4*)(it + 24576 + d * 64 + hf * 32 + q * 8) = o; } }
            if (t2 == 0) GLAST[item] = expf(GC[63]);
        }
        __syncthreads();
    }
}

__device__ void gla_prep(LAS unsigned char* lds, PPtr p, int layer, const int wid_s) {
    const int t = fresh_tid(wid_s), wv = t >> 6, lane = t & 63, fr = lane & 15, fq = lane >> 4;
    LAS bf16_t* QA = (LAS bf16_t*)(lds + 32768);
    LAS bf16_t* KD = (LAS bf16_t*)(lds + 50176);
    LAS float* TOT = (LAS float*)(lds + 67584);
    const bf16_t* Z = (const bf16_t*)(p->ws + WS_Z);
    const float* SMp = (const float*)(p->ws + WS_SM);
    unsigned char* GLP = p->ws + WS_GLP;
    for (int item = fresh_bid(); item < 1024; item += fresh_gdim()) {
        const int n = item & 63, h = (item >> 6) & 3, b = item >> 8;
        const size_t row0 = (size_t)b * SEQ + n * 64;
        bf16_t* it = (bf16_t*)(GLP + (size_t)item * GL_ITEM);
        const int d = t & 127, iq = __builtin_amdgcn_readfirstlane(t >> 7);
        float wup[16];
#pragma unroll
        for (int r = 0; r < 16; ++r) wup[r] = p->in[10][(size_t)layer * 16 * 512 + r * 512 + h * 128 + d];
        const float bup = p->in[11][layer * 512 + h * 128 + d];
        float la[16]; float run = 0.f;
#pragma unroll
        for (int ii = 0; ii < 16; ++ii) {
            const float* gl = SMp + (row0 + iq * 16 + ii) * 32 + 16;
            float dot = bup;
#pragma unroll
            for (int r = 0; r < 16; ++r) dot += gl[r] * wup[r];
            const float ls = fminf(dot, 0.f) - log1pf(__expf(-fabsf(dot)));
            run += ls * (1.f / 16.f); la[ii] = run;
        }
        TOT[iq * 128 + d] = run;
        __syncthreads();
        float off = 0.f, blast = 0.f;
#pragma unroll
        for (int q = 0; q < 4; ++q) { const float v = TOT[q * 128 + d]; blast += v; if (q < iq) off += v; }
        float kdv[16];
#pragma unroll
        for (int ii = 0; ii < 16; ++ii) {
            const int i = iq * 16 + ii; const float bc = la[ii] + off;
            const float q = bf2f(Z[(row0 + i) * ZW + GQ + h * 128 + d]) * 0.08838834764831845f;
            const float k = bf2f(Z[(row0 + i) * ZW + GK + h * 128 + d]);
            it[i * 128 + d] = f2bf(q * __expf(bc));
            QA[i * 136 + d] = f2bf(q * __expf(bc - blast));
            const float kd = k * __expf(blast - bc);
            KD[i * 136 + d] = f2bf(kd); kdv[ii] = kd;
        }
        { u32x4 o0, o1;
          o0.x = pk_bf16(kdv[0], kdv[1]); o0.y = pk_bf16(kdv[2], kdv[3]); o0.z = pk_bf16(kdv[4], kdv[5]); o0.w = pk_bf16(kdv[6], kdv[7]);
          o1.x = pk_bf16(kdv[8], kdv[9]); o1.y = pk_bf16(kdv[10], kdv[11]); o1.z = pk_bf16(kdv[12], kdv[13]); o1.w = pk_bf16(kdv[14], kdv[15]);
          *(u32x4*)(it + 8192 + d * 64 + iq * 16) = o0; *(u32x4*)(it + 8192 + d * 64 + iq * 16 + 8) = o1; }
        if (iq == 0) ((float*)((unsigned char*)it + 73728))[d] = __expf(blast);
        __syncthreads();
#pragma unroll
        for (int tt = 0; tt < 2; ++tt) {
            const int tile = wv * 2 + tt, mi = tile >> 2, ni = tile & 3;
            f32x4 a = {0.f, 0.f, 0.f, 0.f};
#pragma unroll
            for (int ks = 0; ks < 4; ++ks) {
                const bf16x8 bfr = *(const LAS bf16x8*)(KD + (ni * 16 + fr) * 136 + ks * 32 + fq * 8);
                const bf16x8 aq = *(const LAS bf16x8*)(QA + (mi * 16 + fr) * 136 + ks * 32 + fq * 8);
                a = mfma16(aq, bfr, a);
            }
            const int j = ni * 16 + fr;
#pragma unroll
            for (int r = 0; r < 4; ++r) { const int i = mi * 16 + fq * 4 + r; it[16384 + i * 64 + j] = f2bf(i >= j ? a[r] : 0.f); }
        }
        { const int e = t & 255, hf = t >> 8;
#pragma unroll
          for (int q = 0; q < 4; ++q) { bf16_t v[8];
#pragma unroll
              for (int e2 = 0; e2 < 8; ++e2) v[e2] = Z[(row0 + hf * 32 + q * 8 + e2) * ZW + GV + h * 256 + e];
              u32x4 o; o.x = v[0] | ((unsigned)v[1] << 16); o.y = v[2] | ((unsigned)v[3] << 16); o.z = v[4] | ((unsigned)v[5] << 16); o.w = v[6] | ((unsigned)v[7] << 16);
              *(u32x4*)(it + 20480 + e * 64 + hf * 32 + q * 8) = o; } }
        __syncthreads();
    }
}

__device__ void dn_scan(LAS unsigned char* lds, PPtr p, int bh, int es, const int wid_s) {
    const int t = fresh_tid(wid_s), wv = t >> 6, lane = t & 63, fr = lane & 15, fq = lane >> 4;
    const int mt = wv & 3, et = wv >> 2;
    LAS bf16_t* ST = (LAS bf16_t*)lds;
    LAS bf16_t* VT = (LAS bf16_t*)(lds + 8704);
    const bf16_t* DNP = (const bf16_t*)(p->ws + WS_DNP);
    const float* GLAST = (const float*)(p->ws + WS_MISC);
    bf16_t* OA = (bf16_t*)(p->ws + WS_H);
    for (int i = t; i < 32 * 136 / 2; i += 512) ((LAS unsigned*)ST)[i] = 0u;
    f32x4 S0 = {0.f, 0.f, 0.f, 0.f}, S1 = {0.f, 0.f, 0.f, 0.f};
    __syncthreads();
    const int b = bh >> 3, h = bh & 7;
    struct DF { bf16x8 wf[4], qf[4], af[2], kf[2]; float uv[4]; float gl; };
    auto dload = [&](int n) __attribute__((always_inline)) {
        DF f; const bf16_t* it = DNP + (size_t)(bh * 64 + n) * 36864;
#pragma unroll
        for (int ks = 0; ks < 4; ++ks) { f.wf[ks] = *(const bf16x8*)(it + 8192 + (mt * 16 + fr) * 128 + ks * 32 + fq * 8); f.qf[ks] = *(const bf16x8*)(it + 16384 + (mt * 16 + fr) * 128 + ks * 32 + fq * 8); }
#pragma unroll
        for (int ks = 0; ks < 2; ++ks) { f.af[ks] = *(const bf16x8*)(it + 32768 + (mt * 16 + fr) * 64 + ks * 32 + fq * 8); f.kf[ks] = *(const bf16x8*)(it + 24576 + (wv * 16 + fr) * 64 + ks * 32 + fq * 8); }
#pragma unroll
        for (int r = 0; r < 4; ++r) f.uv[r] = bf2f(it[(mt * 16 + fq * 4 + r) * 128 + es * 32 + et * 16 + fr]);
        f.gl = GLAST[bh * 64 + n];
        return f; };
    DF cf = dload(0);
#pragma unroll 1
    for (int n = 0; n < 64; ++n) {
        const DF nf = dload(n < 63 ? n + 1 : 63);
        const bf16x8 (&wf)[4] = cf.wf; const bf16x8 (&qf)[4] = cf.qf; const bf16x8 (&af)[2] = cf.af; const bf16x8 (&kf)[2] = cf.kf; const float (&uv)[4] = cf.uv; const float gl = cf.gl;
        f32x4 P = {0.f, 0.f, 0.f, 0.f}, Q = {0.f, 0.f, 0.f, 0.f};
#pragma unroll
        for (int ks = 0; ks < 4; ++ks) { const bf16x8 bfr = *(const LAS bf16x8*)(ST + (et * 16 + fr) * 136 + ks * 32 + fq * 8); P = mfma16(wf[ks], bfr, P); Q = mfma16(qf[ks], bfr, Q); }
        const f32x4 vn = {uv[0] - P[0], uv[1] - P[1], uv[2] - P[2], uv[3] - P[3]};
        *(LAS u32x2*)(VT + (et * 16 + fr) * 72 + mt * 16 + fq * 4) = pk4(vn);
        __syncthreads();
#pragma unroll
        for (int ks = 0; ks < 2; ++ks) { const bf16x8 bfr = *(const LAS bf16x8*)(VT + (et * 16 + fr) * 72 + ks * 32 + fq * 8); Q = mfma16(af[ks], bfr, Q); }
#pragma unroll
        for (int r = 0; r < 4; ++r) OA[((size_t)b * SEQ + n * 64 + mt * 16 + fq * 4 + r) * 1024 + h * 128 + es * 32 + et * 16 + fr] = f2bf(Q[r]);
        S0 *= gl; S1 *= gl;
#pragma unroll
        for (int ks = 0; ks < 2; ++ks) {
            const bf16x8 b0 = *(const LAS bf16x8*)(VT + fr * 72 + ks * 32 + fq * 8);
            const bf16x8 b1 = *(const LAS bf16x8*)(VT + (16 + fr) * 72 + ks * 32 + fq * 8);
            S0 = mfma16(kf[ks], b0, S0); S1 = mfma16(kf[ks], b1, S1);
        }
        *(LAS u32x2*)(ST + fr * 136 + wv * 16 + fq * 4) = pk4(S0);
        *(LAS u32x2*)(ST + (16 + fr) * 136 + wv * 16 + fq * 4) = pk4(S1);
        __syncthreads();
        cf = nf;
    }
}

__device__ void gla_scan(LAS unsigned char* lds, PPtr p, int bh, int es, const int wid_s) {
    const int t = fresh_tid(wid_s), wv = t >> 6, lane = t & 63, fr = lane & 15, fq = lane >> 4;
    const int mt = wv & 3, eh = wv >> 2;
    LAS bf16_t* STb = (LAS bf16_t*)lds;
    const unsigned char* GLP = p->ws + WS_GLP;
    bf16_t* OB = (bf16_t*)(p->ws + WS_H) + (size_t)MTOK * 1024;
    for (int i = t; i < 64 * 136 / 2; i += 512) ((LAS unsigned*)STb)[i] = 0u;
    f32x4 S[4];
#pragma unroll
    for (int e = 0; e < 4; ++e) S[e] = (f32x4){0.f, 0.f, 0.f, 0.f};
    __syncthreads();
    const int b = bh >> 2, h = bh & 3;
    struct GF { bf16x8 qf[4], af[2], kf[2], vB[4][2]; };
    auto gload = [&](int n) __attribute__((always_inline)) {
        GF f; const unsigned char* itb = GLP + (size_t)(bh * 64 + n) * GL_ITEM; const bf16_t* it = (const bf16_t*)itb;
#pragma unroll
        for (int ks = 0; ks < 4; ++ks) f.qf[ks] = *(const bf16x8*)(it + (mt * 16 + fr) * 128 + ks * 32 + fq * 8);
#pragma unroll
        for (int ks = 0; ks < 2; ++ks) { f.af[ks] = *(const bf16x8*)(it + 16384 + (mt * 16 + fr) * 64 + ks * 32 + fq * 8); f.kf[ks] = *(const bf16x8*)(it + 8192 + (wv * 16 + fr) * 64 + ks * 32 + fq * 8); }
#pragma unroll
        for (int e = 0; e < 4; ++e)
#pragma unroll
            for (int ks = 0; ks < 2; ++ks) f.vB[e][ks] = *(const bf16x8*)(it + 20480 + (es * 64 + e * 16 + fr) * 64 + ks * 32 + fq * 8);
        return f; };
    auto alload = [&](int n) __attribute__((always_inline)) { return *(const f32x4*)((const float*)(GLP + (size_t)(bh * 64 + n) * GL_ITEM + 73728) + wv * 16 + fq * 4); };
    f32x4 alc = alload(0);
    GF cf = gload(0), nf = gload(1);
#pragma unroll 1
    for (int n = 0; n < 64; ++n) {
        const GF nnf = gload(n < 62 ? n + 2 : 63);
        LAS bf16_t* cur = STb + (n & 1) * (64 * 136);
        LAS bf16_t* nxt = STb + ((n + 1) & 1) * (64 * 136);
        const bf16x8 (&qf)[4] = cf.qf; const bf16x8 (&af)[2] = cf.af; const bf16x8 (&kf)[2] = cf.kf; const bf16x8 (&vB)[4][2] = cf.vB; const f32x4 al = alc; const f32x4 aln = alload(n < 63 ? n + 1 : 63);
#pragma unroll
        for (int e2 = 0; e2 < 2; ++e2) {
            const int etile = eh * 2 + e2;
            f32x4 O = {0.f, 0.f, 0.f, 0.f};
#pragma unroll
            for (int ks = 0; ks < 4; ++ks) { const bf16x8 bfr = *(const LAS bf16x8*)(cur + (etile * 16 + fr) * 136 + ks * 32 + fq * 8); O = mfma16(qf[ks], bfr, O); }
#pragma unroll
            for (int ks = 0; ks < 2; ++ks) O = eh ? mfma16(af[ks], vB[2 + e2][ks], O) : mfma16(af[ks], vB[e2][ks], O);
#pragma unroll
            for (int r = 0; r < 4; ++r) OB[((size_t)b * SEQ + n * 64 + mt * 16 + fq * 4 + r) * 1024 + h * 256 + es * 64 + etile * 16 + fr] = f2bf(O[r]);
        }
#pragma unroll
        for (int e = 0; e < 4; ++e) {
            S[e] *= al;
#pragma unroll
            for (int ks = 0; ks < 2; ++ks) S[e] = mfma16(kf[ks], vB[e][ks], S[e]);
            *(LAS u32x2*)(nxt + (e * 16 + fr) * 136 + wv * 16 + fq * 4) = pk4(S[e]);
        }
        __syncthreads();
        cf = nf; nf = nnf; alc = aln;
    }
}

constexpr int S5_LDS_WAVE = 16384 + 8704;
__device__ __forceinline__ void s5_scan(LAS unsigned char* ldsw, PPtr p, int layer, int b, int g, const int wid_s) {
    const int lane = fresh_tid(wid_s) & 63, fr = lane & 15, fq = lane >> 4;
    bf16_t* Z = (bf16_t*)(p->ws + WS_Z);
    const float* lam_re = p->in[14] + (size_t)(layer * 64 + g) * 64;
    const float* lam_im = p->in[15] + (size_t)(layer * 64 + g) * 64;
    const float dt = expf(p->in[16][layer * 64 + g]);
    const float* b_re = p->in[17] + (size_t)(layer * 64 + g) * 64 * 16;
    const float* b_im = p->in[18] + (size_t)(layer * 64 + g) * 64 * 16;
    const float* c_re = p->in[19] + (size_t)(layer * 64 + g) * 16 * 64;
    const float* c_im = p->in[20] + (size_t)(layer * 64 + g) * 16 * 64;
    const float dsk = p->in[21][layer * 1024 + g * 16 + fr];
    float ar, ai;
    { const float lr = fminf(lam_re[lane], -1e-4f), li = lam_im[lane]; const float mag = expf(lr * dt); ar = mag * cosf(li * dt); ai = mag * sinf(li * dt); }
    bf16x8 bB[8];
#pragma unroll
    for (int nt = 0; nt < 8; ++nt) {
        const int pp = (nt * 16 + fr) & 63;
        const float lr = fminf(lam_re[pp], -1e-4f), li = lam_im[pp]; const float mag = expf(lr * dt);
        const float a_r = mag * cosf(li * dt), a_i = mag * sinf(li * dt), nr = a_r - 1.f, den = lr * lr + li * li;
        const float zr = (nr * lr + a_i * li) / den, zi = (a_i * lr - nr * li) / den;
        float v[8];
#pragma unroll
        for (int j = 0; j < 8; ++j) {
            float val = 0.f;
            if (fq < 2) { const float br = b_re[pp * 16 + fq * 8 + j], bi = b_im[pp * 16 + fq * 8 + j]; val = (nt >= 4) ? (zr * bi + zi * br) : (zr * br - zi * bi); }
            v[j] = val;
        }
        u32x4 o; o.x = pk_bf16(v[0], v[1]); o.y = pk_bf16(v[2], v[3]); o.z = pk_bf16(v[4], v[5]); o.w = pk_bf16(v[6], v[7]);
        bB[nt] = __builtin_bit_cast(bf16x8, o);
    }
    bf16x8 cB[4];
#pragma unroll
    for (int ks = 0; ks < 4; ++ks) {
        const int p0 = (ks * 32 + fq * 8) >> 1;
        float v[8];
#pragma unroll
        for (int j = 0; j < 4; ++j) { v[2 * j] = c_re[fr * 64 + p0 + j]; v[2 * j + 1] = -c_im[fr * 64 + p0 + j]; }
        u32x4 o; o.x = pk_bf16(v[0], v[1]); o.y = pk_bf16(v[2], v[3]); o.z = pk_bf16(v[4], v[5]); o.w = pk_bf16(v[6], v[7]);
        cB[ks] = __builtin_bit_cast(bf16x8, o);
    }
    LAS float* const BU0 = (LAS float*)ldsw;
    LAS unsigned* const X0 = (LAS unsigned*)(ldsw + 16384);
    float xr = 0.f, xi = 0.f;
    const size_t rowb = (size_t)b * SEQ;
    auto ldfrag = [&](int tile) __attribute__((always_inline)) {
        u32x4 r = {0u, 0u, 0u, 0u};
        if (fq < 2) r = *(const u32x4*)(Z + (rowb + tile * 16 + fr) * ZW + SU + g * 16 + fq * 8);
        return r; };
    auto stageA = [&](u32x4 uraw, LAS float* bu) __attribute__((always_inline)) {
        const bf16x8 ua = __builtin_bit_cast(bf16x8, uraw);
#pragma unroll
        for (int nt = 0; nt < 8; ++nt) {
            f32x4 acc = {0.f, 0.f, 0.f, 0.f};
            acc = mfma16(ua, bB[nt], acc);
#pragma unroll
            for (int r = 0; r < 4; ++r) bu[(fq * 4 + r) * 128 + nt * 16 + fr] = acc[r];
        } };
    auto stageB = [&](LAS const float* bu, LAS unsigned* xw) __attribute__((always_inline)) {
        float br_[16], bi_[16];
#pragma unroll
        for (int tt = 0; tt < 16; ++tt) { br_[tt] = bu[tt * 128 + lane]; bi_[tt] = bu[tt * 128 + 64 + lane]; }
#pragma unroll
        for (int tt = 0; tt < 16; ++tt) {
            const float nxr = ar * xr - ai * xi + br_[tt], nxi = ar * xi + ai * xr + bi_[tt];
            xr = nxr; xi = nxi;
            xw[tt * 68 + lane] = pk_bf16(xr, xi);
        } };
    auto stageC = [&](LAS const unsigned* xrd, int tile, const bf16_t (&ue)[4], bool doit) __attribute__((always_inline)) {
        f32x4 acc = {0.f, 0.f, 0.f, 0.f};
#pragma unroll
        for (int ks = 0; ks < 4; ++ks) { const bf16x8 xa = *(const LAS bf16x8*)((const LAS bf16_t*)xrd + fr * 136 + ks * 32 + fq * 8); acc = mfma16(xa, cB[ks], acc); }
        if (doit) {
#pragma unroll
            for (int r = 0; r < 4; ++r) {
                bf16_t* zp = Z + (rowb + tile * 16 + fq * 4 + r) * ZW + ZQ + g * 16 + fr;
                *zp = f2bf(geluf_(acc[r] + dsk * bf2f(ue[r])));
            }
        } };
    auto ldue = [&](int tile, bf16_t (&ue)[4]) __attribute__((always_inline)) {
#pragma unroll
        for (int r = 0; r < 4; ++r) ue[r] = Z[(rowb + tile * 16 + fq * 4 + r) * ZW + SU + g * 16 + fr]; };
    u32x4 q1 = ldfrag(1), q2 = ldfrag(2);
    stageA(ldfrag(0), BU0);
    bf16_t uec[4] = {0, 0, 0, 0}, uen[4];
    asm volatile("s_waitcnt lgkmcnt(0)" ::: "memory");
#pragma unroll 1
    for (int t = 0; t < 256; t += 2) {
        { const u32x4 q3 = ldfrag(t + 3 < 256 ? t + 3 : 255); ldue(t, uen);
          stageA(q1, BU0 + 2048); stageB(BU0, X0); stageC(X0 + 1088, t - 1, uec, t > 0);
          q1 = q2; q2 = q3;
#pragma unroll
          for (int r = 0; r < 4; ++r) uec[r] = uen[r];
          asm volatile("s_waitcnt lgkmcnt(0)" ::: "memory"); }
        { const u32x4 q3 = ldfrag(t + 4 < 256 ? t + 4 : 255); ldue(t + 1, uen);
          stageA(q1, BU0); stageB(BU0 + 2048, X0 + 1088); stageC(X0, t, uec, true);
          q1 = q2; q2 = q3;
#pragma unroll
          for (int r = 0; r < 4; ++r) uec[r] = uen[r];
          asm volatile("s_waitcnt lgkmcnt(0)" ::: "memory"); }
    }
    stageC(X0 + 1088, 255, uec, true);
    asm volatile("s_waitcnt lgkmcnt(0)" ::: "memory");
}

template <int W> __device__ void head_norm_gate(bf16_t* O, const bf16_t* Zg  , const float* nw, const int wid_s) {
    constexpr int LPG = W / 8;
    constexpr unsigned HPR = 1024 / W;
    const unsigned total = (unsigned)MTOK * HPR * LPG;
    const int t_ = fresh_tid(wid_s), lane_ = t_ & 63;
    const unsigned gthreads = (unsigned)fresh_gdim() * 512u, gid = (unsigned)fresh_bid() * 512u + (unsigned)t_;
    const int l = (int)(gid % LPG);
    float nwv[8];
#pragma unroll
    for (int c = 0; c < 8; ++c) nwv[c] = nw[l * 8 + c];
    u32x4 w, gz;
    auto ldit = [&](unsigned idx) __attribute__((always_inline)) {
        const unsigned grp = idx / LPG, row = grp / HPR, hh = grp % HPR; const unsigned col = hh * W + l * 8;
        w = *(const u32x4*)(O + (size_t)row * 1024 + col); gz = *(const u32x4*)(Zg + (size_t)row * ZW + col);
    };
    if (gid < total) ldit(gid);
    for (unsigned idx = gid; idx < total; idx += gthreads) {
        const unsigned grp = idx / LPG, row = grp / HPR, hh = grp % HPR; const unsigned col = hh * W + l * 8;
        float v[8] = {lo_bf(w.x), hi_bf(w.x), lo_bf(w.y), hi_bf(w.y), lo_bf(w.z), hi_bf(w.z), lo_bf(w.w), hi_bf(w.w)};
        const float gzv[8] = {lo_bf(gz.x), hi_bf(gz.x), lo_bf(gz.y), hi_bf(gz.y), lo_bf(gz.z), hi_bf(gz.z), lo_bf(gz.w), hi_bf(gz.w)};
        if (idx + gthreads < total) ldit(idx + gthreads);
        float ss = 0.f;
#pragma unroll
        for (int c = 0; c < 8; ++c) ss += v[c] * v[c];
#pragma unroll
        for (int o = 1; o < LPG; o <<= 1) ss += shx(ss, o, lane_);
        const float inv = rsqrtf(ss * (1.f / W) + EPS);
#pragma unroll
        for (int c = 0; c < 8; ++c) v[c] = v[c] * inv * nwv[c] * siluf_(gzv[c]);
        u32x4 o; o.x = pk_bf16(v[0], v[1]); o.y = pk_bf16(v[2], v[3]); o.z = pk_bf16(v[4], v[5]); o.w = pk_bf16(v[6], v[7]);
        *(u32x4*)(O + (size_t)row * 1024 + col) = o;
    }
}

__device__ void xattn(LAS unsigned char* lds, const bf16_t* XQ, const bf16_t* Kb, const bf16_t* VTg, bf16_t* XO, const int wid_s) {
    const int t = fresh_tid(wid_s), wv = t >> 6, lane = t & 63, fr = lane & 15, fq = lane >> 4;
    LAS bf16_t* Pw = (LAS bf16_t*)(lds + wv * 8448);
    for (int item = fresh_bid(); item < 512; item += fresh_gdim()) {
        const int qt = item & 31, hd = (item >> 5) & 3, b = item >> 7;
        const size_t r0 = (size_t)b * SEQ + qt * 128 + wv * 16;
        bf16x8 qf[4];
#pragma unroll
        for (int ks = 0; ks < 4; ++ks) qf[ks] = *(const bf16x8*)(XQ + (r0 + fr) * 512 + hd * 128 + ks * 32 + fq * 8);
        f32x4 s[16];
#pragma unroll
        for (int nt = 0; nt < 16; ++nt) {
            f32x4 a = {0.f, 0.f, 0.f, 0.f};
#pragma unroll
            for (int ks = 0; ks < 4; ++ks) { const bf16x8 kfr = *(const bf16x8*)(Kb + ((size_t)b * 256 + nt * 16 + fr) * 512 + hd * 128 + ks * 32 + fq * 8); a = mfma16(qf[ks], kfr, a); }
            s[nt] = a * 0.08838834764831845f;
        }
        float mx[4], sm[4];
#pragma unroll
        for (int r = 0; r < 4; ++r) {
            float m = s[0][r];
#pragma unroll
            for (int nt = 1; nt < 16; ++nt) m = fmaxf(m, s[nt][r]);
            m = fmaxf(m, shx(m, 1, lane)); m = fmaxf(m, shx(m, 2, lane)); m = fmaxf(m, shx(m, 4, lane)); m = fmaxf(m, shx(m, 8, lane));
            mx[r] = m;
            float su = 0.f;
#pragma unroll
            for (int nt = 0; nt < 16; ++nt) { const float e = __expf(s[nt][r] - m); s[nt][r] = e; su += e; }
            su += shx(su, 1, lane); su += shx(su, 2, lane); su += shx(su, 4, lane); su += shx(su, 8, lane);
            sm[r] = 1.f / su;
        }
#pragma unroll
        for (int nt = 0; nt < 16; ++nt)
#pragma unroll
            for (int r = 0; r < 4; ++r) Pw[(fq * 4 + r) * 264 + nt * 16 + fr] = f2bf(s[nt][r] * sm[r]);
        __syncthreads();
        bf16x8 pf[8];
#pragma unroll
        for (int ks = 0; ks < 8; ++ks) pf[ks] = *(const LAS bf16x8*)(Pw + fr * 264 + ks * 32 + fq * 8);
#pragma unroll
        for (int dtile = 0; dtile < 8; ++dtile) {
            f32x4 o = {0.f, 0.f, 0.f, 0.f};
#pragma unroll
            for (int ks = 0; ks < 8; ++ks) { const bf16x8 vfr = *(const bf16x8*)(VTg + ((size_t)(b * 4 + hd) * 128 + dtile * 16 + fr) * 256 + ks * 32 + fq * 8); o = mfma16(pf[ks], vfr, o); }
#pragma unroll
            for (int r = 0; r < 4; ++r) XO[(r0 + fq * 4 + r) * 512 + hd * 128 + dtile * 16 + fr] = f2bf(o[r]);
        }
        __syncthreads();
    }
}

__device__ void ffn_act(const bf16_t* G, const bf16_t* U, const float* cw, bf16_t* ACT, const int wid_s) {
    const unsigned nitems = (unsigned)(FF / 8) * (MTOK / 16);
    const unsigned gthreads = (unsigned)fresh_gdim() * 512u, gid = (unsigned)fresh_bid() * 512u + (unsigned)fresh_tid(wid_s);
    for (unsigned idx = gid; idx < nitems; idx += gthreads) {
        const unsigned cg = idx % (FF / 8), tb = idx / (FF / 8);
        const unsigned c0 = cg * 8, t0 = tb * 16;
        float w0[8], w1[8], w2[8];
#pragma unroll
        for (int c = 0; c < 8; ++c) { w0[c] = cw[(c0 + c) * 3]; w1[c] = cw[(c0 + c) * 3 + 1]; w2[c] = cw[(c0 + c) * 3 + 2]; }
        float g2[8], g1[8];
        const bool start = (t0 & (SEQ - 1)) == 0;
        const unsigned base = t0 * FF + c0;
        { u32x4 a = {0u, 0u, 0u, 0u}, bq = {0u, 0u, 0u, 0u};
          if (!start) { a = *(const u32x4*)(G + (base - 2 * FF)); bq = *(const u32x4*)(G + (base - FF)); }
          g2[0] = lo_bf(a.x); g2[1] = hi_bf(a.x); g2[2] = lo_bf(a.y); g2[3] = hi_bf(a.y); g2[4] = lo_bf(a.z); g2[5] = hi_bf(a.z); g2[6] = lo_bf(a.w); g2[7] = hi_bf(a.w);
          g1[0] = lo_bf(bq.x); g1[1] = hi_bf(bq.x); g1[2] = lo_bf(bq.y); g1[3] = hi_bf(bq.y); g1[4] = lo_bf(bq.z); g1[5] = hi_bf(bq.z); g1[6] = lo_bf(bq.w); g1[7] = hi_bf(bq.w); }
#pragma unroll 4
        for (unsigned tt = 0; tt < 16; ++tt) {
            const unsigned off = base + tt * FF;
            const u32x4 a = *(const u32x4*)(G + off);
            const u32x4 uq = *(const u32x4*)(U + off);
            const float g0[8] = {lo_bf(a.x), hi_bf(a.x), lo_bf(a.y), hi_bf(a.y), lo_bf(a.z), hi_bf(a.z), lo_bf(a.w), hi_bf(a.w)};
            const float uu[8] = {lo_bf(uq.x), hi_bf(uq.x), lo_bf(uq.y), hi_bf(uq.y), lo_bf(uq.z), hi_bf(uq.z), lo_bf(uq.w), hi_bf(uq.w)};
            float r[8];
#pragma unroll
            for (int c = 0; c < 8; ++c) { const float y = w0[c] * g2[c] + w1[c] * g1[c] + w2[c] * g0[c]; r[c] = geluf_(y) * uu[c]; g2[c] = g1[c]; g1[c] = g0[c]; }
            u32x4 o; o.x = pk_bf16(r[0], r[1]); o.y = pk_bf16(r[2], r[3]); o.z = pk_bf16(r[4], r[5]); o.w = pk_bf16(r[6], r[7]);
            *(u32x4*)(ACT + off) = o;
        }
    }
}

__device__ void ffn_fix(const bf16_t* GB, const bf16_t* UB, const float* cw, bf16_t* ACT, const int wid_s) {
    const unsigned nitems = 256u * 2u * (FF / 8);
    const unsigned gthreads = (unsigned)fresh_gdim() * 512u, gid = (unsigned)fresh_bid() * 512u + (unsigned)fresh_tid(wid_s);
    for (unsigned idx = gid; idx < nitems; idx += gthreads) {
        const unsigned cg = idx % (FF / 8), rest = idx / (FF / 8), rr = rest & 1u, rb = rest >> 1;
        const unsigned c0 = cg * 8;
        const bool first = (rb & 63u) == 0u;
        const u32x4 zero = {0u, 0u, 0u, 0u};
        const u32x4 a0 = *(const u32x4*)(GB + (size_t)(rb * 4 + 2 + rr) * FF + c0);
        u32x4 a1, a2;
        if (rr == 0) { a1 = first ? zero : *(const u32x4*)(GB + (size_t)((rb - 1) * 4 + 1) * FF + c0); a2 = first ? zero : *(const u32x4*)(GB + (size_t)((rb - 1) * 4 + 0) * FF + c0); }
        else         { a1 = *(const u32x4*)(GB + (size_t)(rb * 4 + 2) * FF + c0);                     a2 = first ? zero : *(const u32x4*)(GB + (size_t)((rb - 1) * 4 + 1) * FF + c0); }
        const u32x4 uq = *(const u32x4*)(UB + (size_t)(rb * 2 + rr) * FF + c0);
        const float g0[8] = {lo_bf(a0.x), hi_bf(a0.x), lo_bf(a0.y), hi_bf(a0.y), lo_bf(a0.z), hi_bf(a0.z), lo_bf(a0.w), hi_bf(a0.w)};
        const float g1[8] = {lo_bf(a1.x), hi_bf(a1.x), lo_bf(a1.y), hi_bf(a1.y), lo_bf(a1.z), hi_bf(a1.z), lo_bf(a1.w), hi_bf(a1.w)};
        const float g2[8] = {lo_bf(a2.x), hi_bf(a2.x), lo_bf(a2.y), hi_bf(a2.y), lo_bf(a2.z), hi_bf(a2.z), lo_bf(a2.w), hi_bf(a2.w)};
        const float uu[8] = {lo_bf(uq.x), hi_bf(uq.x), lo_bf(uq.y), hi_bf(uq.y), lo_bf(uq.z), hi_bf(uq.z), lo_bf(uq.w), hi_bf(uq.w)};
        float r[8];
#pragma unroll
        for (int c = 0; c < 8; ++c) { const float y = cw[(c0 + c) * 3] * g2[c] + cw[(c0 + c) * 3 + 1] * g1[c] + cw[(c0 + c) * 3 + 2] * g0[c]; r[c] = geluf_(y) * uu[c]; }
        u32x4 o; o.x = pk_bf16(r[0], r[1]); o.y = pk_bf16(r[2], r[3]); o.z = pk_bf16(r[4], r[5]); o.w = pk_bf16(r[6], r[7]);
        *(u32x4*)(ACT + (size_t)(rb * 64 + rr) * FF + c0) = o;
    }
}

__device__ void convert_layer_small(LAS float* ldsf, PPtr p, int l, const int wid_s) {
    unsigned char* ws = p->ws;
    convert_w(ldsf, p->in[4] + (size_t)l * 2048 * 14368, (bf16_t*)(ws + WS_WA), 2048, 14368, ZN, 1, wid_s);
    convert_w(ldsf, p->in[9] + (size_t)l * 1024 * 2048, (bf16_t*)(ws + WS_WDN), 1024, 2048, 2048, 0, wid_s);
    convert_w(ldsf, p->in[13] + (size_t)l * 1024 * 2048, (bf16_t*)(ws + WS_WGLA), 1024, 2048, 2048, 0, wid_s);
    convert_w(ldsf, p->in[22] + (size_t)l * 1024 * 4096, (bf16_t*)(ws + WS_WGLU), 1024, 4096, 4096, 2, wid_s);
    convert_w(ldsf, p->in[23] + (size_t)l * 2048 * 2048, (bf16_t*)(ws + WS_WMIX), 2048, 2048, 2048, 0, wid_s);
    convert_w(ldsf, p->in[27] + (size_t)l * 2048 * 512, (bf16_t*)(ws + WS_WXQ), 2048, 512, 512, 0, wid_s);
    convert_w(ldsf, p->in[28] + (size_t)l * 2048 * 1024, (bf16_t*)(ws + WS_WXKV), 2048, 1024, 1024, 0, wid_s);
    convert_w(ldsf, p->in[29] + (size_t)l * 512 * 2048, (bf16_t*)(ws + WS_WXO), 512, 2048, 2048, 0, wid_s);
}
__device__ void convert_layer_ffn(LAS float* ldsf, PPtr p, int l, const int wid_s, int nb, int bi) {
    unsigned char* ws = p->ws;
    convert_w(ldsf, p->in[32] + (size_t)l * 2048 * 11264, (bf16_t*)(ws + WS_WA), 2048, 11264, 11264, 3, wid_s, nb, bi);
    convert_w(ldsf, p->in[34] + (size_t)l * 5632 * 2048, (bf16_t*)(ws + WS_WA + 46137344), 5632, 2048, 2048, 0, wid_s, nb, bi);
}


#ifdef DEBUG_NAN
__device__ __noinline__ void chk_f32(const float* q, size_t n, unsigned bit, unsigned* flag) {
    const size_t gthreads = (size_t)gridDim.x * 512, gid = (size_t)blockIdx.x * 512 + threadIdx.x; bool bad = false;
    for (size_t i = gid; i < n; i += gthreads) { const float v = q[i]; if (!(fabsf(v) < 1e30f)) bad = true; }
    if (bad) atomicOr(flag, 1u << bit);
}
__device__ __noinline__ void chk_bf16(const bf16_t* q, size_t n, unsigned bit, unsigned* flag) {
    const size_t gthreads = (size_t)gridDim.x * 512, gid = (size_t)blockIdx.x * 512 + threadIdx.x; bool bad = false;
    for (size_t i = gid; i < n; i += gthreads) { const float v = bf2f(q[i]); if (!(fabsf(v) < 1e30f)) bad = true; }
    if (bad) atomicOr(flag, 1u << bit);
}
#define CHKF(ptr, n, bit) do { if (l == DEBUG_NAN - 1) { chk_f32(ptr, n, bit, (unsigned*)(PP()->ws + WS_MISC + 32768)); } gsync(grid); } while (0)
#define CHKB(ptr, n, bit) do { if (l == DEBUG_NAN - 1) { chk_bf16(ptr, n, bit, (unsigned*)(PP()->ws + WS_MISC + 32768)); } xbar(wid_s); } while (0)
#else
#define CHKF(ptr, n, bit) do {} while (0)
#define CHKB(ptr, n, bit) do {} while (0)
#endif
#ifdef DEBUG_TS
__device__ __forceinline__ bool ts_in(const int* sel, int n, int k) { for (int q = 0; q < n; ++q) if (sel[q] == k) return true; return false; }
#define TS(k) do { const unsigned long long t_ = __builtin_amdgcn_s_memrealtime(); const int selA_[] = DEBUG_TS_A; const int selB_[] = DEBUG_TS_B; \
    const int kk_ = (k) % 20; \
    if (ts_in(selA_, (int)(sizeof(selA_) / sizeof(int)), kk_)) tsA += t_ - tsL; if (ts_in(selB_, (int)(sizeof(selB_) / sizeof(int)), kk_)) tsB += t_ - tsL; tsL = t_; } while (0)
#else
#define TS(k) do {} while (0)
#endif
#ifndef PMASK
#define PMASK 0xFFFFFFFFu
#endif
#define ON(k) ((PMASK >> (k)) & 1u)
constexpr size_t WS_LIMIT = 941621248;
static_assert(WS_END <= WS_LIMIT, "workspace map exceeds the guaranteed workspace size");
static_assert(WS_DNP + (size_t)MTOK * FF * 2 <= WS_MISC, "ACT does not fit");
static_assert((size_t)MTOK * FF * 2 * 2 <= SZ_Z, "G,U do not fit in Z");

#define m_ws (PP()->ws)
#define m_Z ((bf16_t*)(m_ws + WS_Z))
#define m_Y ((bf16_t*)(m_ws + WS_Z))
#define m_SMp ((float*)(m_ws + WS_SM))
#define m_H ((bf16_t*)(m_ws + WS_H))
#define m_OA m_H
#define m_OB (m_H + (size_t)MTOK * 1024)
#define m_MRG ((bf16_t*)(m_ws + WS_DNP))
#define m_XQ ((bf16_t*)(m_ws + WS_DNP))
#define m_XO ((bf16_t*)(m_ws + WS_DNP + (size_t)MTOK * 512 * 2))
#define m_ACT ((bf16_t*)(m_ws + WS_DNP))
#define m_MB ((bf16_t*)(m_ws + WS_GLP))
#define m_MEMN ((bf16_t*)(m_ws + WS_GLP))
#define m_KB ((bf16_t*)(m_ws + WS_GLP + 4194304))
#define m_VTG ((bf16_t*)(m_ws + WS_GLP + 5242880))
#define m_G ((bf16_t*)(m_ws + WS_Z))
#define m_U ((bf16_t*)(m_ws + WS_Z + 16777216))
#define m_xs ((bf16_t*)(m_ws + WS_XS))
#define m_out (PP()->out)
#define p PP()
__global__ void __launch_bounds__(512, 2) fwd_megakernel(Params p_unused) {
    extern __shared__ __attribute__((aligned(16))) unsigned char lds_raw[];
    LAS unsigned char* lds = (LAS unsigned char*)lds_raw;
    LAS float* ldsf = (LAS float*)lds_raw;
    cg::grid_group grid = cg::this_grid();
    if ((threadIdx.x & 63) == 0) ((LAS int*)(lds + 131072))[__builtin_amdgcn_s_getreg(10244) & 63] = (int)(threadIdx.x >> 6);
    { unsigned* bar0 = (unsigned*)(PP()->ws + WS_BAR);
      if (threadIdx.x == 0) { volatile LAS unsigned* st = (volatile LAS unsigned*)(lds + XB_LDS_OFF); st[0] = 0u; st[1] = 0u;
          (void)xb_add(&bar0[XB_XCNT(xb_xcc_id())], 1u); } }
    __syncthreads();
    constexpr int wid_s = 0;
#ifdef DEBUG_TS
    unsigned long long tsA = 0ull, tsB = 0ull, tsL = __builtin_amdgcn_s_memrealtime();
#endif
    if (ON(0)) convert_layer_small(ldsf, p, 0, wid_s);
    if (ON(1)) norm_rows_f(p->in[0], m_xs, p->in[2], m_H, MTOK, wid_s);
    if (PP()->ws == nullptr) grid.sync();
    xbar(wid_s); TS(0);

#pragma unroll 1
    for (int l = 0; l < 2; ++l) {
        if (ON(2)) { EpiZ e; e.Z = m_Z; e.SMp = m_SMp; run_gemm(lds, m_H, DM, (const bf16_t*)(m_ws + WS_WA), MTOK, ZN, DM, e, wid_s); }
#ifdef REPEAT_PH1
        { EpiZ e; e.Z = m_Z; e.SMp = m_SMp; run_gemm(lds, m_H, DM, (const bf16_t*)(m_ws + WS_WA), MTOK, ZN, DM, e, wid_s); }
#endif
        xbar(wid_s); TS(l * 20 + 1);

#ifdef DEBUG_Z
        {
            unsigned long long* cw = (unsigned long long*)(PP()->ws + WS_MISC + 32768);
            const size_t gthreads = (size_t)gridDim.x * 512, gid = (size_t)blockIdx.x * 512 + threadIdx.x;
            const bf16_t* zz = m_Z; const bf16_t* wa = (const bf16_t*)(m_ws + WS_WA);
            unsigned long long c = 0, mi = ~0ull, cwa = 0;
            for (size_t i = gid; i < (size_t)MTOK * ZW; i += gthreads) { const float v = bf2f(zz[i]); if (!(fabsf(v) < 1e30f)) { ++c; if (i < mi) mi = i; } }
            for (size_t i = gid; i < (size_t)ZN * 2048; i += gthreads) { const float v = bf2f(wa[i]); if (!(fabsf(v) < 1e30f)) ++cwa; }
            if (c) { atomicAdd(cw, c); atomicMin(cw + 1, mi); }
            if (cwa) atomicAdd(cw + 2, cwa);
            xbar(wid_s);
            const unsigned long long C = cw[0], MI = cw[1], WB = cw[2];
            const int pnf = (int)((MI % ZW) / 256), pmf = (int)((MI / ZW) / 256);
            const int wb = WB == 0 ? 0 : (WB < 1000 ? 1 : 2), zb = C < 10000 ? 0 : (C < 10000000 ? 1 : 2);
            const float e1 = exp10f(10.f + (float)(pmf / 4));
            const float v1 = (10.f + pnf) * e1, v2 = (10.f + 10.f * (3 * wb + zb)) * e1 * 0.01f;
            float* o = PP()->out;
            for (size_t i = gid; i < (size_t)MTOK * DM; i += gthreads) o[i] = (i == 0) ? v1 : v2;
            return;
        }
#endif

        CHKB(m_H, (size_t)MTOK * DM, 0); CHKB(m_Z, (size_t)MTOK * ZW, 1); CHKF(m_SMp, (size_t)MTOK * 32, 2);
        if (ON(3)) dn_prep(lds, p, l, wid_s);
        if (ON(4)) gla_prep(lds, p, l, wid_s);
        xbar(wid_s); TS(l * 20 + 2);
        CHKB((const bf16_t*)(m_ws + WS_DNP), (size_t)DN_ITEM * 1024, 3); CHKB((const bf16_t*)(m_ws + WS_GLP), (size_t)GL_ITEM * 512, 4);
        for (int role = blockIdx.x; role < 256; role += gridDim.x) {
            if (role < 128) { if (ON(5)) { const int x_ = role & 7, j_ = role >> 3; dn_scan(lds, p, x_ * 4 + (j_ >> 2), j_ & 3, wid_s); } }
            else if (role < 192) { if (ON(6)) { const int li_ = role - 128, x_ = li_ & 7, j_ = li_ >> 3; gla_scan(lds, p, x_ * 2 + (j_ >> 2), j_ & 3, wid_s); } }
            else { const int wv = fresh_tid(wid_s) >> 6; if (ON(7) && wv < 4) { const int pair = (role - 192) * 4 + wv; s5_scan(lds + wv * S5_LDS_WAVE, p, l, pair >> 6, pair & 63, wid_s); } }
            __syncthreads();
        }
        { const int bid_ = fresh_bid(), gd_ = fresh_gdim(), nbc = gd_ >= 256 ? 192 : gd_; if (ON(0) && bid_ < nbc) convert_layer_ffn(ldsf, p, l, wid_s, nbc, bid_); }
        xbar(wid_s); TS(l * 20 + 3);
#ifdef REPEAT_PH3
        for (int role = blockIdx.x; role < 256; role += gridDim.x) {
            if (role < 128) { if (ON(5)) { const int x_ = role & 7, j_ = role >> 3; dn_scan(lds, p, x_ * 4 + (j_ >> 2), j_ & 3, wid_s); } }
            else if (role < 192) { if (ON(6)) { const int li_ = role - 128, x_ = li_ & 7, j_ = li_ >> 3; gla_scan(lds, p, x_ * 2 + (j_ >> 2), j_ & 3, wid_s); } }
            else { const int wv = fresh_tid(wid_s) >> 6; if (ON(7) && wv < 4) { const int pair = (role - 192) * 4 + wv; s5_scan(lds + wv * S5_LDS_WAVE, p, l, pair >> 6, pair & 63, wid_s); } }
            __syncthreads();
        }
        xbar(wid_s);
#endif
        CHKB(m_OA, (size_t)MTOK * 1024, 5); CHKB(m_OB, (size_t)MTOK * 1024, 6); CHKB(m_Z, (size_t)MTOK * ZW, 7);
        if (ON(8)) head_norm_gate<128>(m_OA, m_Z + ZZ, p->in[8] + l * 128, wid_s);
        if (ON(8)) head_norm_gate<256>(m_OB, m_Z + GR, p->in[12] + l * 256, wid_s);
        if (ON(9)) { EpiGLU e; e.Z = m_Z; e.MRG = m_MRG; run_gemm(lds, m_Z + ZQ, ZW, (const bf16_t*)(m_ws + WS_WGLU), MTOK, 4096, 1024, e, wid_s); }
        xbar(wid_s); TS(l * 20 + 4);
        CHKB(m_OA, (size_t)MTOK * 2048, 8); CHKB(m_MRG, (size_t)MTOK * DM, 9);
        if (ON(10)) { EpiAcc<false> e; e.Z = m_Z; e.MRG = m_MRG; e.MB = nullptr; e.goff = 0; run_gemm(lds, m_OA, 1024, (const bf16_t*)(m_ws + WS_WDN), MTOK, DM, 1024, e, wid_s); }
        if (ON(10)) { EpiAcc<true> e; e.Z = m_Z; e.MRG = m_MRG; e.MB = m_MB; e.goff = 2048; run_gemm(lds, m_OB, 1024, (const bf16_t*)(m_ws + WS_WGLA), MTOK, DM, 1024, e, wid_s); }
        xbar(wid_s); TS(l * 20 + 5);
        CHKB(m_MB, (size_t)MTOK * DM, 10);
        if (ON(11)) { EpiBf16 e; e.C = m_Y; e.ldc = DM; run_gemm(lds, m_MB, DM, (const bf16_t*)(m_ws + WS_WMIX), MTOK, DM, DM, e, wid_s); }
        xbar(wid_s); TS(l * 20 + 6);
        CHKF(m_Y, (size_t)MTOK * DM, 11);
        if (ON(1)) norm_rows(m_xs, m_Y, p->in[3] + l * DM, nullptr, m_xs, p->in[24] + l * DM, m_H, MTOK, wid_s);
        if (ON(1)) norm_rows_f(p->in[1], nullptr, p->in[26] + l * DM, m_MEMN, 1024, wid_s);
        xbar(wid_s); TS(l * 20 + 7);
        CHKB(m_xs, (size_t)MTOK * DM, 12); CHKB(m_H, (size_t)MTOK * DM, 13);
        if (ON(12)) { EpiBf16 e; e.C = m_XQ; e.ldc = 512; run_gemm(lds, m_H, DM, (const bf16_t*)(m_ws + WS_WXQ), MTOK, 512, DM, e, wid_s); }
        if (ON(13)) { EpiKV e; e.Kb = m_KB; e.VT = m_VTG; run_gemm(lds, m_MEMN, DM, (const bf16_t*)(m_ws + WS_WXKV), 1024, 1024, DM, e, wid_s, 128); }
        xbar(wid_s); TS(l * 20 + 8);
        CHKB(m_XQ, (size_t)MTOK * 512, 14); CHKB(m_KB, (size_t)1024 * 1024, 15);
        if (ON(14)) xattn(lds, m_XQ, m_KB, m_VTG, m_XO, wid_s);
        xbar(wid_s); TS(l * 20 + 9);
        CHKB(m_XO, (size_t)MTOK * 512, 16);
        if (ON(11)) { EpiBf16 e; e.C = m_Y; e.ldc = DM; run_gemm(lds, m_XO, 512, (const bf16_t*)(m_ws + WS_WXO), MTOK, DM, 512, e, wid_s); }
        xbar(wid_s); TS(l * 20 + 10);
        CHKF(m_Y, (size_t)MTOK * DM, 17);
        if (ON(1)) norm_rows(m_xs, m_Y, p->in[25] + l * DM, nullptr, m_xs, p->in[30] + l * DM, m_H, MTOK, wid_s);
        xbar(wid_s); TS(l * 20 + 11);
        CHKB(m_xs, (size_t)MTOK * DM, 18);
        if (ON(15)) { EpiFFN e; e.ACT = m_ACT; e.GB = m_G; e.UB = m_U; e.cw = p->in[33] + (size_t)l * FF * 3; run_gemm(lds, m_H, DM, (const bf16_t*)(m_ws + WS_WA), MTOK, 2 * FF, DM, e, wid_s); }
        xbar(wid_s); TS(l * 20 + 12);
        CHKB(m_G, (size_t)MTOK * FF * 2, 19);
        if (ON(16)) ffn_fix(m_G, m_U, p->in[33] + (size_t)l * FF * 3, m_ACT, wid_s);
        xbar(wid_s); TS(l * 20 + 13);
        CHKB(m_ACT, (size_t)MTOK * FF, 20);
        if (ON(11)) { EpiBf16 e; e.C = m_Y; e.ldc = DM; run_gemm(lds, m_ACT, FF, (const bf16_t*)(m_ws + WS_WA + 46137344), MTOK, DM, FF, e, wid_s); }
        xbar(wid_s); TS(l * 20 + 14);
        CHKF(m_Y, (size_t)MTOK * DM, 21);
        if (l == 0) {
            if (ON(1)) norm_rows(m_xs, m_Y, p->in[31] + l * DM, nullptr, m_xs, p->in[2] + DM, m_H, MTOK, wid_s);
            if (ON(0)) convert_layer_small(ldsf, p, 1, wid_s);
        } else {
            if (ON(1)) norm_rows(m_xs, m_Y, p->in[31] + l * DM, m_out, nullptr, nullptr, nullptr, MTOK, wid_s);
        }
        xbar(wid_s); TS(l * 20 + 15);
        }
#ifdef DEBUG_TS
    {   const float A = (float)tsA * 0.01f, B = (float)tsB * 0.01f;
        xbar(wid_s);
        const unsigned gthreads = (unsigned)fresh_gdim() * 512u, gid = (unsigned)fresh_bid() * 512u + (unsigned)fresh_tid(wid_s);
        float* o = PP()->out;
        for (unsigned i = gid; i < (unsigned)MTOK * DM; i += gthreads) o[i] = (i == 0u) ? B * 10000.f : A;
    }
#endif
#ifdef DEBUG_NAN
    { const unsigned f = *(volatile unsigned*)(PP()->ws + WS_MISC + 32768); int idx = -1; for (int k = 0; k < 32; ++k) if ((f >> k) & 1u) { idx = k; break; }
      bool finalbad = false; const size_t gthreads = (size_t)gridDim.x * 512, gid = (size_t)blockIdx.x * 512 + threadIdx.x;
      const float val = idx < 0 ? 16.f : exp2f(5.f + idx);
      float* o = PP()->out;
      for (size_t i = gid; i < (size_t)MTOK * DM; i += gthreads) { if (idx >= 0) o[i] = val; else { const float v = o[i]; if (!(fabsf(v) < 1e30f)) o[i] = 16.f; } } }
#endif
}

#undef m_ws
#undef m_Z
#undef m_Y
#undef m_SMp
#undef m_H
#undef m_OA
#undef m_OB
#undef m_MRG
#undef m_XQ
#undef m_XO
#undef m_ACT
#undef m_MB
#undef m_MEMN
#undef m_KB
#undef m_VTG
#undef m_G
#undef m_U
#undef m_xs
#undef m_out
#undef p
extern "C" void kernel_launch(void* const* d_in, const int* in_sizes, int n_in,
                              void* d_out, int out_size, void* d_ws, size_t ws_size,
                              hipStream_t stream) {
    static int grid_blocks = 0;
    constexpr int kDynLds = 131072 + 512;
    if (!grid_blocks) {
        int dev = 0, cus = 0, per_cu = 0;
        (void)hipGetDevice(&dev);
        (void)hipDeviceGetAttribute(&cus, hipDeviceAttributeMultiprocessorCount, dev);
        if (hipFuncSetAttribute((const void*)fwd_megakernel, hipFuncAttributeMaxDynamicSharedMemorySize, kDynLds) != hipSuccess) fprintf(stderr, "hipFuncSetAttribute failed\n");
        if (hipOccupancyMaxActiveBlocksPerMultiprocessor(&per_cu, (const void*)fwd_megakernel, 512, kDynLds) != hipSuccess || per_cu < 1) { fprintf(stderr, "occupancy query: %d\n", per_cu); per_cu = 1; }
        (void)hipGetLastError();
        grid_blocks = cus;
        if (n_in != 35 || ws_size < WS_END) fprintf(stderr, "kernel_launch: unexpected n_in %d or ws_size %zu (< %zu)\n", n_in, ws_size, (size_t)WS_END);
    }
    Params hp{};
    for (int i = 0; i < 35; ++i) hp.in[i] = (const float*)d_in[i];
    hp.out = (float*)d_out; hp.ws = (unsigned char*)d_ws;
    (void)hipMemsetAsync((unsigned char*)d_ws + WS_BAR, 0, XCD_BAR_WORDS * 4, stream);
    void* args[] = {&hp};
    hipError_t e = hipLaunchCooperativeKernel((const void*)fwd_megakernel, dim3(grid_blocks), dim3(512), args, kDynLds, stream);
    if (e != hipSuccess) fprintf(stderr, "cooperative launch failed: %s (grid %d)\n", hipGetErrorString(e), grid_blocks);
}
```
